# Optimizing an MI355X kernel written in HIP

```python
import math
import jax, jax.numpy as jnp
from jax import lax
import numpy as np

D_MODEL = 1024
BATCH = 4
SEQ = 8192
DEPTH = 4

A_HEADS = 8
A_HEAD_DIM = 64
A_WIDTH = A_HEADS * A_HEAD_DIM
A_KV_RANK = 128
IDX_HEADS = 8
IDX_DIM = 64
TOPK_MAX = 256
Q_BLOCK = 128
REL_BUCKETS = 32
REL_MAX_DIST = 128
B_HEADS = 4
B_HEAD_DIM = 128
B_WIDTH = B_HEADS * B_HEAD_DIM
CONV_WIDTH = 4
CHUNK = 64
C_WIDTH = 512
C_GROUP = 16
C_GROUPS = C_WIDTH // C_GROUP
C_STATE = 64
DT_MIN = 0.001
DT_MAX = 0.1
N_EXPERTS = 64
TOP_K = 8
D_EXPERT = 256
D_SHARED = 256
ROUTED_SCALE = 2.5
MOE_BLOCK = 256
SPLITS = (A_WIDTH, A_KV_RANK, IDX_HEADS * IDX_DIM, IDX_DIM, IDX_HEADS, 3 * B_WIDTH, B_WIDTH, B_HEADS, B_HEADS, C_WIDTH, 3 * D_MODEL)
D_IN = sum(SPLITS)
DEEPNORM_ALPHA = (2 * DEPTH) ** 0.25
DEEPNORM_BETA = (8 * DEPTH) ** -0.25
LN_EPS = 1e-5
RMS_EPS = 1e-6
NEG_INF = -1e30

kernel_name = 'hybrid_dsa_deltanet_s5_moe_deepnorm'


def layer_norm(x, g, b):
    xf = x.astype(jnp.float32)
    mu = jnp.mean(xf, -1, keepdims=True)
    var = jnp.mean(jnp.square(xf - mu), -1, keepdims=True)
    return ((xf - mu) * lax.rsqrt(var + LN_EPS) * g + b).astype(x.dtype)


def rms_norm(x, g):
    xf = x.astype(jnp.float32)
    return (xf * lax.rsqrt(jnp.mean(xf * xf, -1, keepdims=True) + RMS_EPS) * g).astype(x.dtype)


def l2_normalize(x):
    return x * lax.rsqrt(jnp.sum(x * x, -1, keepdims=True) + RMS_EPS)


def rel_bucket(dist):
    n_exact = REL_BUCKETS // 2
    d = jnp.maximum(dist, 1).astype(jnp.float32)
    large = n_exact + (jnp.log(d / n_exact) / math.log(REL_MAX_DIST / n_exact) * (REL_BUCKETS - n_exact)).astype(jnp.int32)
    return jnp.where(dist < n_exact, dist, jnp.minimum(large, REL_BUCKETS - 1))


def dsa_attention(q, c_kv, q_idx, k_idx, w_idx, kv_norm_g, w_kv_up, rel_bias):
    bn, s = q.shape[0], q.shape[1]
    k_sel = min(TOPK_MAX, s // 4)
    kv = jnp.einsum('bsr,rd->bsd', rms_norm(c_kv, kv_norm_g), w_kv_up).reshape(bn, s, 2, A_HEADS, A_HEAD_DIM)
    k, v = kv[:, :, 0], kv[:, :, 1]
    nb = s // Q_BLOCK
    key_pos = jnp.arange(s, dtype=jnp.int32)

    def to_blocks(t):
        return jnp.moveaxis(t.reshape(bn, nb, Q_BLOCK, *t.shape[2:]), 1, 0)

    def one_block(args):
        qb, qib, wb, tpos = args
        s_idx = jnp.einsum('bqhd,bsd->bqhs', qib, k_idx) * IDX_DIM ** -0.5
        score = jnp.einsum('bqh,bqhs->bqs', wb, jax.nn.relu(s_idx)).astype(jnp.float32)
        visible = key_pos[None, :] <= tpos[:, None]
        score = jnp.where(visible[None], score, -jnp.inf)
        _, sel = lax.top_k(score, k_sel)
        k_g = jax.vmap(lambda kb, ib: kb[ib])(k, sel)
        v_g = jax.vmap(lambda vb, ib: vb[ib])(v, sel)
        dist = tpos[None, :, None] - sel
        bias = jnp.moveaxis(rel_bias[rel_bucket(jnp.maximum(dist, 0))], 3, 1)
        logits = jnp.einsum('bqhd,bqkhd->bhqk', qb, k_g).astype(jnp.float32) * A_HEAD_DIM ** -0.5 + bias
        logits = jnp.where((dist >= 0)[:, None], logits, NEG_INF)
        p = jax.nn.softmax(logits, axis=-1).astype(v.dtype)
        return jnp.einsum('bhqk,bqkhd->bqhd', p, v_g)

    out = lax.map(one_block, (to_blocks(q), to_blocks(q_idx), to_blocks(w_idx), key_pos.reshape(nb, Q_BLOCK)))
    return jnp.moveaxis(out, 0, 1).reshape(bn, s, A_WIDTH)


def causal_depthwise_conv(x, w):
    s = x.shape[1]
    xp = jnp.pad(x, ((0, 0), (CONV_WIDTH - 1, 0), (0, 0)))
    return sum(xp[:, j:j + s] * w[j] for j in range(CONV_WIDTH))


def chunk_gated_delta_rule(q, k, v, g, beta):
    bn, s, h, dk = q.shape
    dv = v.shape[-1]
    n = s // CHUNK

    def chunks(t):
        return jnp.moveaxis(t.reshape(bn, n, CHUNK, h, -1), 3, 1)

    q, k, v = chunks(q), chunks(k), chunks(v)
    gc = jnp.cumsum(chunks(g[..., None])[..., 0], axis=-1)
    beta = chunks(beta[..., None])[..., 0]
    causal = jnp.tril(jnp.ones((CHUNK, CHUNK), bool))
    strict = jnp.tril(jnp.ones((CHUNK, CHUNK), bool), -1)
    decay = jnp.exp(jnp.where(causal, gc[..., :, None] - gc[..., None, :], -jnp.inf))
    k_beta = k * beta[..., None]
    m = jnp.where(strict, jnp.einsum('bhnid,bhnjd->bhnij', k_beta, k) * decay, 0.0)
    eye = jnp.eye(CHUNK, dtype=jnp.float32)
    t_inv = lax.linalg.triangular_solve(eye + m, jnp.broadcast_to(eye, m.shape), left_side=True, lower=True)
    u = t_inv @ (v * beta[..., None])
    w = t_inv @ (k_beta * jnp.exp(gc)[..., None])
    qk = jnp.einsum('bhnid,bhnjd->bhnij', q, k) * decay
    q_dec = q * jnp.exp(gc)[..., None]
    k_dec = k * jnp.exp(gc[..., -1:] - gc)[..., None]
    g_last = jnp.exp(gc[..., -1])

    def step(state, inp):
        u_n, w_n, qd_n, kd_n, qk_n, gl_n = inp
        v_new = u_n - w_n @ state
        o_n = qd_n @ state + qk_n @ v_new
        state = state * gl_n[..., None, None] + jnp.swapaxes(kd_n, -1, -2) @ v_new
        return state, o_n

    xs = tuple(jnp.moveaxis(t, 2, 0) for t in (u, w, q_dec, k_dec, qk, g_last))
    _, o = lax.scan(step, jnp.zeros((bn, h, dk, dv), jnp.float32), xs)
    o = jnp.moveaxis(jnp.moveaxis(o, 0, 2), 1, 3)
    return o.reshape(bn, s, h, dv)


def gated_deltanet(qkv, z, a, b, conv_w, a_log, dt_bias, out_norm_g):
    bn, s, _ = qkv.shape
    dtype = qkv.dtype
    qkv = jax.nn.silu(causal_depthwise_conv(qkv, conv_w)).astype(jnp.float32)
    q, k, v = [t.reshape(bn, s, B_HEADS, B_HEAD_DIM) for t in jnp.split(qkv, 3, axis=-1)]
    q = l2_normalize(q) * B_HEAD_DIM ** -0.5
    k = l2_normalize(k)
    beta = jax.nn.sigmoid(b.astype(jnp.float32))
    g = -jnp.exp(a_log.astype(jnp.float32)) * jax.nn.softplus(a.astype(jnp.float32) + dt_bias)
    o = chunk_gated_delta_rule(q, k, v, g, beta)
    o = rms_norm(o, out_norm_g) * jax.nn.silu(z.astype(jnp.float32)).reshape(bn, s, B_HEADS, B_HEAD_DIM)
    return o.reshape(bn, s, B_WIDTH).astype(dtype)


def complex_affine_combine(e1, e2):
    a1r, a1i, b1r, b1i = e1
    a2r, a2i, b2r, b2i = e2
    return (a2r * a1r - a2i * a1i, a2r * a1i + a2i * a1r,
            a2r * b1r - a2i * b1i + b2r, a2r * b1i + a2i * b1r + b2i)


def s5_branch(u, lam_re, lam_im, log_dt, b_re, b_im, c_re, c_im, d_skip, glu_w, glu_b):
    bn, s, _ = u.shape
    uf = u.astype(jnp.float32).reshape(bn, s, C_GROUPS, C_GROUP)
    dt = jnp.exp(log_dt.astype(jnp.float32))[:, None]
    lr, li = lam_re.astype(jnp.float32), lam_im.astype(jnp.float32)
    mag = jnp.exp(lr * dt)
    a_re, a_im = mag * jnp.cos(li * dt), mag * jnp.sin(li * dt)
    den = lr * lr + li * li
    f_re = ((a_re - 1.0) * lr + a_im * li) / den
    f_im = (a_im * lr - (a_re - 1.0) * li) / den
    bb_re = f_re[..., None] * b_re - f_im[..., None] * b_im
    bb_im = f_re[..., None] * b_im + f_im[..., None] * b_re
    bu_re = jnp.einsum('bsgi,gpi->bsgp', uf, bb_re)
    bu_im = jnp.einsum('bsgi,gpi->bsgp', uf, bb_im)
    elems = (jnp.broadcast_to(a_re, bu_re.shape), jnp.broadcast_to(a_im, bu_re.shape), bu_re, bu_im)
    _, _, x_re, x_im = lax.associative_scan(complex_affine_combine, elems, axis=1)
    y = jnp.einsum('bsgp,gip->bsgi', x_re, c_re) - jnp.einsum('bsgp,gip->bsgi', x_im, c_im) + d_skip * uf
    y = jax.nn.gelu(y.reshape(bn, s, C_WIDTH))
    out = y * jax.nn.sigmoid(y @ glu_w + glu_b)
    return out.astype(u.dtype)


def hybrid_mixer(x, rel_bias, w_in, a_kv_norm, a_kv_up, b_conv, b_a_log, b_dt_bias, b_out_norm,
                 c_lambda_re, c_lambda_im, c_log_dt, c_b_re, c_b_im, c_c_re, c_c_im, c_d, c_glu_w, c_glu_b,
                 w_br_a, w_br_b, w_br_c, w_o):
    bn, s, _ = x.shape
    h = jnp.einsum('bsd,de->bse', x, w_in)
    offsets = np.cumsum(SPLITS)[:-1].tolist()
    a_q, a_ckv, idx_q, idx_k, idx_w, b_qkv, b_z, b_a, b_b, c_u, gate_logits = jnp.split(h, offsets, axis=-1)
    ya = dsa_attention(a_q.reshape(bn, s, A_HEADS, A_HEAD_DIM), a_ckv,
                       idx_q.reshape(bn, s, IDX_HEADS, IDX_DIM), idx_k, idx_w * IDX_HEADS ** -0.5,
                       a_kv_norm, a_kv_up, rel_bias)
    yb = gated_deltanet(b_qkv, b_z, b_a, b_b, b_conv, b_a_log, b_dt_bias, b_out_norm)
    yc = s5_branch(c_u, c_lambda_re, c_lambda_im, c_log_dt, c_b_re, c_b_im, c_c_re, c_c_im, c_d, c_glu_w, c_glu_b)
    ga, gb, gc = jnp.split(jax.nn.sigmoid(gate_logits.astype(jnp.float32)).astype(x.dtype), 3, axis=-1)
    merged = ga * (ya @ w_br_a) + gb * (yb @ w_br_b) + gc * (yc @ w_br_c)
    return merged @ w_o


def moe_ffn(x, router_w, router_bias, exp_w_gu, exp_w_down, sh_w_gu, sh_w_down):
    bn, s, d = x.shape
    xt = x.reshape(bn * s, d)
    n_tok = xt.shape[0]
    scores = jax.nn.sigmoid(jnp.einsum('td,de->te', xt, router_w).astype(jnp.float32))
    _, top_idx = lax.top_k(scores + router_bias.astype(jnp.float32), TOP_K)
    top_s = jnp.take_along_axis(scores, top_idx, axis=-1)
    gates = top_s / jnp.sum(top_s, -1, keepdims=True) * ROUTED_SCALE
    e_flat = top_idx.reshape(-1)
    n_asg = e_flat.shape[0]
    order = jnp.argsort(e_flat)
    e_sorted = e_flat[order]
    counts = jax.ops.segment_sum(jnp.ones_like(e_flat), e_flat, num_segments=N_EXPERTS)
    starts = jnp.cumsum(counts) - counts
    padded = (counts + MOE_BLOCK - 1) // MOE_BLOCK * MOE_BLOCK
    pad_ends = jnp.cumsum(padded)
    dest = pad_ends[e_sorted] - padded[e_sorted] + jnp.arange(n_asg, dtype=jnp.int32) - starts[e_sorted]
    n_blk = n_asg // MOE_BLOCK + N_EXPERTS + 1
    n_pad = n_blk * MOE_BLOCK
    buf_tok = jnp.full((n_pad,), n_tok, jnp.int32).at[dest].set((order // TOP_K).astype(jnp.int32))
    buf_gate = jnp.zeros((n_pad,), jnp.float32).at[dest].set(gates.reshape(-1)[order])
    blk_expert = jnp.minimum(jnp.searchsorted(pad_ends, jnp.arange(n_blk, dtype=jnp.int32) * MOE_BLOCK, side='right'), N_EXPERTS - 1)
    x_pad = jnp.concatenate([xt, jnp.zeros((1, d), xt.dtype)], axis=0)

    def expert_block(acc, blk):
        tok, gate, e = blk
        hg, hu = jnp.split(x_pad[tok] @ exp_w_gu[e], 2, axis=-1)
        y = (jax.nn.silu(hg) * hu) @ exp_w_down[e]
        return acc.at[tok].add((y * gate[:, None]).astype(acc.dtype)), None

    routed, _ = lax.scan(expert_block, jnp.zeros_like(x_pad),
                         (buf_tok.reshape(n_blk, MOE_BLOCK), buf_gate.reshape(n_blk, MOE_BLOCK), blk_expert))
    sg, su = jnp.split(xt @ sh_w_gu, 2, axis=-1)
    shared = (jax.nn.silu(sg) * su) @ sh_w_down
    return (routed[:n_tok] + shared).reshape(bn, s, d)


def setup_inputs(seed: int = 0) -> dict:
    key = jax.random.key(seed)
    ks = jax.random.split(key, 40)
    L, G, P, GH = DEPTH, C_GROUPS, C_STATE, C_GROUP

    def nrm(k, shape, scale):
        return jax.random.normal(k, shape, jnp.float32) * scale

    dt_b = jnp.exp(jax.random.uniform(ks[7], (L, B_HEADS), minval=math.log(DT_MIN), maxval=math.log(DT_MAX)))
    return {
        'x': nrm(ks[0], (BATCH, SEQ, D_MODEL), 1.0),
        'rel_bias': nrm(ks[1], (REL_BUCKETS, A_HEADS), 0.5),
        'w_in': nrm(ks[2], (L, D_MODEL, D_IN), D_MODEL ** -0.5),
        'a_kv_norm': 1.0 + nrm(ks[3], (L, A_KV_RANK), 0.02),
        'a_kv_up': nrm(ks[4], (L, A_KV_RANK, 2 * A_WIDTH), A_KV_RANK ** -0.5),
        'b_conv': nrm(ks[5], (L, CONV_WIDTH, 3 * B_WIDTH), CONV_WIDTH ** -0.5),
        'b_a_log': jnp.log(jax.random.uniform(ks[6], (L, B_HEADS), minval=1.0, maxval=16.0)),
        'b_dt_bias': dt_b + jnp.log(-jnp.expm1(-dt_b)),
        'b_out_norm': 1.0 + nrm(ks[8], (L, B_HEAD_DIM), 0.02),
        'c_lambda_re': -0.5 + nrm(ks[9], (L, G, P), 0.01),
        'c_lambda_im': math.pi * jnp.arange(P, dtype=jnp.float32) + nrm(ks[10], (L, G, P), 0.01),
        'c_log_dt': jax.random.uniform(ks[11], (L, G), minval=math.log(DT_MIN), maxval=math.log(DT_MAX)),
        'c_b_re': nrm(ks[12], (L, G, P, GH), (2 * GH) ** -0.5),
        'c_b_im': nrm(ks[13], (L, G, P, GH), (2 * GH) ** -0.5),
        'c_c_re': nrm(ks[14], (L, G, GH, P), P ** -0.5),
        'c_c_im': nrm(ks[15], (L, G, GH, P), P ** -0.5),
        'c_d': nrm(ks[16], (L, G, GH), 1.0),
        'c_glu_w': nrm(ks[17], (L, C_WIDTH, C_WIDTH), C_WIDTH ** -0.5),
        'c_glu_b': nrm(ks[18], (L, C_WIDTH), 0.02),
        'w_br_a': nrm(ks[19], (L, A_WIDTH, D_MODEL), A_WIDTH ** -0.5),
        'w_br_b': nrm(ks[20], (L, B_WIDTH, D_MODEL), B_WIDTH ** -0.5),
        'w_br_c': nrm(ks[21], (L, C_WIDTH, D_MODEL), C_WIDTH ** -0.5),
        'w_o': nrm(ks[22], (L, D_MODEL, D_MODEL), D_MODEL ** -0.5 * DEEPNORM_BETA),
        'ln1_g': 1.0 + nrm(ks[23], (L, D_MODEL), 0.02),
        'ln1_b': nrm(ks[24], (L, D_MODEL), 0.02),
        'router_w': nrm(ks[25], (L, D_MODEL, N_EXPERTS), D_MODEL ** -0.5),
        'router_bias': nrm(ks[26], (L, N_EXPERTS), 0.01),
        'exp_w_gu': nrm(ks[27], (L, N_EXPERTS, D_MODEL, 2 * D_EXPERT), D_MODEL ** -0.5),
        'exp_w_down': nrm(ks[28], (L, N_EXPERTS, D_EXPERT, D_MODEL), D_EXPERT ** -0.5 * DEEPNORM_BETA),
        'sh_w_gu': nrm(ks[29], (L, D_MODEL, 2 * D_SHARED), D_MODEL ** -0.5),
        'sh_w_down': nrm(ks[30], (L, D_SHARED, D_MODEL), D_SHARED ** -0.5 * DEEPNORM_BETA),
        'ln2_g': 1.0 + nrm(ks[31], (L, D_MODEL), 0.02),
        'ln2_b': nrm(ks[32], (L, D_MODEL), 0.02),
    }


def reference(x, rel_bias, w_in, a_kv_norm, a_kv_up, b_conv, b_a_log, b_dt_bias, b_out_norm,
              c_lambda_re, c_lambda_im, c_log_dt, c_b_re, c_b_im, c_c_re, c_c_im, c_d, c_glu_w, c_glu_b,
              w_br_a, w_br_b, w_br_c, w_o, ln1_g, ln1_b,
              router_w, router_bias, exp_w_gu, exp_w_down, sh_w_gu, sh_w_down, ln2_g, ln2_b):
    for i in range(DEPTH):
        mix = hybrid_mixer(x, rel_bias, w_in[i], a_kv_norm[i], a_kv_up[i], b_conv[i], b_a_log[i], b_dt_bias[i],
                           b_out_norm[i], c_lambda_re[i], c_lambda_im[i], c_log_dt[i], c_b_re[i], c_b_im[i],
                           c_c_re[i], c_c_im[i], c_d[i], c_glu_w[i], c_glu_b[i], w_br_a[i], w_br_b[i], w_br_c[i], w_o[i])
        x = layer_norm(DEEPNORM_ALPHA * x + mix, ln1_g[i], ln1_b[i])
        ffn = moe_ffn(x, router_w[i], router_bias[i], exp_w_gu[i], exp_w_down[i], sh_w_gu[i], sh_w_down[i])
        x = layer_norm(DEEPNORM_ALPHA * x + ffn, ln2_g[i], ln2_b[i])
    return x
```

```cpp
#include <hip/hip_runtime.h>
#include <stdint.h>
#include <stdio.h>

#define LAS __attribute__((address_space(3)))
typedef unsigned short bf16_t;
typedef short bf16x8 __attribute__((ext_vector_type(8)));
typedef float f32x4 __attribute__((ext_vector_type(4)));
typedef float f32x16 __attribute__((ext_vector_type(16)));
typedef float f32x2 __attribute__((ext_vector_type(2)));
typedef unsigned u32x4 __attribute__((ext_vector_type(4)));
typedef unsigned u32x2 __attribute__((ext_vector_type(2)));

constexpr int D_MODEL = 1024, BATCH = 4, SEQ = 8192, DEPTH = 4, NTOK = BATCH * SEQ;
constexpr int D_IN = 6864;
constexpr float DN_ALPHA = 1.681792830507429f;
constexpr float LN_EPS = 1e-5f, RMS_EPS = 1e-6f;
constexpr int NWG_THREADS = 512;

typedef __bf16 bf16x2_t __attribute__((ext_vector_type(2)));
__device__ __forceinline__ unsigned cvt_pk_bf16(float lo, float hi) { const f32x2 v = {lo, hi}; const bf16x2_t r = __builtin_convertvector(v, bf16x2_t); return __builtin_bit_cast(unsigned, r); }
__device__ __forceinline__ bf16_t f2bf(float f) { unsigned u = __float_as_uint(f); u += 0x7FFFu + ((u >> 16) & 1u); return (bf16_t)(u >> 16); }
__device__ __forceinline__ float bf2f(bf16_t b) { return __uint_as_float(((unsigned)b) << 16); }
__device__ __forceinline__ float bflo(unsigned w) { return __uint_as_float(w << 16); }
__device__ __forceinline__ float bfhi(unsigned w) { return __uint_as_float(w & 0xffff0000u); }
__device__ __forceinline__ float sigmoidf_(float x) { return 1.0f / (1.0f + __expf(-x)); }
__device__ __forceinline__ float siluf_(float x) { return x / (1.0f + __expf(-x)); }
__device__ __forceinline__ int lane_opq() { int l = (int)__builtin_amdgcn_mbcnt_hi(~0u, __builtin_amdgcn_mbcnt_lo(~0u, 0u)); asm volatile("" : "+v"(l)); return l; }
__device__ __forceinline__ float shf(float v, int src) { return __int_as_float(__builtin_amdgcn_ds_bpermute(src << 2, __float_as_int(v))); }
__device__ __forceinline__ int shi(int v, int src) { return __builtin_amdgcn_ds_bpermute(src << 2, v); }
__device__ __forceinline__ float wave_sum(float v) {
    const int l = lane_opq();
#pragma unroll
    for (int o = 32; o >= 1; o >>= 1) v += shf(v, l ^ o);
    return v;
}
__device__ __forceinline__ float wave_max(float v) {
    const int l = lane_opq();
#pragma unroll
    for (int o = 32; o >= 1; o >>= 1) v = fmaxf(v, shf(v, l ^ o));
    return v;
}

#define XB_TMO      128
#define XB_XCNT(j)  (256  + 64 * (j))
#define XB_XSUB(j)  (1280 + 64 * (j))
#define XB_XGEN(j)  (2304 + 64 * (j))
#define XB_TOP      3328
#define XB_TOPGEN   3392
#define XCD_BAR_WORDS 3456
#define XB_SPIN_CAP (1u << 18)

__device__ __forceinline__ unsigned xb_ld(unsigned* p)              { return __hip_atomic_load(p, __ATOMIC_RELAXED, __HIP_MEMORY_SCOPE_AGENT); }
__device__ __forceinline__ unsigned xb_add(unsigned* p, unsigned v) { return __hip_atomic_fetch_add(p, v, __ATOMIC_RELAXED, __HIP_MEMORY_SCOPE_AGENT); }
__device__ __forceinline__ unsigned xb_xcc_id() { return (unsigned)__builtin_amdgcn_s_getreg((3 << 11) | 20) & 0xFu; }
#define XB_SPIN(cond, bar) do { unsigned _sp = 0; while (cond) { __builtin_amdgcn_s_sleep(1); \
    if ((++_sp & 255u) == 0u) { if (xb_ld(&(bar)[XB_TMO])) break; if (_sp > XB_SPIN_CAP) { atomicAdd(&(bar)[XB_TMO], 1u); break; } } } } while (0)

struct XcdBarrier { unsigned* bar; unsigned x; volatile LAS unsigned* st; };

__device__ __forceinline__ XcdBarrier xcd_barrier_post(unsigned* bar, volatile LAS unsigned* st, int tid) {
    XcdBarrier b; b.bar = bar; b.x = xb_xcc_id(); b.st = st;
    if (tid == 0) (void)xb_add(&bar[XB_XCNT(b.x)], 1u);
    return b;
}
__device__ __forceinline__ void xcd_barrier_complete(unsigned* bar, unsigned x, unsigned& nloc, unsigned& nx) {
    const unsigned G = gridDim.x * gridDim.y * gridDim.z;
    unsigned sum, cnt, mine, sp = 0u;
    for (;;) {
        sum = 0u; cnt = 0u; mine = 0u;
#pragma unroll
        for (unsigned j = 0; j < 16; ++j) { const unsigned c = xb_ld(&bar[XB_XCNT(j)]); sum += c; cnt += (c > 0u) ? 1u : 0u; mine = (j == x) ? c : mine; }
        if (sum == G) break;
        __builtin_amdgcn_s_sleep(1);
        if ((++sp & 255u) == 0u) { if (xb_ld(&bar[XB_TMO])) break; if (sp > XB_SPIN_CAP) { atomicAdd(&bar[XB_TMO], 1u); break; } }
    }
    nloc = mine > 0u ? mine : 1u; nx = cnt > 0u ? cnt : 1u;
}
__device__ __noinline__ void xcd_barrier_ni(unsigned* bar_, unsigned x_, unsigned st_, int tid) {
    XcdBarrier b; b.bar = bar_; b.x = x_; b.st = (volatile LAS unsigned*)(size_t)st_;
    asm volatile("s_waitcnt vmcnt(0)" ::: "memory");
    __syncthreads();
    if (tid == 0) {
        unsigned* bar = b.bar;
        __builtin_amdgcn_s_waitcnt(0);
        unsigned nloc = b.st[0], nx = b.st[1];
        if (nloc == 0u) { xcd_barrier_complete(bar, b.x, nloc, nx); b.st[0] = nloc; b.st[1] = nx; }
        const unsigned old = xb_add(&bar[XB_XSUB(b.x)], 1u);
        const unsigned gen = old / nloc;
        if (old + 1u == (gen + 1u) * nloc) {
            __builtin_amdgcn_fence(__ATOMIC_RELEASE, "agent");
            asm volatile("s_waitcnt vmcnt(0)" ::: "memory");
            const unsigned og = xb_add(&bar[XB_TOP], 1u);
            const unsigned tg = og / nx;
            if (og + 1u == (tg + 1u) * nx) xb_add(&bar[XB_TOPGEN], 1u);
            else XB_SPIN(xb_ld(&bar[XB_TOPGEN]) == tg, bar);
            __builtin_amdgcn_fence(__ATOMIC_ACQUIRE, "agent");
            xb_add(&bar[XB_XGEN(b.x)], 1u);
            asm volatile("s_waitcnt vmcnt(0)" ::: "memory");
        } else {
            XB_SPIN(xb_ld(&bar[XB_XGEN(b.x)]) == gen, bar);
            __builtin_amdgcn_fence(__ATOMIC_ACQUIRE, "agent");
            asm volatile("s_waitcnt vmcnt(0)" ::: "memory");
        }
    }
    __syncthreads();
}

namespace pg8 {
#ifndef PG8_A_AUX
#define PG8_A_AUX 0
#endif
constexpr int BM = 256, BK = 64, HALF = 128, HTB = HALF * BK * 2, STAGE_BYTES = 8 * HTB;
__device__ __forceinline__ int lds_byte(int r, int c) { const int st = (r >> 4) * 2 + (c >> 5), rr = r & 15, cc = c & 31, ob = rr * 64 + cc * 2; return st * 1024 + (ob ^ (((ob >> 9) & 1) << 5)); }
__device__ __forceinline__ void stage_rc(int b, int& R, int& C) { const int st = b / 1024, sb = b % 1024, swz = sb ^ (((sb >> 9) & 1) << 5); R = (st >> 1) * 16 + swz / 64; C = (st & 1) * 32 + (swz % 64) / 2; }
__device__ __forceinline__ int perm32(int rho) { const int n = rho >> 4, i = rho & 15; return 8 * (i >> 2) + 4 * n + (i & 3); }
struct Unit { int pm, pn; };

template <class Epi, class Sched>
__device__ __forceinline__ void gemm_phase(LAS unsigned char* lds, const int wave_, const char* Abase, const int K, const Sched& S, const Epi& E) {
    int tid_ = wave_ * 64 + (int)__builtin_amdgcn_mbcnt_hi(~0u, __builtin_amdgcn_mbcnt_lo(~0u, 0u)); asm volatile("" : "+v"(tid_));
    const int tid = tid_, wid = __builtin_amdgcn_readfirstlane(tid >> 6), lane = tid & 63, wr = wid >> 2, wc = wid & 3, fr = lane & 15, fq = lane >> 4;
    const int nt = K / BK;
    int RA[2], CA[2]; unsigned voffB[2];
#pragma unroll
    for (int i = 0; i < 2; ++i) { int R, C; stage_rc(tid * 16 + i * 8192, R, C); const int Rb = Epi::PERM ? ((R & ~31) + perm32(R & 31)) : R;
        RA[i] = R; CA[i] = C * 2; voffB[i] = (unsigned)(Rb * K + C) * 2u; }
    const size_t kstep = (size_t)(BK * 2);
    const size_t hstep = (size_t)HALF * K * 2;
    const unsigned ldsw = (unsigned)wid * 1024u;
    const int aoff = lds_byte(wr * 64 + fr, fq * 8), boff = lds_byte(wc * 32 + fr, fq * 8);
#define PG8_SA(b, h) (((b) * 2 + (h)) * HTB)
#define PG8_SB(b, h) ((4 + (b) * 2 + (h)) * HTB)
#define PG8_STAGE(bufoff, gbase, voff) do { _Pragma("unroll") for (int _i = 0; _i < 2; ++_i) \
        __builtin_amdgcn_global_load_lds((const unsigned*)((const char*)(gbase) + (voff)[_i]), (LAS unsigned*)(lds + (bufoff) + ldsw + _i * 8192), 16, 0, 0); } while (0)
#define PG8_STAGEA(bufoff, base, offs, kb) do { _Pragma("unroll") for (int _i = 0; _i < 2; ++_i) \
        __builtin_amdgcn_global_load_lds((const unsigned*)((base) + (size_t)(offs)[_i] + (size_t)(kb)), (LAS unsigned*)(lds + (bufoff) + ldsw + _i * 8192), 16, 0, PG8_A_AUX); } while (0)
#define PG8_LDA(dst, b, h) do { _Pragma("unroll") for (int m = 0; m < 4; ++m) _Pragma("unroll") for (int k = 0; k < 2; ++k) dst[m][k] = *(const LAS bf16x8*)(lds + PG8_SA(b, h) + aoff + m * 2048 + k * 1024); } while (0)
#define PG8_LDB(dst, b, h) do { _Pragma("unroll") for (int n = 0; n < 2; ++n) _Pragma("unroll") for (int k = 0; k < 2; ++k) dst[n][k] = *(const LAS bf16x8*)(lds + PG8_SB(b, h) + boff + n * 2048 + k * 1024); } while (0)
#define PG8_MMA(ai, bj, At, Bt) do { __builtin_amdgcn_s_setprio(1); _Pragma("unroll") for (int m = 0; m < 4; ++m) _Pragma("unroll") for (int n = 0; n < 2; ++n) _Pragma("unroll") for (int k = 0; k < 2; ++k) \
        acc[ai][bj][m][n] = __builtin_amdgcn_mfma_f32_16x16x32_bf16(Bt[n][k], At[m][k], acc[ai][bj][m][n], 0, 0, 0); __builtin_amdgcn_s_setprio(0); } while (0)
#define PG8_WAIT_V(n) asm volatile("s_waitcnt vmcnt(" #n ")" ::: "memory")
#define PG8_WAIT_L(n) asm volatile("s_waitcnt lgkmcnt(" #n ")" ::: "memory")
#define PG8_BAR __builtin_amdgcn_s_barrier()
#define PG8_SCHED __builtin_amdgcn_sched_barrier(0)
    Unit cur, nxt; int ui = 0;
    if (!S.next(0, cur)) return;
    f32x4 acc[2][2][4][2];
#pragma unroll
    for (int a = 0; a < 2; ++a)
#pragma unroll
        for (int b = 0; b < 2; ++b)
#pragma unroll
            for (int m = 0; m < 4; ++m)
#pragma unroll
                for (int n = 0; n < 2; ++n) acc[a][b][m][n] = (f32x4){0.f, 0.f, 0.f, 0.f};
    bf16x8 At[4][2], B0[2][2], B1[2][2];
    constexpr bool GA = Sched::GATHER;
    unsigned ac0[2], ac1[2];
    const size_t hstepA = GA ? (size_t)0 : (size_t)HALF * S.a_ld() * 2;
    const char* cA = Abase; const char* nA = Abase;
    if constexpr (GA) {
#pragma unroll
        for (int i = 0; i < 2; ++i) { ac0[i] = S.a_row_off(cur, RA[i]) + CA[i]; ac1[i] = S.a_row_off(cur, HALF + RA[i]) + CA[i]; }
    } else {
#pragma unroll
        for (int i = 0; i < 2; ++i) { ac0[i] = (unsigned)(RA[i] * S.a_ld() * 2 + CA[i]); ac1[i] = ac0[i]; }
        cA = Abase + (size_t)S.a_tile_off(cur);
    }
    const char* cB = S.b_ptr(cur);
    PG8_STAGE(PG8_SB(0, 0), cB, voffB); PG8_STAGEA(PG8_SA(0, 0), cA, ac0, 0); PG8_STAGE(PG8_SB(0, 1), cB + hstep, voffB); PG8_STAGEA(PG8_SA(0, 1), cA + hstepA, ac1, 0);
    if (wr == 1) PG8_BAR;
    PG8_WAIT_V(4); PG8_BAR;
    PG8_STAGE(PG8_SB(1, 0), cB + kstep, voffB); PG8_STAGEA(PG8_SA(1, 0), cA, ac0, kstep); PG8_STAGE(PG8_SB(1, 1), cB + hstep + kstep, voffB);
    PG8_WAIT_V(6); PG8_BAR;
    for (;;) {
        const bool has_next = S.next(ui + 1, nxt);
        const char* nB = has_next ? S.b_ptr(nxt) : cB;
        if constexpr (!GA) { nA = has_next ? Abase + (size_t)S.a_tile_off(nxt) : cA; }
        unsigned s0[2], s1[2];
        for (int t = 0; t < nt; t += 2) {
            const bool last = (t == nt - 2);
            const size_t k1 = (size_t)(t + 1) * kstep;
            const size_t k2 = last ? (size_t)0 : (size_t)(t + 2) * kstep;
            const char* b2 = last ? nB : cB + (size_t)(t + 2) * kstep;
            const char* b3 = b2 + kstep;
            const char* a2 = (last && !GA) ? nA : cA;
#pragma unroll
            for (int i = 0; i < 2; ++i) { s0[i] = ac0[i]; s1[i] = ac1[i]; }
            if constexpr (GA) { if (last && has_next) {
#pragma unroll
                for (int i = 0; i < 2; ++i) { int R, C; stage_rc(tid * 16 + i * 8192, R, C); s0[i] = S.a_row_off(nxt, R) + C * 2; s1[i] = S.a_row_off(nxt, HALF + R) + C * 2; } } }
            PG8_LDB(B0, 0, 0); PG8_SCHED; PG8_LDA(At, 0, 0); PG8_STAGEA(PG8_SA(1, 1), cA + hstepA, ac1, k1);
            PG8_WAIT_L(8); PG8_BAR; PG8_WAIT_L(0); PG8_MMA(0, 0, At, B0); PG8_BAR; PG8_SCHED;
            PG8_LDB(B1, 0, 1); PG8_STAGE(PG8_SB(0, 0), b2, voffB);
            PG8_BAR; PG8_WAIT_L(0); PG8_MMA(0, 1, At, B1); PG8_BAR;
            PG8_LDA(At, 0, 1); PG8_STAGEA(PG8_SA(0, 0), a2, s0, k2);
            PG8_BAR; PG8_WAIT_L(0); PG8_MMA(1, 0, At, B0); PG8_BAR; PG8_SCHED;
            PG8_STAGE(PG8_SB(0, 1), b2 + hstep, voffB);
            PG8_WAIT_V(6); PG8_BAR; PG8_MMA(1, 1, At, B1); PG8_BAR;
            PG8_LDB(B0, 1, 0); PG8_SCHED; PG8_LDA(At, 1, 0); PG8_STAGEA(PG8_SA(0, 1), a2 + hstepA, s1, k2);
            PG8_WAIT_L(8); PG8_BAR; PG8_WAIT_L(0); PG8_MMA(0, 0, At, B0); PG8_BAR; PG8_SCHED;
            PG8_LDB(B1, 1, 1); PG8_STAGE(PG8_SB(1, 0), b3, voffB);
            PG8_BAR; PG8_WAIT_L(0); PG8_MMA(0, 1, At, B1); PG8_BAR;
            PG8_LDA(At, 1, 1); PG8_STAGEA(PG8_SA(1, 0), a2, s0, k2 + kstep);
            PG8_BAR; PG8_WAIT_L(0); PG8_MMA(1, 0, At, B0); PG8_BAR; PG8_SCHED;
            PG8_STAGE(PG8_SB(1, 1), b3 + hstep, voffB);
            PG8_WAIT_V(6); PG8_BAR; PG8_MMA(1, 1, At, B1); PG8_BAR;
        }
        { int l2 = (int)__builtin_amdgcn_mbcnt_hi(~0u, __builtin_amdgcn_mbcnt_lo(~0u, 0u)); asm volatile("" : "+v"(l2)); E(acc, cur, wr, wc, l2 & 15, l2 >> 4); }
        if (!has_next) break;
#pragma unroll
        for (int a = 0; a < 2; ++a)
#pragma unroll
            for (int b = 0; b < 2; ++b)
#pragma unroll
                for (int m = 0; m < 4; ++m)
#pragma unroll
                    for (int n = 0; n < 2; ++n) acc[a][b][m][n] = (f32x4){0.f, 0.f, 0.f, 0.f};
        cur = nxt; cB = nB; cA = nA; ++ui;
        if constexpr (GA) {
#pragma unroll
            for (int i = 0; i < 2; ++i) { ac0[i] = s0[i]; ac1[i] = s1[i]; }
        }
    }
    PG8_WAIT_V(0);
    if (wr == 0) PG8_BAR;
    PG8_BAR;
#undef PG8_SA
#undef PG8_SB
#undef PG8_STAGE
#undef PG8_STAGEA
#undef PG8_LDA
#undef PG8_LDB
#undef PG8_MMA
#undef PG8_WAIT_V
#undef PG8_WAIT_L
#undef PG8_BAR
#undef PG8_SCHED
}
}
using pg8::Unit;

constexpr size_t al256(size_t x) { return (x + 255) & ~(size_t)255; }
constexpr size_t MB = 1024 * 1024;
constexpr size_t WS_CTL = 0;
constexpr size_t CTL_BAR = 0;
constexpr size_t CTL_MOECNT = 16384;
constexpr size_t CTL_BYTES = 32768;
constexpr int NIN = 7424;
constexpr size_t WS_WIN  = al256(WS_CTL + CTL_BYTES);
constexpr size_t WS_WBRA = WS_WIN  + (size_t)NIN * 1024 * 2;
constexpr size_t WS_WBRB = WS_WBRA + (size_t)1024 * 1024 * 2;
constexpr size_t WS_WBRC = WS_WBRB + (size_t)1024 * 512 * 2;
constexpr size_t WS_WO   = WS_WBRC + (size_t)1024 * 512 * 2;
constexpr size_t WS_WGLU = WS_WO   + (size_t)1024 * 1024 * 2;
constexpr size_t WS_WRT  = WS_WGLU + (size_t)512 * 512 * 2;
constexpr size_t WS_WGU  = WS_WRT  + (size_t)256 * 1024 * 2;
constexpr size_t WS_WDN  = WS_WGU  + (size_t)65 * 512 * 1024 * 2;
constexpr size_t WS_S5TF = WS_WDN  + (size_t)65 * 1024 * 256 * 2;
constexpr size_t WS_S5E  = WS_S5TF + (size_t)32 * 512 * 640 * 2;
constexpr size_t WS_S5A32 = WS_S5E + (size_t)32 * 256 * 512 * 2;
constexpr size_t WS_WEND = al256(WS_S5A32 + 32 * 64 * 8);
constexpr size_t WS_X   = WS_WEND;
constexpr size_t WS_XB  = WS_X  + (size_t)NTOK * 1024 * 4;
constexpr size_t WS_XM  = WS_XB + (size_t)NTOK * 1024 * 2;
constexpr size_t WS_XMB = WS_XM + (size_t)NTOK * 1024 * 4;
constexpr size_t WS_R   = WS_XMB + (size_t)NTOK * 1024 * 2;
constexpr size_t WS_QT    = WS_R;
constexpr size_t WS_IDXQ  = WS_QT    + (size_t)NTOK * 1024 * 2;
constexpr size_t WS_BQKV  = WS_IDXQ  + (size_t)NTOK * 512 * 2;
constexpr size_t WS_BZ    = WS_BQKV  + (size_t)NTOK * 1536 * 2;
constexpr size_t WS_CUP   = WS_BZ    + (size_t)NTOK * 512 * 2;
constexpr size_t WS_GATES = WS_CUP   + (size_t)32 * 1024 * 640 * 2;
constexpr size_t WS_MISC  = WS_GATES + (size_t)NTOK * 3072 * 2;
constexpr size_t WS_CKV   = WS_MISC  + (size_t)NTOK * 256 * 4;
constexpr size_t WS_IDXK  = WS_CKV   + (size_t)NTOK * 128 * 2;
constexpr size_t WS_SEL   = WS_IDXK  + (size_t)NTOK * 64 * 2;
constexpr size_t WS_CTX   = WS_SEL   + (size_t)NTOK * 256 * 4;
constexpr size_t WS_YB    = WS_CTX   + (size_t)NTOK * 1024 * 2;
constexpr size_t WS_XLOC  = WS_YB    + (size_t)NTOK * 512 * 2;
constexpr size_t WS_YCPRE = WS_XLOC  + (size_t)32 * 1024 * 256 * 4;
constexpr size_t WS_YC    = WS_YCPRE + (size_t)NTOK * 512 * 2;
constexpr size_t WS_U     = WS_YC    + (size_t)NTOK * 512 * 2;
constexpr size_t WS_DNA   = WS_U;
constexpr size_t WS_DNB   = WS_DNA + (size_t)2048 * 128 * 128 * 2;
constexpr size_t WS_DNQ   = WS_DNB + (size_t)2048 * 128 * 128 * 4;
constexpr size_t WS_DNO   = WS_DNQ + (size_t)2048 * 64 * 128 * 2;
constexpr size_t WS_DNS   = WS_DNO + (size_t)2048 * 64 * 128 * 4;
constexpr size_t WS_UEND  = WS_DNS + (size_t)2048 * 128 * 128 * 2;
constexpr size_t WS_SCORES = WS_UEND;
constexpr size_t WS_MERGED = WS_U;
constexpr size_t WS_MERGEDB = WS_MERGED + (size_t)NTOK * 1024 * 4;
static_assert(WS_MERGEDB + (size_t)NTOK * 1024 * 2 <= WS_UEND, "union");
constexpr size_t WS_SCORES2 = WS_U;
static_assert((size_t)8192 * 8192 * 4 <= WS_UEND - WS_U, "scores2");
constexpr size_t WS_MIXEND = WS_SCORES + (size_t)8192 * 8192 * 4;
constexpr int MOE_ROWS = NTOK * 8 + 64 * 256;
constexpr int MOE_TILES = MOE_ROWS / 256;
constexpr size_t WS_RLOG  = WS_R;
constexpr size_t WS_TOPI  = WS_RLOG + (size_t)NTOK * 256 * 4;
constexpr size_t WS_TOPG  = WS_TOPI + (size_t)NTOK * 8 * 4;
constexpr size_t WS_TOPR  = WS_TOPG + (size_t)NTOK * 8 * 4;
constexpr size_t WS_SROW  = WS_TOPR + (size_t)NTOK * 8 * 4;
constexpr size_t WS_TEXP  = WS_SROW + (size_t)MOE_ROWS * 4;
constexpr size_t WS_EBASE = WS_TEXP + al256((MOE_TILES + 8) * 4);
constexpr size_t WS_HS    = al256(WS_EBASE + 256);
constexpr size_t WS_YS    = WS_HS + (size_t)(NTOK + MOE_ROWS) * 256 * 2;
constexpr size_t WS_MOEEND = WS_YS + (size_t)(NTOK + MOE_ROWS) * 1024 * 2;
constexpr size_t WS_TOTAL = WS_MIXEND > WS_MOEEND ? WS_MIXEND : WS_MOEEND;
static_assert(WS_TOTAL < (size_t)2040 * MB, "workspace budget");

constexpr int LDS_BYTES = 147456;

struct Params {
    const float* in[33];
    float* out;
    unsigned char* ws;
};
enum { I_X = 0, I_RELB, I_WIN, I_KVN, I_KVUP, I_BCONV, I_BALOG, I_BDTB, I_BONORM, I_CLRE, I_CLIM, I_CLOGDT, I_CBRE, I_CBIM, I_CCRE, I_CCIM, I_CD,
       I_GLUW, I_GLUB, I_WBRA, I_WBRB, I_WBRC, I_WO, I_LN1G, I_LN1B, I_RTW, I_RTB, I_EGU, I_EDN, I_SGU, I_SDN, I_LN2G, I_LN2B };

struct Ctx {
    LAS unsigned char* lds; int tid, lane, wave, wg, nwg;
};

template <class Map>
__device__ __forceinline__ void cvt_tile(const Ctx& c, const float* __restrict__ src, int ld, bf16_t* __restrict__ dst, int K, int n0, int k0, const Map& map) {
    LAS float* t = (LAS float*)c.lds;
    const int n = c.tid & 63, kq = c.tid >> 6;
    const int sc = map(n0 + n);
#pragma unroll
    for (int i = 0; i < 8; ++i) { const int k = i * 8 + kq; t[k * 65 + n] = sc >= 0 ? src[(size_t)(k0 + k) * ld + sc] : 0.f; }
    __syncthreads();
    { const int nn = c.tid >> 3, kc = (c.tid & 7) * 8; u32x4 w;
      w.x = cvt_pk_bf16(t[(kc + 0) * 65 + nn], t[(kc + 1) * 65 + nn]); w.y = cvt_pk_bf16(t[(kc + 2) * 65 + nn], t[(kc + 3) * 65 + nn]);
      w.z = cvt_pk_bf16(t[(kc + 4) * 65 + nn], t[(kc + 5) * 65 + nn]); w.w = cvt_pk_bf16(t[(kc + 6) * 65 + nn], t[(kc + 7) * 65 + nn]);
      *(u32x4*)(dst + (size_t)(n0 + nn) * K + k0 + kc) = w; }
    __syncthreads();
}
template <class Map>
__device__ __forceinline__ void cvt_tile4(const Ctx& c, const float* __restrict__ src, int ld, bf16_t* __restrict__ dst, int K, int n0, int k0, const Map& map) {
    LAS float* t = (LAS float*)c.lds;
    const int n = c.tid & 63, kq = c.tid >> 6;
    const int sc = map(n0 + n);
    float v[32];
#pragma unroll
    for (int i = 0; i < 32; ++i) { const int k = i * 8 + kq; v[i] = sc >= 0 ? src[(size_t)(k0 + k) * ld + sc] : 0.f; }
#pragma unroll
    for (int i = 0; i < 32; ++i) { const int k = i * 8 + kq; t[(k >> 6) * (64 * 65) + (k & 63) * 65 + n] = v[i]; }
    __syncthreads();
    { const int nn = c.tid >> 3, kc = (c.tid & 7) * 8;
#pragma unroll
      for (int sb = 0; sb < 4; ++sb) { const LAS float* tt = t + sb * (64 * 65); u32x4 w;
        w.x = cvt_pk_bf16(tt[(kc + 0) * 65 + nn], tt[(kc + 1) * 65 + nn]); w.y = cvt_pk_bf16(tt[(kc + 2) * 65 + nn], tt[(kc + 3) * 65 + nn]);
        w.z = cvt_pk_bf16(tt[(kc + 4) * 65 + nn], tt[(kc + 5) * 65 + nn]); w.w = cvt_pk_bf16(tt[(kc + 6) * 65 + nn], tt[(kc + 7) * 65 + nn]);
        *(u32x4*)(dst + (size_t)(n0 + nn) * K + k0 + sb * 64 + kc) = w; } }
    __syncthreads();
}
struct MapIdent { __device__ int operator()(int n) const { return n; } };
struct MapLimit { int lim; __device__ int operator()(int n) const { return n < lim ? n : -1; } };
struct MapWin {
    __device__ int operator()(int n) const {
        if (n < 512) return 640 + n;
        if (n < 2048) return 1224 + (n - 512);
        if (n < 2560) return 2760 + (n - 2048);
        if (n < 3072) return 3280 + (n - 2560);
        if (n < 6144) return 3792 + (n - 3072);
        if (n < 6272) return 512 + (n - 6144);
        if (n < 6336) return 1152 + (n - 6272);
        if (n < 6344) return 1216 + (n - 6336);
        if (n < 6348) return 3272 + (n - 6344);
        if (n < 6352) return 3276 + (n - 6348);
        return -1;
    }
};
struct MapGU { __device__ int operator()(int n) const { const int j = n >> 8, p = n & 255; return p < 128 ? 128 * j + p : 256 + 128 * j + (p - 128); } };

__device__ __forceinline__ void sincos_rev(float phi, float& s, float& c) {
    float r = phi * 0.15915494309189535f; r -= rintf(r);
    s = __builtin_amdgcn_sinf(r); c = __builtin_amdgcn_cosf(r);
}

template <class Map>
__device__ __forceinline__ void cvt_direct(const Ctx& c, const float* __restrict__ src, int ld, bf16_t* __restrict__ dst, int K, int n0, int k0, const Map& map) {
    const int kb = (c.tid >> 6) * 8, n4 = (c.tid & 63) * 4; const int sc = map(n0 + n4);
    f32x4 v[8];
#pragma unroll
    for (int i = 0; i < 8; ++i) v[i] = *(const f32x4*)(src + (size_t)(k0 + kb + i) * ld + sc);
#pragma unroll
    for (int q = 0; q < 4; ++q) { u32x4 w; w.x = cvt_pk_bf16(v[0][q], v[1][q]); w.y = cvt_pk_bf16(v[2][q], v[3][q]); w.z = cvt_pk_bf16(v[4][q], v[5][q]); w.w = cvt_pk_bf16(v[6][q], v[7][q]);
        *(u32x4*)(dst + (size_t)(n0 + n4 + q) * K + k0 + kb) = w; }
}
constexpr int P0X_JOBS = 2080 + 1040;
__device__ __forceinline__ void phase_p0_experts(const Ctx& c, const Params& P, int l) {
    unsigned char* ws = P.ws; unsigned* ctr = (unsigned*)(ws + WS_CTL + 20480) + 64 * l;
    LAS int* slot = (LAS int*)(c.lds + 70000);
    for (;;) {
        if (c.tid == 0) slot[0] = (int)atomicAdd(ctr, 1u);
        __syncthreads();
        const int q0 = __builtin_amdgcn_readfirstlane(slot[0]);
        if (q0 >= P0X_JOBS) break;
        __syncthreads();
        if (q0 < 2080) { const int e = q0 >> 5, r = q0 & 31, nt = r >> 4, kt = r & 15;
            const float* src = e < 64 ? P.in[I_EGU] + ((size_t)l * 64 + e) * 1024 * 512 : P.in[I_SGU] + (size_t)l * 1024 * 512;
            cvt_direct(c, src, 512, (bf16_t*)(ws + WS_WGU) + (size_t)e * 512 * 1024, 1024, nt * 256, kt * 64, MapGU()); }
        else { const int q = q0 - 2080, e = q >> 4, nt = (q >> 2) & 3, kt = q & 3;
            const float* src = e < 64 ? P.in[I_EDN] + ((size_t)l * 64 + e) * 256 * 1024 : P.in[I_SDN] + (size_t)l * 256 * 1024;
            cvt_direct(c, src, 1024, (bf16_t*)(ws + WS_WDN) + (size_t)e * 1024 * 256, 256, nt * 256, kt * 64, MapIdent()); }
    }
    __syncthreads();
}
__device__ __forceinline__ void phase_p0(const Ctx& c, const Params& P, int l) {
    unsigned char* ws = P.ws;
    constexpr int J0 = 400, J1 = J0 + 32, J2 = J1 + 32, J3 = J2 + 64, J4 = J3 + 16, J5 = J4 + 16;
    for (int j = c.wg; j < J5; j += c.nwg) {
        if (j < J0) { const int nt = j >> 2, kt = j & 3;
            cvt_tile4(c, P.in[I_WIN] + (size_t)l * 1024 * D_IN, D_IN, (bf16_t*)(ws + WS_WIN) + (size_t)1024 * 1024, 1024, nt * 64, kt * 256, MapWin()); }
        else if (j < J1) { const int q = j - J0, nt = q >> 1, kt = q & 1;
            cvt_tile4(c, P.in[I_WBRB] + (size_t)l * 512 * 1024, 1024, (bf16_t*)(ws + WS_WBRB), 512, nt * 64, kt * 256, MapIdent()); }
        else if (j < J2) { const int q = j - J1, nt = q >> 1, kt = q & 1;
            cvt_tile4(c, P.in[I_WBRC] + (size_t)l * 512 * 1024, 1024, (bf16_t*)(ws + WS_WBRC), 512, nt * 64, kt * 256, MapIdent()); }
        else if (j < J3) { const int q = j - J2, nt = q >> 2, kt = q & 3;
            cvt_tile4(c, P.in[I_WO] + (size_t)l * 1024 * 1024, 1024, (bf16_t*)(ws + WS_WO), 1024, nt * 64, kt * 256, MapIdent()); }
        else if (j < J4) { const int q = j - J3, nt = q >> 1, kt = q & 1;
            cvt_tile4(c, P.in[I_GLUW] + (size_t)l * 512 * 512, 512, (bf16_t*)(ws + WS_WGLU), 512, nt * 64, kt * 256, MapIdent()); }
        else if (j < J5) { const int q = j - J4, nt = q >> 2, kt = q & 3; MapLimit m; m.lim = 64;
            cvt_tile4(c, P.in[I_RTW] + (size_t)l * 1024 * 64, 64, (bf16_t*)(ws + WS_WRT), 1024, nt * 64, kt * 256, m); }
    }
    {
        LAS float* tA = (LAS float*)c.lds;
        LAS float* tB = tA + 64 * 65;
        const float* kvup = P.in[I_KVUP] + (size_t)l * 128 * 1024;
        for (int j = c.wg; j < 256; j += c.nwg) {
            const int h = (j & 127) >> 4, blk = j & 15;
            if (j < 128) {
                const float* win = P.in[I_WIN] + (size_t)l * 1024 * D_IN;
                for (int i = c.tid; i < 64 * 64; i += 512) { const int dm = i >> 6, e = i & 63; tA[dm * 65 + e] = win[(size_t)(blk * 64 + dm) * D_IN + h * 64 + e]; }
                for (int i = c.tid; i < 128 * 64; i += 512) { const int r = i >> 6, e = i & 63; tB[r * 65 + e] = kvup[(size_t)r * 1024 + h * 64 + e]; }
                __syncthreads();
#pragma unroll
                for (int it = 0; it < 2; ++it) { const int o = c.tid + it * 512, r = o >> 3, d8 = (o & 7) * 8; float a[8];
#pragma unroll
                    for (int q = 0; q < 8; ++q) a[q] = 0.f;
                    for (int e = 0; e < 64; ++e) { const float b = tB[r * 65 + e];
#pragma unroll
                        for (int q = 0; q < 8; ++q) a[q] += tA[(d8 + q) * 65 + e] * b; }
                    u32x4 w; w.x = cvt_pk_bf16(a[0], a[1]); w.y = cvt_pk_bf16(a[2], a[3]); w.z = cvt_pk_bf16(a[4], a[5]); w.w = cvt_pk_bf16(a[6], a[7]);
                    *(u32x4*)((bf16_t*)(ws + WS_WIN) + (size_t)(h * 128 + r) * 1024 + blk * 64 + d8) = w; }
                __syncthreads();
            } else {
                const float* wbr = P.in[I_WBRA] + (size_t)l * 512 * 1024;
                for (int i = c.tid; i < 64 * 64; i += 512) { const int e = i >> 6, cc = i & 63; tA[cc * 65 + e] = wbr[(size_t)(h * 64 + e) * 1024 + blk * 64 + cc]; }
                for (int i = c.tid; i < 128 * 64; i += 512) { const int r = i >> 6, e = i & 63; tB[r * 65 + e] = kvup[(size_t)r * 1024 + 512 + h * 64 + e]; }
                __syncthreads();
#pragma unroll
                for (int it = 0; it < 2; ++it) { const int o = c.tid + it * 512, cc = o >> 4, r8 = (o & 15) * 8; float a[8];
#pragma unroll
                    for (int q = 0; q < 8; ++q) a[q] = 0.f;
                    for (int e = 0; e < 64; ++e) { const float b = tA[cc * 65 + e];
#pragma unroll
                        for (int q = 0; q < 8; ++q) a[q] += tB[(r8 + q) * 65 + e] * b; }
                    u32x4 w; w.x = cvt_pk_bf16(a[0], a[1]); w.y = cvt_pk_bf16(a[2], a[3]); w.z = cvt_pk_bf16(a[4], a[5]); w.w = cvt_pk_bf16(a[6], a[7]);
                    *(u32x4*)((bf16_t*)(ws + WS_WBRA) + (size_t)(blk * 64 + cc) * 1024 + h * 128 + r8) = w; }
                __syncthreads();
            }
        }
    }
    for (int g = c.wg; g < 32; g += c.nwg) {
        LAS float* AP = (LAS float*)c.lds;
        LAS float* BB = AP + 33 * 128;
        LAS float* CC = BB + 64 * 32;
        LAS float* KT = CC + 16 * 128;
        const float dt = __expf(P.in[I_CLOGDT][l * 32 + g]);
        if (c.tid < 64) { const int p = c.tid;
            const float lr = P.in[I_CLRE][(l * 32 + g) * 64 + p], li = P.in[I_CLIM][(l * 32 + g) * 64 + p];
            const float mag = __expf(lr * dt); float sn, cs; sincos_rev(li * dt, sn, cs);
            const float are = mag * cs, aim = mag * sn, den = lr * lr + li * li;
            const float fre = ((are - 1.0f) * lr + aim * li) / den, fim = (aim * lr - (are - 1.0f) * li) / den;
            float pr = 1.f, pi = 0.f;
            for (int k = 0; k <= 32; ++k) { AP[(k * 64 + p) * 2] = pr; AP[(k * 64 + p) * 2 + 1] = pi; const float nr = pr * are - pi * aim, ni = pr * aim + pi * are; pr = nr; pi = ni; }
            ((float*)(ws + WS_S5A32))[(g * 64 + p) * 2] = AP[(32 * 64 + p) * 2]; ((float*)(ws + WS_S5A32))[(g * 64 + p) * 2 + 1] = AP[(32 * 64 + p) * 2 + 1];
            for (int j = 0; j < 16; ++j) { const float br = P.in[I_CBRE][((size_t)(l * 32 + g) * 64 + p) * 16 + j], bi = P.in[I_CBIM][((size_t)(l * 32 + g) * 64 + p) * 16 + j];
                BB[(p * 16 + j) * 2] = fre * br - fim * bi; BB[(p * 16 + j) * 2 + 1] = fre * bi + fim * br; }
        }
        for (int i = c.tid; i < 16 * 64; i += 512) { const int ii = i >> 6, p = i & 63;
            CC[i * 2] = P.in[I_CCRE][((size_t)(l * 32 + g) * 16 + ii) * 64 + p]; CC[i * 2 + 1] = P.in[I_CCIM][((size_t)(l * 32 + g) * 16 + ii) * 64 + p]; }
        __syncthreads();
        for (int o = c.tid; o < 32 * 256; o += 512) { const int tau = o >> 8, i = (o >> 4) & 15, j = o & 15; float s = 0.f;
            for (int p = 0; p < 64; ++p) { const float cr = CC[(i * 64 + p) * 2], ci = CC[(i * 64 + p) * 2 + 1], ar = AP[(tau * 64 + p) * 2], ai = AP[(tau * 64 + p) * 2 + 1];
                const float xr = cr * ar - ci * ai, xi = cr * ai + ci * ar; s += xr * BB[(p * 16 + j) * 2] - xi * BB[(p * 16 + j) * 2 + 1]; }
            if (tau == 0 && i == j) s += P.in[I_CD][(l * 32 + g) * 16 + i];
            KT[o] = s; }
        __syncthreads();
        bf16_t* TF = (bf16_t*)(ws + WS_S5TF) + (size_t)g * 512 * 640;
        for (int o = c.tid; o < 512 * 80; o += 512) { const int n = o / 80, k8 = (o % 80) * 8, tp = n >> 4, i = n & 15; float v[8];
            if (k8 < 512) { const int sp = k8 >> 4, j0 = k8 & 15;
#pragma unroll
                for (int q = 0; q < 8; ++q) v[q] = tp >= sp ? KT[(tp - sp) * 256 + i * 16 + j0 + q] : 0.f; }
            else { const int p0 = (k8 - 512) >> 1;
#pragma unroll
                for (int q = 0; q < 4; ++q) { const int p = p0 + q; const float cr = CC[(i * 64 + p) * 2], ci = CC[(i * 64 + p) * 2 + 1], ar = AP[((tp + 1) * 64 + p) * 2], ai = AP[((tp + 1) * 64 + p) * 2 + 1];
                    v[2 * q] = cr * ar - ci * ai; v[2 * q + 1] = -(cr * ai + ci * ar); } }
            u32x4 w; w.x = cvt_pk_bf16(v[0], v[1]); w.y = cvt_pk_bf16(v[2], v[3]); w.z = cvt_pk_bf16(v[4], v[5]); w.w = cvt_pk_bf16(v[6], v[7]);
            *(u32x4*)(TF + (size_t)n * 640 + k8) = w; }
        bf16_t* EE = (bf16_t*)(ws + WS_S5E) + (size_t)g * 256 * 512;
        for (int o = c.tid; o < 256 * 64; o += 512) { const int n = o >> 6, k8 = (o & 63) * 8; float v[8];
            if (n < 128) { const int p = n >> 1, cpx = n & 1, sp = k8 >> 4, j0 = k8 & 15; const float ar = AP[((31 - sp) * 64 + p) * 2], ai = AP[((31 - sp) * 64 + p) * 2 + 1];
#pragma unroll
                for (int q = 0; q < 8; ++q) { const float br = BB[(p * 16 + j0 + q) * 2], bi = BB[(p * 16 + j0 + q) * 2 + 1]; v[q] = cpx ? (ar * bi + ai * br) : (ar * br - ai * bi); } }
            else {
#pragma unroll
                for (int q = 0; q < 8; ++q) v[q] = 0.f; }
            u32x4 w; w.x = cvt_pk_bf16(v[0], v[1]); w.y = cvt_pk_bf16(v[2], v[3]); w.z = cvt_pk_bf16(v[4], v[5]); w.w = cvt_pk_bf16(v[6], v[7]);
            *(u32x4*)(EE + (size_t)n * 512 + k8) = w; }
        __syncthreads();
    }
}

struct SchedPlain {
    int nM, nN, nwg, G, c, K; const char* Bt;
    __device__ __forceinline__ void init(int M, int N, int K_, const void* Bt_, int G_, int c_) { nM = M / 256; nN = N / 256; nwg = nM * nN; G = G_; c = c_; K = K_; Bt = (const char*)Bt_; }
    __device__ __forceinline__ bool next(int i, Unit& u) const {
        const long L = (long)i * G + c; if (L >= nwg) return false;
        int wgid = (int)L; { const int q = nwg / 8, r = nwg % 8, xcd = wgid % 8, off = wgid / 8; wgid = (xcd < r ? xcd * (q + 1) : r * (q + 1) + (xcd - r) * q) + off; }
        const int nig = 8 * nN, gid = wgid / nig, fm = gid * 8, gsz = (nM - fm) < 8 ? (nM - fm) : 8;
        u.pm = fm + ((wgid % nig) % gsz); u.pn = (wgid % nig) / gsz; return true;
    }
    static constexpr bool GATHER = false;
    __device__ __forceinline__ int a_ld() const { return K; }
    __device__ __forceinline__ size_t a_tile_off(const Unit& u) const { return (size_t)u.pm * 256 * K * 2; }
    __device__ __forceinline__ unsigned a_row_off(const Unit& u, int r) const { return 0u; }
    __device__ __forceinline__ const char* b_ptr(const Unit& u) const { return Bt + (size_t)u.pn * 256 * K * 2; }
};
struct SchedGrouped {
    int nMg, nNg, ngr, nwg, G, c, K, lda; const char* Bt;
    __device__ __forceinline__ void init(int ngr_, int Mg, int Ng, int K_, const void* Bt_, int G_, int c_) { ngr = ngr_; nMg = Mg / 256; nNg = Ng / 256; nwg = ngr * nMg * nNg; G = G_; c = c_; K = K_; lda = K_; Bt = (const char*)Bt_; }
    __device__ __forceinline__ bool next(int i, Unit& u) const {
        const int L = i * G + c; if (L >= nwg) return false;
        const int per = nMg * nNg, g = L / per, r = L % per;
        u.pm = g * nMg + r / nNg; u.pn = g * nNg + r % nNg; return true;
    }
    static constexpr bool GATHER = false;
    __device__ __forceinline__ int a_ld() const { return lda; }
    __device__ __forceinline__ size_t a_tile_off(const Unit& u) const { return (size_t)u.pm * 256 * lda * 2; }
    __device__ __forceinline__ unsigned a_row_off(const Unit& u, int r) const { return 0u; }
    __device__ __forceinline__ const char* b_ptr(const Unit& u) const { return Bt + (size_t)u.pn * 256 * K * 2; }
};
#define EPI_LOOP_BEGIN \
    _Pragma("unroll") for (int ai = 0; ai < 2; ++ai) _Pragma("unroll") for (int m = 0; m < 4; ++m) { const int r = ai * 128 + wr * 64 + m * 16 + fr; \
    _Pragma("unroll") for (int bj = 0; bj < 2; ++bj) { const int c8 = bj * 128 + wc * 32 + fq * 8; const f32x4 v0 = acc[ai][bj][m][0], v1 = acc[ai][bj][m][1];
#define EPI_LOOP_END } asm volatile("" ::: "memory"); }
__device__ __forceinline__ u32x4 pack8(const f32x4 a, const f32x4 b) { u32x4 w; w.x = cvt_pk_bf16(a[0], a[1]); w.y = cvt_pk_bf16(a[2], a[3]); w.z = cvt_pk_bf16(b[0], b[1]); w.w = cvt_pk_bf16(b[2], b[3]); return w; }
__device__ __forceinline__ void unpack8(const u32x4 w, f32x4& a, f32x4& b) { a = (f32x4){bflo(w.x), bfhi(w.x), bflo(w.y), bfhi(w.y)}; b = (f32x4){bflo(w.z), bfhi(w.z), bflo(w.w), bfhi(w.w)}; }

struct EpiWin {
    static constexpr bool PERM = true;
    unsigned char* ws;
    __device__ __forceinline__ void operator()(const f32x4 (&acc)[2][2][4][2], const Unit& u, int wr, int wc, int fr, int fq) const {
        asm volatile("" : "+v"(fr), "+v"(fq));
        const int pn = u.pn; const int row0 = u.pm * 256;
        if (pn == 28) {
            float* M = (float*)(ws + WS_MISC);
            EPI_LOOP_BEGIN
                float* p = M + (size_t)(row0 + r) * 256 + c8; *(f32x4*)p = v0; *(f32x4*)(p + 4) = v1;
            EPI_LOOP_END
        } else if (pn == 14 || pn == 15) {
            bf16_t* C = (bf16_t*)(ws + WS_CUP);
            EPI_LOOP_BEGIN
                const int t = row0 + r, b = t >> 13, s = t & 8191, n = s >> 5, sp = s & 31, cc = (pn - 14) * 256 + c8, g = cc >> 4, j0 = cc & 15;
                *(u32x4*)(C + ((size_t)(g * 1024 + b * 256 + n) * 640) + sp * 16 + j0) = pack8(v0, v1);
            EPI_LOOP_END
        } else {
            bf16_t* base; int ld, ct;
            if (pn < 4) { base = (bf16_t*)(ws + WS_QT); ld = 1024; ct = pn; }
            else if (pn < 6) { base = (bf16_t*)(ws + WS_IDXQ); ld = 512; ct = pn - 4; }
            else if (pn < 12) { base = (bf16_t*)(ws + WS_BQKV); ld = 1536; ct = pn - 6; }
            else if (pn < 14) { base = (bf16_t*)(ws + WS_BZ); ld = 512; ct = pn - 12; }
            else { base = (bf16_t*)(ws + WS_GATES); ld = 3072; ct = pn - 16; }
            EPI_LOOP_BEGIN
                __builtin_nontemporal_store(pack8(v0, v1), (u32x4*)(base + (size_t)(row0 + r) * ld + ct * 256 + c8));
            EPI_LOOP_END
        }
    }
};
struct EpiBf16 {
    static constexpr bool PERM = true;
    bf16_t* O; int ld;
    __device__ __forceinline__ void operator()(const f32x4 (&acc)[2][2][4][2], const Unit& u, int wr, int wc, int fr, int fq) const {
        asm volatile("" : "+v"(fr), "+v"(fq));
        EPI_LOOP_BEGIN
            *(u32x4*)(O + (size_t)(u.pm * 256 + r) * ld + u.pn * 256 + c8) = pack8(v0, v1);
        EPI_LOOP_END
    }
};
struct EpiF32 {
    static constexpr bool PERM = true;
    float* O; int ld;
    __device__ __forceinline__ void operator()(const f32x4 (&acc)[2][2][4][2], const Unit& u, int wr, int wc, int fr, int fq) const {
        asm volatile("" : "+v"(fr), "+v"(fq));
        EPI_LOOP_BEGIN
            float* p = O + (size_t)(u.pm * 256 + r) * ld + u.pn * 256 + c8; *(f32x4*)p = v0; *(f32x4*)(p + 4) = v1;
        EPI_LOOP_END
    }
};
template <int MODE> struct EpiMerge {
    static constexpr bool PERM = true;
    float* Mf; bf16_t* Mb; const bf16_t* gates; int gcol0;
    __device__ __forceinline__ void operator()(const f32x4 (&acc)[2][2][4][2], const Unit& u, int wr, int wc, int fr, int fq) const {
        asm volatile("" : "+v"(fr), "+v"(fq));
        EPI_LOOP_BEGIN
            const size_t row = (size_t)(u.pm * 256 + r); const int col = u.pn * 256 + c8;
            const u32x4 gw = *(const u32x4*)(gates + row * 3072 + gcol0 + col); f32x4 g0, g1; unpack8(gw, g0, g1);
#pragma unroll
            for (int q = 0; q < 4; ++q) { g0[q] = sigmoidf_(g0[q]); g1[q] = sigmoidf_(g1[q]); }
            f32x4 a = v0 * g0, b = v1 * g1; bf16_t* p = Mb + row * 1024 + col;
            if (MODE != 0) { f32x4 m0, m1; unpack8(*(const u32x4*)p, m0, m1); a += m0; b += m1; }
            *(u32x4*)p = pack8(a, b);
        EPI_LOOP_END
    }
};
struct SchedMergeBC : SchedPlain {
    size_t offB, offC; const char* BtB; const char* BtC;
    __device__ __forceinline__ bool next(int i, Unit& u) const {
        Unit t; if (!SchedPlain::next(i >> 1, t)) return false;
        u.pm = t.pm; u.pn = (i & 1) * 4 + t.pn; return true;
    }
    __device__ __forceinline__ size_t a_tile_off(const Unit& u) const { return ((u.pn >> 2) ? offC : offB) + (size_t)u.pm * 256 * 512 * 2; }
    __device__ __forceinline__ const char* b_ptr(const Unit& u) const { return ((u.pn >> 2) ? BtC : BtB) + (size_t)(u.pn & 3) * 256 * 512 * 2; }
};
struct EpiMergeBC {
    static constexpr bool PERM = true;
    bf16_t* Mb; const bf16_t* gates;
    __device__ __forceinline__ void operator()(const f32x4 (&acc)[2][2][4][2], const Unit& u, int wr, int wc, int fr, int fq) const {
        asm volatile("" : "+v"(fr), "+v"(fq));
        const int gcol0 = 1024 + 1024 * (u.pn >> 2), pn = u.pn & 3;
        EPI_LOOP_BEGIN
            const size_t row = (size_t)(u.pm * 256 + r); const int col = pn * 256 + c8;
            const u32x4 gw = *(const u32x4*)(gates + row * 3072 + gcol0 + col); f32x4 g0, g1; unpack8(gw, g0, g1);
#pragma unroll
            for (int q = 0; q < 4; ++q) { g0[q] = sigmoidf_(g0[q]); g1[q] = sigmoidf_(g1[q]); }
            f32x4 a = v0 * g0, b = v1 * g1; bf16_t* p = Mb + row * 1024 + col;
            { f32x4 m0, m1; unpack8(*(const u32x4*)p, m0, m1); a += m0; b += m1; }
            *(u32x4*)p = pack8(a, b);
        EPI_LOOP_END
    }
};
struct EpiResid {
    static constexpr bool PERM = true;
    const bf16_t* XB; float* O;
    __device__ __forceinline__ void operator()(const f32x4 (&acc)[2][2][4][2], const Unit& u, int wr, int wc, int fr, int fq) const {
        asm volatile("" : "+v"(fr), "+v"(fq));
        EPI_LOOP_BEGIN
            const size_t o = (size_t)(u.pm * 256 + r) * 1024 + u.pn * 256 + c8;
            f32x4 x0, x1; unpack8(*(const u32x4*)(XB + o), x0, x1);
            *(f32x4*)(O + o) = x0 * DN_ALPHA + v0; *(f32x4*)(O + o + 4) = x1 * DN_ALPHA + v1;
        EPI_LOOP_END
    }
};
struct EpiGlu {
    static constexpr bool PERM = true;
    const bf16_t* Y; const float* bias; bf16_t* O;
    __device__ __forceinline__ void operator()(const f32x4 (&acc)[2][2][4][2], const Unit& u, int wr, int wc, int fr, int fq) const {
        asm volatile("" : "+v"(fr), "+v"(fq));
        EPI_LOOP_BEGIN
            const size_t o = (size_t)(u.pm * 256 + r) * 512 + u.pn * 256 + c8; const int col = u.pn * 256 + c8;
            f32x4 y0, y1; unpack8(*(const u32x4*)(Y + o), y0, y1);
            const f32x4 b0 = *(const f32x4*)(bias + col), b1 = *(const f32x4*)(bias + col + 4); f32x4 a, b;
#pragma unroll
            for (int q = 0; q < 4; ++q) { a[q] = y0[q] * sigmoidf_(v0[q] + b0[q]); b[q] = y1[q] * sigmoidf_(v1[q] + b1[q]); }
            *(u32x4*)(O + o) = pack8(a, b);
        EPI_LOOP_END
    }
};
__device__ __forceinline__ float gelu_f(float v) {
    const float av = fabsf(v), t = __builtin_amdgcn_rcpf(av * 0.2316418882f + 1.0f);
    float q = t * 0.5307027145f + (-0.7265760135f); q = q * t + 0.7107068705f; q = q * t + (-0.142248368f); q = q * t + 0.127414796f; q = q * t;
    const float e = __builtin_amdgcn_exp2f((v * v) * (-0.72134752044f));
    const float mm = v * (q * e); return v < 0.f ? mm : v - mm;
}
struct EpiS5 {
    static constexpr bool PERM = true;
    bf16_t* O;
    __device__ __forceinline__ void operator()(const f32x4 (&acc)[2][2][4][2], const Unit& u, int wr, int wc, int fr, int fq) const {
        asm volatile("" : "+v"(fr), "+v"(fq));
        const int g = u.pm >> 2, rb = (u.pm & 3) * 256, cb = (u.pn & 1) * 256;
        EPI_LOOP_BEGIN
            const int rr = rb + r, b = rr >> 8, n = rr & 255, cc = cb + c8, tp = cc >> 4, i0 = cc & 15; f32x4 a, bb;
#pragma unroll
            for (int q = 0; q < 4; ++q) { a[q] = gelu_f(v0[q]); bb[q] = gelu_f(v1[q]); }
            *(u32x4*)(O + (size_t)(b * 8192 + n * 32 + tp) * 512 + g * 16 + i0) = pack8(a, bb);
        EPI_LOOP_END
    }
};
struct EpiXloc {
    static constexpr bool PERM = true;
    float* O;
    __device__ __forceinline__ void operator()(const f32x4 (&acc)[2][2][4][2], const Unit& u, int wr, int wc, int fr, int fq) const {
        asm volatile("" : "+v"(fr), "+v"(fq));
        EPI_LOOP_BEGIN
            float* p = O + (size_t)(u.pm * 256 + r) * 256 + c8; *(f32x4*)p = v0; *(f32x4*)(p + 4) = v1;
        EPI_LOOP_END
    }
};
struct EpiGU {
    static constexpr bool PERM = true;
    bf16_t* HS;
    __device__ __forceinline__ void operator()(const f32x4 (&acc)[2][2][4][2], const Unit& u, int wr, int wc, int fr, int fq) const {
        asm volatile("" : "+v"(fr), "+v"(fq));
#pragma unroll
        for (int ai = 0; ai < 2; ++ai)
#pragma unroll
            for (int m = 0; m < 4; ++m) { const int r = ai * 128 + wr * 64 + m * 16 + fr; const int c8 = wc * 32 + fq * 8; f32x4 a, b;
                const f32x4 g0 = acc[ai][0][m][0], g1 = acc[ai][0][m][1], u0 = acc[ai][1][m][0], u1 = acc[ai][1][m][1];
#pragma unroll
                for (int q = 0; q < 4; ++q) { a[q] = siluf_(g0[q]) * u0[q]; b[q] = siluf_(g1[q]) * u1[q]; }
                __builtin_nontemporal_store(pack8(a, b), (u32x4*)(HS + (size_t)(u.pm * 256 + r) * 256 + (u.pn & 1) * 128 + c8)); }
    }
};
struct EpiDown {
    static constexpr bool PERM = true;
    bf16_t* YS;
    __device__ __forceinline__ void operator()(const f32x4 (&acc)[2][2][4][2], const Unit& u, int wr, int wc, int fr, int fq) const {
        asm volatile("" : "+v"(fr), "+v"(fq));
        EPI_LOOP_BEGIN
            __builtin_nontemporal_store(pack8(v0, v1), (u32x4*)(YS + (size_t)(u.pm * 256 + r) * 1024 + (u.pn & 3) * 256 + c8));
        EPI_LOOP_END
    }
};
struct SchedGU {
    const int* texp; const int* srow; int ntiles, G, c; const char* Bt;
    __device__ __forceinline__ bool next(int i, Unit& u) const {
        const int L = i * G + c, pm = ((L >> 4) << 3) | (L & 7); if (pm >= 128 + ntiles) return false;
        const int e = pm < 128 ? 64 : __builtin_amdgcn_readfirstlane(texp[pm - 128]);
        u.pm = pm; u.pn = e * 2 + ((L >> 3) & 1); return true;
    }
    static constexpr bool GATHER = true;
    __device__ __forceinline__ int a_ld() const { return 1024; }
    __device__ __forceinline__ size_t a_tile_off(const Unit& u) const { return 0; }
    __device__ __forceinline__ unsigned a_row_off(const Unit& u, int r) const {
        const int tok = u.pm < 128 ? u.pm * 256 + r : srow[(u.pm - 128) * 256 + r];
        return (unsigned)tok * 2048u;
    }
    __device__ __forceinline__ const char* b_ptr(const Unit& u) const { return Bt + (size_t)u.pn * 256 * 1024 * 2; }
};
struct SchedDown {
    const int* texp; int ntiles, G, c; const char* Bt;
    __device__ __forceinline__ bool next(int i, Unit& u) const {
        const int L = i * G + c, pm = ((L >> 5) << 3) | (L & 7); if (pm >= 128 + ntiles) return false;
        const int e = pm < 128 ? 64 : __builtin_amdgcn_readfirstlane(texp[pm - 128]);
        u.pm = pm; u.pn = e * 4 + ((L >> 3) & 3); return true;
    }
    static constexpr bool GATHER = false;
    __device__ __forceinline__ int a_ld() const { return 256; }
    __device__ __forceinline__ size_t a_tile_off(const Unit& u) const { return (size_t)u.pm * 256 * 512; }
    __device__ __forceinline__ unsigned a_row_off(const Unit& u, int r) const { return 0u; }
    __device__ __forceinline__ const char* b_ptr(const Unit& u) const { return Bt + (size_t)u.pn * 256 * 256 * 2; }
};

__device__ __forceinline__ void phase_load_x(const Ctx& c, const Params& P) {
    const float* x = P.in[I_X]; float* X = (float*)(P.ws + WS_X); bf16_t* XB = (bf16_t*)(P.ws + WS_XB);
    const size_t n8 = (size_t)NTOK * 1024 / 8;
    for (size_t i = (size_t)c.wg * 512 + c.tid; i < n8; i += (size_t)c.nwg * 512) {
        const f32x4 a = *(const f32x4*)(x + i * 8), b = *(const f32x4*)(x + i * 8 + 4);
        *(u32x4*)(XB + i * 8) = pack8(a, b);
    }
}
__device__ __forceinline__ void phase_ln(const Ctx& c, const float* in, const float* g, const float* bta, float* outF, bf16_t* outB) {
    const int gw = c.wg * 8 + c.wave, nw = c.nwg * 8;
    f32x4 gg[4], bb[4];
#pragma unroll
    for (int q = 0; q < 4; ++q) { gg[q] = *(const f32x4*)(g + q * 256 + c.lane * 4); bb[q] = *(const f32x4*)(bta + q * 256 + c.lane * 4); }
    for (int row = gw; row < NTOK; row += nw) {
        const float* p = in + (size_t)row * 1024; f32x4 v[4]; float s = 0.f;
#pragma unroll
        for (int q = 0; q < 4; ++q) { v[q] = *(const f32x4*)(p + q * 256 + c.lane * 4); s += (v[q][0] + v[q][1]) + (v[q][2] + v[q][3]); }
        const float mu = wave_sum(s) * (1.0f / 1024.0f); float qq = 0.f;
#pragma unroll
        for (int q = 0; q < 4; ++q) { const f32x4 d = v[q] - mu; qq += (d[0] * d[0] + d[1] * d[1]) + (d[2] * d[2] + d[3] * d[3]); }
        const float rs = rsqrtf(wave_sum(qq) * (1.0f / 1024.0f) + LN_EPS);
#pragma unroll
        for (int q = 0; q < 4; ++q) { const f32x4 o = (v[q] - mu) * rs * gg[q] + bb[q];
            if (outF) *(f32x4*)(outF + (size_t)row * 1024 + q * 256 + c.lane * 4) = o;
            u32x2 w; w.x = cvt_pk_bf16(o[0], o[1]); w.y = cvt_pk_bf16(o[2], o[3]); *(u32x2*)(outB + (size_t)row * 1024 + q * 256 + c.lane * 4) = w; }
    }
}
__device__ __forceinline__ void phase_kvnorm(const Ctx& c, const Params& P, int l) {
    const float* M = (const float*)(P.ws + WS_MISC); bf16_t* CKV = (bf16_t*)(P.ws + WS_CKV); bf16_t* IK = (bf16_t*)(P.ws + WS_IDXK);
    const float* g = P.in[I_KVN] + l * 128; const float g0 = g[c.lane * 2], g1 = g[c.lane * 2 + 1];
    const int gw = c.wg * 8 + c.wave, nw = c.nwg * 8;
    for (int t = gw; t < NTOK; t += nw) {
        const f32x2 v = *(const f32x2*)(M + (size_t)t * 256 + c.lane * 2);
        const float ms = wave_sum(v[0] * v[0] + v[1] * v[1]) * (1.0f / 128.0f); const float rs = rsqrtf(ms + RMS_EPS);
        *(unsigned*)(CKV + (size_t)t * 128 + c.lane * 2) = cvt_pk_bf16(v[0] * rs * g0, v[1] * rs * g1);
        const float k = M[(size_t)t * 256 + 128 + c.lane]; IK[(size_t)t * 64 + c.lane] = f2bf(k);
    }
}
__device__ __forceinline__ void phase_s5_carry(const Ctx& c, const Params& P, int wg0, int nwgs) {
    if (c.wg < wg0 || c.wg >= wg0 + nwgs) return;
    LAS float* SE = (LAS float*)c.lds;
    const float* XL = (const float*)(P.ws + WS_XLOC); bf16_t* CUP = (bf16_t*)(P.ws + WS_CUP); const float* A32 = (const float*)(P.ws + WS_S5A32);
    for (int task = c.wg - wg0; task < 128; task += nwgs) {
        const int b = task >> 5, g = task & 31, p = c.tid & 63, seg = c.tid >> 6;
        const float ar = A32[(g * 64 + p) * 2], ai = A32[(g * 64 + p) * 2 + 1];
        const size_t rowb = (size_t)g * 1024 + b * 256 + seg * 32;
        float Lr[32], Li[32]; float sr = 0.f, si = 0.f;
#pragma unroll
        for (int i = 0; i < 32; ++i) { Lr[i] = sr; Li[i] = si; const f32x2 x = *(const f32x2*)(XL + (rowb + i) * 256 + p * 2);
            const float nr = ar * sr - ai * si + x[0], ni = ar * si + ai * sr + x[1]; sr = nr; si = ni; }
        SE[(seg * 64 + p) * 2] = sr; SE[(seg * 64 + p) * 2 + 1] = si;
        float br = ar, bi = ai;
#pragma unroll
        for (int q = 0; q < 5; ++q) { const float nr = br * br - bi * bi, ni = 2.f * br * bi; br = nr; bi = ni; }
        __syncthreads();
        float xr = 0.f, xi = 0.f;
        for (int s = 0; s < seg; ++s) { const float er = SE[(s * 64 + p) * 2], ei = SE[(s * 64 + p) * 2 + 1]; const float nr = br * xr - bi * xi + er, ni = br * xi + bi * xr + ei; xr = nr; xi = ni; }
        float pr = 1.f, pi = 0.f;
#pragma unroll
        for (int i = 0; i < 32; ++i) { const float vr = pr * xr - pi * xi + Lr[i], vi = pr * xi + pi * xr + Li[i];
            *(unsigned*)(CUP + (rowb + i) * 640 + 512 + p * 2) = cvt_pk_bf16(vr, vi);
            const float nr = pr * ar - pi * ai, ni = pr * ai + pi * ar; pr = nr; pi = ni; }
        __syncthreads();
    }
}

__device__ __forceinline__ bf16x8 ldfragL(const LAS bf16_t* base, int stride, int row, int k0) { return *(const LAS bf16x8*)(base + row * stride + k0); }
__device__ __forceinline__ bf16x8 ldfragG(const bf16_t* base, int stride, int row, int k0) { return *(const bf16x8*)(base + (size_t)row * stride + k0); }
__device__ __forceinline__ f32x4 mfma16(bf16x8 a, bf16x8 b, f32x4 c) { return __builtin_amdgcn_mfma_f32_16x16x32_bf16(a, b, c, 0, 0, 0); }

#ifndef DBG_TID
#define DBG_TID 0
#endif
constexpr int DN_QS = 136, DN_TS = 72, DN_MS = 68;
constexpr int DL_QN = 0;
constexpr int DL_KN = DL_QN + 64 * DN_QS * 2;
constexpr int DL_KTBG = DL_KN + 128 * DN_TS * 2;
constexpr int DL_KTDEC = DL_KTBG + 128 * DN_TS * 2;
constexpr int DL_VTB = DL_KTDEC + 128 * DN_TS * 2;
constexpr int DL_MF = DL_VTB + 128 * DN_TS * 2;
constexpr int DL_QK = DL_MF + 128 * DN_TS * 2;
constexpr int DL_TB = DL_QK + 64 * DN_TS * 2;
constexpr int DL_SC = DL_TB + 64 * DN_TS * 2;
constexpr int DL_END = DL_SC + 5 * 64 * 4;
static_assert(64 * DN_MS * 4 <= 128 * DN_TS * 2 && 64 * DN_QS * 2 <= 128 * DN_TS * 2 && DL_END <= LDS_BYTES, "deltanet LDS map");

__device__ __forceinline__ void phase_dn_prep(const Ctx& c, const Params& P, int l) {
    LAS bf16_t* QN = (LAS bf16_t*)(c.lds + DL_QN); LAS bf16_t* KN = (LAS bf16_t*)(c.lds + DL_KN); LAS bf16_t* WT = KN;
    LAS bf16_t* KTBG = (LAS bf16_t*)(c.lds + DL_KTBG); LAS bf16_t* KTDEC = (LAS bf16_t*)(c.lds + DL_KTDEC); LAS bf16_t* VTB = (LAS bf16_t*)(c.lds + DL_VTB);
    LAS float* MF = (LAS float*)(c.lds + DL_MF); LAS bf16_t* UT = (LAS bf16_t*)(c.lds + DL_MF);
    LAS bf16_t* QK = (LAS bf16_t*)(c.lds + DL_QK); LAS bf16_t* TB = (LAS bf16_t*)(c.lds + DL_TB);
    LAS float* GC = (LAS float*)(c.lds + DL_SC); LAS float* BETA = GC + 64; LAS float* EGC = GC + 128; LAS float* EDEC = GC + 192; LAS float* GLAST = GC + 256;
    const bf16_t* BQKV = (const bf16_t*)(P.ws + WS_BQKV); const float* MISC = (const float*)(P.ws + WS_MISC);
    const float* conv = P.in[I_BCONV] + (size_t)l * 4 * 1536;
    const int lane = c.lane, w = c.wave, fr = lane & 15, fq = lane >> 4;
    for (int unit = c.wg; unit < 2048; unit += c.nwg) {
        const int b = unit >> 9, h = (unit >> 7) & 3, n = unit & 127;
        const size_t tok0 = (size_t)b * 8192 + n * 64;
        if (w == 0) {
            const float a = MISC[(tok0 + lane) * 256 + 200 + h], bb = MISC[(tok0 + lane) * 256 + 204 + h];
            const float xx = a + P.in[I_BDTB][l * 4 + h];
            const float sp = fmaxf(xx, 0.f) + log1pf(__expf(-fabsf(xx)));
            const float g = -__expf(P.in[I_BALOG][l * 4 + h]) * sp;
            float cs = g;
#pragma unroll
            for (int o = 1; o < 64; o <<= 1) { const float t = shf(cs, lane - o); if (lane >= o) cs += t; }
            const float last = shf(cs, 63);
            GC[lane] = cs; BETA[lane] = sigmoidf_(bb); EGC[lane] = __expf(cs); EDEC[lane] = __expf(last - cs); if (lane == 0) GLAST[0] = __expf(last);
        }
        __syncthreads();
        {
            float cw[3][4][2], hx[3][3][2];
#pragma unroll
            for (int s = 0; s < 3; ++s) { const int col = s * 512 + h * 128 + 2 * lane;
#pragma unroll
                for (int j = 0; j < 4; ++j) { cw[s][j][0] = conv[j * 1536 + col]; cw[s][j][1] = conv[j * 1536 + col + 1]; }
#pragma unroll
                for (int d = 0; d < 3; ++d) { const int pos = n * 64 + 8 * w - 3 + d; unsigned v = 0u;
                    if (pos >= 0) v = *(const unsigned*)(BQKV + ((size_t)b * 8192 + pos) * 1536 + col);
                    hx[s][d][0] = bflo(v); hx[s][d][1] = bfhi(v); } }
#pragma unroll
            for (int i = 0; i < 8; ++i) { const int t = 8 * w + i; float y[3][2];
#pragma unroll
                for (int s = 0; s < 3; ++s) { const int col = s * 512 + h * 128 + 2 * lane; const unsigned v = *(const unsigned*)(BQKV + (tok0 + t) * 1536 + col); const float c0 = bflo(v), c1 = bfhi(v);
                    const float z0 = cw[s][0][0] * hx[s][0][0] + cw[s][1][0] * hx[s][1][0] + cw[s][2][0] * hx[s][2][0] + cw[s][3][0] * c0;
                    const float z1 = cw[s][0][1] * hx[s][0][1] + cw[s][1][1] * hx[s][1][1] + cw[s][2][1] * hx[s][2][1] + cw[s][3][1] * c1;
                    y[s][0] = siluf_(z0); y[s][1] = siluf_(z1);
                    hx[s][0][0] = hx[s][1][0]; hx[s][0][1] = hx[s][1][1]; hx[s][1][0] = hx[s][2][0]; hx[s][1][1] = hx[s][2][1]; hx[s][2][0] = c0; hx[s][2][1] = c1; }
                const float rq = rsqrtf(wave_sum(y[0][0] * y[0][0] + y[0][1] * y[0][1]) + RMS_EPS) * 0.08838834764831845f;
                const float rk = rsqrtf(wave_sum(y[1][0] * y[1][0] + y[1][1] * y[1][1]) + RMS_EPS);
                const float q0 = y[0][0] * rq, q1 = y[0][1] * rq, k0 = y[1][0] * rk, k1 = y[1][1] * rk;
                const float bt = BETA[t], eg = EGC[t], ed = EDEC[t];
                *(LAS unsigned*)(QN + t * DN_QS + 2 * lane) = cvt_pk_bf16(q0, q1);
                *(LAS unsigned*)(KN + t * DN_QS + 2 * lane) = cvt_pk_bf16(k0, k1);
                KTBG[(2 * lane) * DN_TS + t] = f2bf(k0 * bt * eg); KTBG[(2 * lane + 1) * DN_TS + t] = f2bf(k1 * bt * eg);
                KTDEC[(2 * lane) * DN_TS + t] = f2bf(k0 * ed); KTDEC[(2 * lane + 1) * DN_TS + t] = f2bf(k1 * ed);
                VTB[(2 * lane) * DN_TS + t] = f2bf(y[2][0] * bt); VTB[(2 * lane + 1) * DN_TS + t] = f2bf(y[2][1] * bt);
            }
        }
        __syncthreads();
        {
            const int rt = w & 3; const bool isqk = w >= 4; const LAS bf16_t* Asrc = isqk ? QN : KN;
            bf16x8 af[4];
#pragma unroll
            for (int ks = 0; ks < 4; ++ks) af[ks] = ldfragL(Asrc, DN_QS, rt * 16 + fr, ks * 32 + fq * 8);
            for (int ct = 0; ct < 4; ++ct) {
                f32x4 acc = (f32x4){0.f, 0.f, 0.f, 0.f};
                if (ct <= rt) {
#pragma unroll
                    for (int ks = 0; ks < 4; ++ks) acc = mfma16(af[ks], ldfragL(KN, DN_QS, ct * 16 + fr, ks * 32 + fq * 8), acc);
                }
                const int j = ct * 16 + fr; const float gj = GC[j];
#pragma unroll
                for (int r = 0; r < 4; ++r) { const int i = rt * 16 + 4 * fq + r; const float dec = __expf(fminf(GC[i] - gj, 0.f));
                    if (isqk) QK[i * DN_TS + j] = f2bf(i >= j ? acc[r] * dec : 0.f);
                    else MF[i * DN_MS + j] = (i > j) ? BETA[i] * acc[r] * dec : 0.f; }
            }
        }
        __syncthreads();
        {
            LAS float* TF = (LAS float*)KN;
            LAS float* SW = (LAS float*)(c.lds + DL_END + 64) + w * 272;
            if (w < 4) {
                const int I = w; float t[16];
#pragma unroll
                for (int i = 0; i < 16; ++i) { float sacc = (i == fr) ? 1.f : 0.f;
#pragma unroll
                    for (int j = 0; j < i; ++j) sacc -= MF[(16 * I + i) * DN_MS + 16 * I + j] * t[j];
                    t[i] = sacc; }
                if (fq == 0) {
#pragma unroll
                    for (int i = 0; i < 16; ++i) { TF[(16 * I + i) * DN_MS + 16 * I + fr] = t[i]; TB[(16 * I + i) * DN_TS + 16 * I + fr] = f2bf(t[i]); } }
            } else {
                for (int e = (w - 4) * 64 + lane; e < 4096; e += 256) { const int i = e >> 6, j = e & 63; if ((j >> 4) > (i >> 4)) TB[i * DN_TS + j] = 0; }
            }
            __syncthreads();
#pragma unroll
            for (int d = 1; d < 4; ++d) {
                if (w < 4 - d) {
                    const int J = w, I = w + d; f32x4 acc = (f32x4){0.f, 0.f, 0.f, 0.f};
                    for (int K = J; K < I; ++K)
#pragma unroll
                        for (int ks = 0; ks < 4; ++ks) acc = __builtin_amdgcn_mfma_f32_16x16x4f32(MF[(16 * I + fr) * DN_MS + 16 * K + 4 * ks + fq], TF[(16 * K + 4 * ks + fq) * DN_MS + 16 * J + fr], acc, 0, 0, 0);
#pragma unroll
                    for (int r = 0; r < 4; ++r) SW[(4 * fq + r) * 17 + fr] = acc[r];
                    asm volatile("s_waitcnt lgkmcnt(0)" ::: "memory");
                    f32x4 acc2 = (f32x4){0.f, 0.f, 0.f, 0.f};
#pragma unroll
                    for (int ks = 0; ks < 4; ++ks) acc2 = __builtin_amdgcn_mfma_f32_16x16x4f32(TF[(16 * I + fr) * DN_MS + 16 * I + 4 * ks + fq], SW[(4 * ks + fq) * 17 + fr], acc2, 0, 0, 0);
#pragma unroll
                    for (int r = 0; r < 4; ++r) { TF[(16 * I + 4 * fq + r) * DN_MS + 16 * J + fr] = -acc2[r]; TB[(16 * I + 4 * fq + r) * DN_TS + 16 * J + fr] = f2bf(-acc2[r]); }
                }
                __syncthreads();
            }
        }
#if DBG_TID
        {
            LAS int* FL = (LAS int*)(c.lds + DL_END);
            if (c.tid == 0) FL[0] = 0;
            __syncthreads();
            int f = 0;
            auto bad16 = [](bf16_t v) { return (v & 0x7f80) == 0x7f80; };
            auto bad32 = [](float v) { return (__float_as_uint(v) & 0x7f800000u) == 0x7f800000u; };
            for (int i = c.tid; i < 64; i += 512) { if (bad32(GC[i]) || bad32(EGC[i]) || bad32(EDEC[i]) || bad32(BETA[i])) f |= 1; }
            for (int i = c.tid; i < 64 * 128; i += 512) { const int r = i >> 7, cc = i & 127; if (bad16(QN[r * DN_QS + cc])) f |= 2; }
            for (int i = c.tid; i < 128 * 64; i += 512) { const int r = i >> 6, cc = i & 63; if (bad16(KTBG[r * DN_TS + cc])) f |= 4; if (bad16(KTDEC[r * DN_TS + cc])) f |= 8; if (bad16(VTB[r * DN_TS + cc])) f |= 16; }
            for (int i = c.tid; i < 64 * 64; i += 512) { const int r = i >> 6, cc = i & 63; if (bad32(MF[r * DN_MS + cc])) f |= 32; if (bad16(QK[r * DN_TS + cc])) f |= 64; if (bad16(TB[r * DN_TS + cc])) f |= 128; }
            if (f) __hip_atomic_fetch_or(&FL[0], f, __ATOMIC_RELAXED, __HIP_MEMORY_SCOPE_WORKGROUP);
            __syncthreads();
        }
#endif
        {
#pragma unroll
            for (int q = 0; q < 8; ++q) { const int tile = w * 8 + q, which = tile >> 5, it = (tile >> 3) & 3, dt = tile & 7;
                const LAS bf16_t* Bsrc = which ? VTB : KTBG; f32x4 acc = (f32x4){0.f, 0.f, 0.f, 0.f};
#pragma unroll
                for (int ks = 0; ks < 2; ++ks) acc = mfma16(ldfragL(TB, DN_TS, it * 16 + fr, ks * 32 + fq * 8), ldfragL(Bsrc, DN_TS, dt * 16 + fr, ks * 32 + fq * 8), acc);
                LAS bf16_t* dst = (which ? UT : WT) + (dt * 16 + fr) * DN_TS + it * 16 + 4 * fq;
                u32x2 pk; pk.x = cvt_pk_bf16(acc[0], acc[1]); pk.y = cvt_pk_bf16(acc[2], acc[3]); *(LAS u32x2*)dst = pk; }
        }
        __syncthreads();
        {
            bf16_t* DNA = (bf16_t*)(P.ws + WS_DNA) + (size_t)unit * 128 * 128; float* DNB = (float*)(P.ws + WS_DNB) + (size_t)unit * 128 * 128;
            bf16_t* DNQ = (bf16_t*)(P.ws + WS_DNQ) + (size_t)unit * 64 * 128; float* DNO = (float*)(P.ws + WS_DNO) + (size_t)unit * 64 * 128;
            const float glast = GLAST[0];
            for (int q = 0; q < 24; ++q) { const int tile = w * 24 + q; f32x4 acc = (f32x4){0.f, 0.f, 0.f, 0.f};
                if (tile < 64) {
                    const int mt = tile >> 3, nt = tile & 7;
#pragma unroll
                    for (int ks = 0; ks < 2; ++ks) acc = mfma16(ldfragL(WT, DN_TS, mt * 16 + fr, ks * 32 + fq * 8), ldfragL(KTDEC, DN_TS, nt * 16 + fr, ks * 32 + fq * 8), acc);
                    const int d1 = nt * 16 + fr, d2 = mt * 16 + 4 * fq; float v[4];
#pragma unroll
                    for (int r = 0; r < 4; ++r) v[r] = ((d1 == d2 + r) ? glast : 0.f) - acc[r];
#if DBG_TID
                    { const float fl = (float)((LAS int*)(c.lds + DL_END))[0]; v[0] = fl; v[1] = fl; v[2] = fl; v[3] = fl; }
#endif
                    u32x2 pk; pk.x = cvt_pk_bf16(v[0], v[1]); pk.y = cvt_pk_bf16(v[2], v[3]); *(u32x2*)(DNA + (size_t)d1 * 128 + d2) = pk;
                } else if (tile < 128) {
                    const int tt = tile - 64, mt = tt >> 3, nt = tt & 7;
#pragma unroll
                    for (int ks = 0; ks < 2; ++ks) acc = mfma16(ldfragL(KTDEC, DN_TS, mt * 16 + fr, ks * 32 + fq * 8), ldfragL(UT, DN_TS, nt * 16 + fr, ks * 32 + fq * 8), acc);
                    *(f32x4*)(DNB + (size_t)(tt * 64 + lane) * 4) = acc;
                } else if (tile < 160) {
                    const int tt = tile - 128, mt = tt >> 2, nt = tt & 3;
#pragma unroll
                    for (int ks = 0; ks < 2; ++ks) acc = mfma16(ldfragL(WT, DN_TS, mt * 16 + fr, ks * 32 + fq * 8), ldfragL(QK, DN_TS, nt * 16 + fr, ks * 32 + fq * 8), acc);
                    const int i = nt * 16 + fr, d = mt * 16 + 4 * fq; const float eg = EGC[i];
                    const u32x2 qw = *(const LAS u32x2*)(QN + i * DN_QS + d);
                    u32x2 pk; pk.x = cvt_pk_bf16(bflo(qw.x) * eg - acc[0], bfhi(qw.x) * eg - acc[1]); pk.y = cvt_pk_bf16(bflo(qw.y) * eg - acc[2], bfhi(qw.y) * eg - acc[3]);
                    *(u32x2*)(DNQ + (size_t)i * 128 + d) = pk;
                } else {
                    const int tt = tile - 160, mt = tt >> 2, nt = tt & 3;
#pragma unroll
                    for (int ks = 0; ks < 2; ++ks) acc = mfma16(ldfragL(UT, DN_TS, mt * 16 + fr, ks * 32 + fq * 8), ldfragL(QK, DN_TS, nt * 16 + fr, ks * 32 + fq * 8), acc);
                    *(f32x4*)(DNO + (size_t)(tt * 64 + lane) * 4) = acc;
                }
            }
        }
        __syncthreads();
    }
}

__device__ __forceinline__ void phase_dn_scan(const Ctx& c, const Params& P, int nwgs) {
    if (c.wg >= nwgs) return;
    LAS bf16_t* ST = (LAS bf16_t*)c.lds;
    const int lane = c.lane, w = c.wave, fr = lane & 15, fq = lane >> 4;
    for (int task = c.wg; task < 64; task += nwgs) {
        const int bh = task >> 2, sl = task & 3;
        for (int i = c.tid; i < 2 * 32 * DN_QS / 2; i += 512) ((LAS unsigned*)ST)[i] = 0u;
        __syncthreads();
        const bf16_t* DNA = (const bf16_t*)(P.ws + WS_DNA) + (size_t)bh * 128 * 128 * 128; const float* DNB = (const float*)(P.ws + WS_DNB) + (size_t)bh * 128 * 128 * 128;
        bf16_t* DNS = (bf16_t*)(P.ws + WS_DNS) + (size_t)bh * 128 * 128 * 128;
        { const int dvl = fr + 16 * (w & 1), d1 = 32 * (w >> 1) + fq * 8;
          *(u32x4*)(DNS + (size_t)(sl * 32 + dvl) * 128 + d1) = (u32x4){0u, 0u, 0u, 0u}; }
        constexpr int PF = 4;
        bf16x8 af[PF][4]; f32x4 bi[PF][2];
#pragma unroll
        for (int p = 0; p < PF; ++p) {
#pragma unroll
            for (int ks = 0; ks < 4; ++ks) af[p][ks] = ldfragG(DNA + (size_t)p * 128 * 128, 128, w * 16 + fr, ks * 32 + fq * 8);
#pragma unroll
            for (int nt = 0; nt < 2; ++nt) bi[p][nt] = *(const f32x4*)(DNB + (size_t)p * 128 * 128 + (size_t)((w * 8 + sl * 2 + nt) * 64 + lane) * 4);
        }
#pragma unroll
        for (int n = 0; n < 127; ++n) {
            const int p = n % PF;
            const LAS bf16_t* cur = ST + (n & 1) * 32 * DN_QS; LAS bf16_t* nxt = ST + ((n + 1) & 1) * 32 * DN_QS;
            f32x4 acc[2] = {bi[p][0], bi[p][1]};
            bf16x8 a2[4];
#pragma unroll
            for (int ks = 0; ks < 4; ++ks) a2[ks] = af[p][ks];
            if (n + PF < 127) {
                const bf16_t* An = DNA + (size_t)(n + PF) * 128 * 128; const float* Bn = DNB + (size_t)(n + PF) * 128 * 128;
#pragma unroll
                for (int ks = 0; ks < 4; ++ks) af[p][ks] = ldfragG(An, 128, w * 16 + fr, ks * 32 + fq * 8);
#pragma unroll
                for (int nt = 0; nt < 2; ++nt) bi[p][nt] = *(const f32x4*)(Bn + (size_t)((w * 8 + sl * 2 + nt) * 64 + lane) * 4);
            }
            __builtin_amdgcn_sched_barrier(0);
#pragma unroll
            for (int nt = 0; nt < 2; ++nt)
#pragma unroll
                for (int ks = 0; ks < 4; ++ks) acc[nt] = mfma16(a2[ks], ldfragL(cur, DN_QS, nt * 16 + fr, ks * 32 + fq * 8), acc[nt]);
            bf16_t* Sg = DNS + (size_t)(n + 1) * 128 * 128;
#pragma unroll
            for (int nt = 0; nt < 2; ++nt) { u32x2 pk; pk.x = cvt_pk_bf16(acc[nt][0], acc[nt][1]); pk.y = cvt_pk_bf16(acc[nt][2], acc[nt][3]);
                *(LAS u32x2*)(nxt + (nt * 16 + fr) * DN_QS + w * 16 + 4 * fq) = pk;
                *(u32x2*)(Sg + (size_t)(sl * 32 + nt * 16 + fr) * 128 + w * 16 + 4 * fq) = pk; }
            asm volatile("s_waitcnt lgkmcnt(0)" ::: "memory"); __builtin_amdgcn_s_barrier(); asm volatile("" ::: "memory");
        }
        __syncthreads();
    }
}

__device__ __forceinline__ void phase_dn_out(const Ctx& c, const Params& P, int l) {
    const int lane = c.lane, fr = lane & 15, fq = lane >> 4;
    const bf16_t* BZ = (const bf16_t*)(P.ws + WS_BZ); bf16_t* YB = (bf16_t*)(P.ws + WS_YB); const float* gn = P.in[I_BONORM] + l * 128;
    for (int task = c.wg * 8 + c.wave; task < 2048 * 4; task += c.nwg * 8) {
        const int unit = task >> 2, it = task & 3, b = unit >> 9, h = (unit >> 7) & 3, n = unit & 127;
        const bf16_t* S = (const bf16_t*)(P.ws + WS_DNS) + (size_t)unit * 128 * 128; const bf16_t* Q = (const bf16_t*)(P.ws + WS_DNQ) + (size_t)unit * 64 * 128;
        const float* O = (const float*)(P.ws + WS_DNO) + (size_t)unit * 64 * 128;
        bf16x8 bq[4];
#pragma unroll
        for (int ks = 0; ks < 4; ++ks) bq[ks] = ldfragG(Q, 128, it * 16 + fr, ks * 32 + fq * 8);
        f32x4 acc[8]; float ss = 0.f;
#pragma unroll
        for (int mt = 0; mt < 8; ++mt) { acc[mt] = *(const f32x4*)(O + (size_t)((mt * 4 + it) * 64 + lane) * 4);
#pragma unroll
            for (int ks = 0; ks < 4; ++ks) acc[mt] = mfma16(ldfragG(S, 128, mt * 16 + fr, ks * 32 + fq * 8), bq[ks], acc[mt]);
            ss += (acc[mt][0] * acc[mt][0] + acc[mt][1] * acc[mt][1]) + (acc[mt][2] * acc[mt][2] + acc[mt][3] * acc[mt][3]); }
        ss += shf(ss, lane ^ 16); ss += shf(ss, lane ^ 32);
        const float rs = rsqrtf(ss * (1.0f / 128.0f) + RMS_EPS);
        const size_t tok = (size_t)b * 8192 + n * 64 + it * 16 + fr;
#pragma unroll
        for (int mt = 0; mt < 8; ++mt) { const int dv = mt * 16 + 4 * fq; const u32x2 zw = *(const u32x2*)(BZ + tok * 512 + h * 128 + dv); const f32x4 g4 = *(const f32x4*)(gn + dv);
            u32x2 pk; pk.x = cvt_pk_bf16(acc[mt][0] * rs * g4[0] * siluf_(bflo(zw.x)), acc[mt][1] * rs * g4[1] * siluf_(bfhi(zw.x)));
            pk.y = cvt_pk_bf16(acc[mt][2] * rs * g4[2] * siluf_(bflo(zw.y)), acc[mt][3] * rs * g4[3] * siluf_(bfhi(zw.y)));
            *(u32x2*)(YB + tok * 512 + h * 128 + dv) = pk; }
    }
}

__device__ __forceinline__ f32x16 mfma32(bf16x8 a, bf16x8 b, f32x16 c) { return __builtin_amdgcn_mfma_f32_32x32x16_bf16(a, b, c, 0, 0, 0); }

constexpr int IX_KS = 72;
__device__ __forceinline__ void phase_idx_scores(const Ctx& c, const Params& P, int b, size_t sc_off = WS_SCORES) {
    LAS bf16_t* KL = (LAS bf16_t*)c.lds;
    const bf16_t* IQ = (const bf16_t*)(P.ws + WS_IDXQ) + (size_t)b * 8192 * 512; const bf16_t* IK = (const bf16_t*)(P.ws + WS_IDXK) + (size_t)b * 8192 * 64;
    const float* MISC = (const float*)(P.ws + WS_MISC) + (size_t)b * 8192 * 256; float* SC = (float*)(P.ws + sc_off);
    const int lane = c.lane, w = c.wave, l31 = lane & 31, lh = lane >> 5;
    constexpr int NBLK = 64 * 65 / 2;
    const int blk0 = (int)((long)c.wg * NBLK / c.nwg), blk1 = (int)((long)(c.wg + 1) * NBLK / c.nwg);
    int qt = 0; while ((qt + 1) * (qt + 2) / 2 <= blk0) ++qt;
    int kb = blk0 - qt * (qt + 1) / 2;
    for (int blk = blk0; blk < blk1; ++blk) {
        LAS bf16_t* kl = KL + (blk & 1) * 128 * IX_KS;
        { const int key = c.tid >> 2, pc = c.tid & 3; const bf16_t* src = IK + (size_t)(kb * 128 + key) * 64 + pc * 16;
          const u32x4 a = *(const u32x4*)src, bq = *(const u32x4*)(src + 8);
          *(LAS u32x4*)(kl + key * IX_KS + pc * 16) = a; *(LAS u32x4*)(kl + key * IX_KS + pc * 16 + 8) = bq; }
        __syncthreads();
        for (int hp = 0; hp < 2; ++hp) {
            const int qlo = qt * 128 + w * 16 + hp * 8;
            bf16x8 af[2][4]; f32x2 wq2[2][8];
#pragma unroll
            for (int at = 0; at < 2; ++at) { const int qq = ((l31 >> 2) & 1) + 2 * (l31 >> 4), hd = (l31 & 3) + 4 * ((l31 >> 3) & 1);
#pragma unroll
                for (int ks = 0; ks < 4; ++ks) af[at][ks] = *(const bf16x8*)(IQ + (size_t)(qlo + 4 * at + qq) * 512 + hd * 64 + ks * 16 + lh * 8);
                const float* wp0 = MISC + (size_t)(qlo + 4 * at + lh) * 256 + 192; const float* wp1 = wp0 + 2 * 256;
                const f32x4 a0 = *(const f32x4*)wp0, a1 = *(const f32x4*)(wp0 + 4), b0 = *(const f32x4*)wp1, b1 = *(const f32x4*)(wp1 + 4);
#pragma unroll
                for (int q = 0; q < 4; ++q) { wq2[at][q] = (f32x2){a0[q], b0[q]}; wq2[at][4 + q] = (f32x2){a1[q], b1[q]}; } }
            for (int kt = 0; kt < 4; ++kt) {
                const int key0 = kb * 128 + kt * 32;
                if (key0 > qlo + 7) break;
                bf16x8 bf[4];
#pragma unroll
                for (int ks = 0; ks < 4; ++ks) bf[ks] = *(const LAS bf16x8*)(kl + (kt * 32 + l31) * IX_KS + ks * 16 + lh * 8);
#pragma unroll
                for (int at = 0; at < 2; ++at) {
                    f32x16 acc;
#pragma unroll
                    for (int q = 0; q < 16; ++q) acc[q] = 0.f;
#pragma unroll
                    for (int ks = 0; ks < 4; ++ks) acc = mfma32(af[at][ks], bf[ks], acc);
                    f32x2 s01 = (f32x2){0.f, 0.f};
#pragma unroll
                    for (int hd = 0; hd < 8; ++hd) { const f32x2 rl = (f32x2){fmaxf(acc[hd], 0.f), fmaxf(acc[8 + hd], 0.f)}; s01 = __builtin_elementwise_fma(wq2[at][hd], rl, s01); }
                    const int q0 = qlo + 4 * at + lh;
                    SC[(size_t)q0 * 8192 + key0 + l31] = s01[0]; SC[(size_t)(q0 + 2) * 8192 + key0 + l31] = s01[1];
                }
            }
        }
        ++kb; if (kb > qt) { kb = 0; ++qt; }
    }
    __syncthreads();
}

__device__ __forceinline__ unsigned ord_key(float v) { const unsigned bits = __float_as_uint(v + 0.0f); return bits ^ ((bits >> 31) ? 0xFFFFFFFFu : 0x80000000u); }
__device__ __forceinline__ int mbcnt64(unsigned long long m) { return (int)__builtin_amdgcn_mbcnt_hi((unsigned)(m >> 32), __builtin_amdgcn_mbcnt_lo((unsigned)m, 0u)); }
constexpr int SEL_CAP = 1024;
__device__ __forceinline__ void phase_select(const Ctx& c, const Params& P, int b, size_t sc_off = WS_SCORES) {
    const float* SC = (const float*)(P.ws + sc_off); int* SEL = (int*)(P.ws + WS_SEL) + (size_t)b * 8192 * 256;
    const int lane = c.lane;
    LAS unsigned* CU = (LAS unsigned*)(c.lds + c.wave * (SEL_CAP * 8)); LAS int* CI = (LAS int*)(CU + SEL_CAP);
    for (int t = c.wg * 8 + c.wave; t < 8192; t += c.nwg * 8) {
        int* out = SEL + (size_t)t * 256;
        if (t < 256) { for (int i = lane; i < 256; i += 64) out[i] = i <= t ? i : 0; continue; }
        const float* row = SC + (size_t)t * 8192; const int n = t + 1, ngrp = (n + 63) >> 6;
        unsigned tau0 = 1u; int ks = 0, msamp = 0; unsigned su[8];
        if (n > SEL_CAP) {
            msamp = 512;
#pragma unroll
            for (int q = 0; q < 8; ++q) { const int sidx = (int)(((long)(lane + 64 * q) * n) >> 9); su[q] = ord_key(row[sidx]); }
            ks = (int)((448l * 512 + n - 1) / n); if (ks < 1) ks = 1;
        }
        int C = 0; bool ok = false;
        for (int attempt = 0; attempt < 5 && !ok; ++attempt) {
            if (n > SEL_CAP) {
                unsigned prefix = 0u;
                for (int bit = 31; bit >= 0; --bit) { const unsigned cand = prefix | (1u << bit); int cnt = 0;
#pragma unroll
                    for (int q = 0; q < 8; ++q) cnt += __popcll(__ballot(su[q] >= cand));
                    if (cnt >= ks) prefix = cand; }
                tau0 = prefix;
            }
            C = 0; bool over = false;
            const int nv4 = (n + 255) >> 8;
            for (int g0 = 0; g0 < nv4; g0 += 16) {
                f32x4 v4[16];
#pragma unroll
                for (int k = 0; k < 16; ++k) { v4[k] = (f32x4){0.f, 0.f, 0.f, 0.f}; if (g0 + k < nv4) v4[k] = *(const f32x4*)(row + (g0 + k) * 256 + lane * 4); }
#pragma unroll
                for (int k = 0; k < 16; ++k) {
                    if (g0 + k < nv4) {
                        const int idx0 = (g0 + k) * 256 + lane * 4; unsigned uq[4]; bool f[4]; int pre = 0, tot = 0;
#pragma unroll
                        for (int q = 0; q < 4; ++q) { uq[q] = (idx0 + q <= t) ? ord_key(v4[k][q]) : 0u; f[q] = uq[q] >= tau0; const unsigned long long m = __ballot(f[q]); pre += mbcnt64(m); tot += __popcll(m); }
                        int pos = C + pre;
#pragma unroll
                        for (int q = 0; q < 4; ++q) { if (f[q]) { if (pos < SEL_CAP) { CU[pos] = uq[q]; CI[pos] = idx0 + q; } ++pos; } }
                        C += tot;
                    }
                }
            }
            over = C > SEL_CAP;
            if (over) { ks = ks > 1 ? ks >> 1 : 1; if (n <= SEL_CAP) break; }
            else if (C < 256) { ks = ks * 2 + 8; if (ks > msamp) ks = msamp; if (n <= SEL_CAP) break; }
            else ok = true;
        }
        asm volatile("s_waitcnt lgkmcnt(0)" ::: "memory");
        if (ok) {
            unsigned cu[16];
#pragma unroll
            for (int q = 0; q < 16; ++q) { const int ci = lane + 64 * q; cu[q] = ci < C ? CU[ci] : 0u; }
            unsigned prefix = 0u;
            for (int bit = 31; bit >= 0; --bit) { const unsigned cand = prefix | (1u << bit); int cnt = 0;
#pragma unroll
                for (int q = 0; q < 16; ++q) cnt += __popcll(__ballot(cu[q] >= cand));
                if (cnt >= 256) prefix = cand;
                if (cnt == 256) break; }
            int cgt = 0;
#pragma unroll
            for (int q = 0; q < 16; ++q) cgt += __popcll(__ballot(cu[q] > prefix));
            const int need_eq = 256 - cgt; int obase = 0, eqseen = 0;
#pragma unroll
            for (int q = 0; q < 16; ++q) { const bool gt = cu[q] > prefix, eq = cu[q] == prefix; const unsigned long long meq = __ballot(eq);
                const bool take = gt || (eq && (eqseen + mbcnt64(meq)) < need_eq); const unsigned long long mt = __ballot(take);
                if (take) out[obase + mbcnt64(mt)] = CI[lane + 64 * q];
                obase += __popcll(mt); eqseen += __popcll(meq); }
        } else {
            unsigned prefix = 0u;
            for (int bit = 31; bit >= 0; --bit) { const unsigned cand = prefix | (1u << bit); int cnt = 0;
                for (int g = 0; g < ngrp; ++g) { const int idx = g * 64 + lane; const unsigned u = idx <= t ? ord_key(row[idx]) : 0u; cnt += __popcll(__ballot(u >= cand)); }
                if (cnt >= 256) prefix = cand;
                if (cnt == 256) break; }
            int cgt = 0;
            for (int g = 0; g < ngrp; ++g) { const int idx = g * 64 + lane; const unsigned u = idx <= t ? ord_key(row[idx]) : 0u; cgt += __popcll(__ballot(u > prefix)); }
            const int need_eq = 256 - cgt; int obase = 0, eqseen = 0;
            for (int g = 0; g < ngrp; ++g) { const int idx = g * 64 + lane; const unsigned u = idx <= t ? ord_key(row[idx]) : 0u;
                const bool gt = u > prefix, eq = u == prefix; const unsigned long long meq = __ballot(eq);
                const bool take = gt || (eq && (eqseen + mbcnt64(meq)) < need_eq); const unsigned long long mt = __ballot(take);
                if (take) out[obase + mbcnt64(mt)] = idx;
                obase += __popcll(mt); eqseen += __popcll(meq); }
        }
    }
    __syncthreads();
}

__device__ __forceinline__ unsigned off_b(unsigned row, unsigned ch) { return 256u * row + 16u * (ch ^ (((row & 3u) << 2) | ((row >> 2) & 3u))); }
__device__ __forceinline__ unsigned rho_of(unsigned kap) { return (kap & 32u) | (((kap >> 2) & 3u) << 3) | (((kap >> 4) & 1u) << 2) | (kap & 3u); }
__device__ __forceinline__ void tr_read4(unsigned a0, unsigned a1, unsigned a2, unsigned a3, bf16x8& x, bf16x8& y) {
    u32x2 r0, r1, r2, r3;
    asm volatile("ds_read_b64_tr_b16 %0, %4\n\tds_read_b64_tr_b16 %1, %5\n\tds_read_b64_tr_b16 %2, %6\n\tds_read_b64_tr_b16 %3, %7\n\ts_waitcnt lgkmcnt(0)"
                 : "=&v"(r0), "=&v"(r1), "=&v"(r2), "=&v"(r3) : "v"(a0), "v"(a1), "v"(a2), "v"(a3) : "memory");
    u32x4 xx; xx.x = r0.x; xx.y = r0.y; xx.z = r1.x; xx.w = r1.y; u32x4 yy; yy.x = r2.x; yy.y = r2.y; yy.z = r3.x; yy.w = r3.y;
    x = __builtin_bit_cast(bf16x8, xx); y = __builtin_bit_cast(bf16x8, yy);
}
constexpr int AT_TILE = 16384, AT_WAVE = AT_TILE + 256, AT_BIAS = 8 * AT_WAVE;
__device__ __forceinline__ void phase_attn(const Ctx& c, const Params& P) {
    const int lane = c.lane, w = c.wave, fr = lane & 15, fq = lane >> 4;
    LAS unsigned char* tile = c.lds + w * AT_WAVE; LAS int* kidx = (LAS int*)(tile + AT_TILE); LAS float* BT = (LAS float*)(c.lds + AT_BIAS);
    const unsigned tile_a = (unsigned)(size_t)tile;
    for (int i = c.tid; i < 129 * 8; i += 512) { const int d = i >> 3, h = i & 7; int bk;
        if (d < 16) bk = d; else { const int lg = 16 + (int)(logf((float)d / 16.0f) / 2.0794415416798357f * 16.0f); bk = lg < 31 ? lg : 31; }
        BT[i] = P.in[I_RELB][bk * 8 + h]; }
    __syncthreads();
    const bf16_t* QT = (const bf16_t*)(P.ws + WS_QT); const bf16_t* CKV = (const bf16_t*)(P.ws + WS_CKV); const int* SEL = (const int*)(P.ws + WS_SEL); bf16_t* CTX = (bf16_t*)(P.ws + WS_CTX);
    for (int t = c.wg * 8 + w; t < NTOK; t += c.nwg * 8) {
        const int b = t >> 13, s = t & 8191, nsel = s + 1 < 256 ? s + 1 : 256;
        bf16x8 qf[4];
#pragma unroll
        for (int ks = 0; ks < 4; ++ks) { u32x4 z = (u32x4){0u, 0u, 0u, 0u}; if (fr < 8) z = *(const u32x4*)(QT + (size_t)t * 1024 + fr * 128 + ks * 32 + fq * 8); qf[ks] = __builtin_bit_cast(bf16x8, z); }
        f32x4 ctx[8];
#pragma unroll
        for (int cc = 0; cc < 8; ++cc) ctx[cc] = (f32x4){0.f, 0.f, 0.f, 0.f};
        float mrun = -1e30f, lrun = 0.f;
        int nidx = lane < nsel ? SEL[(size_t)t * 256 + lane] : 0;
        u32x4 pre[8]; bool havepre = false;
        for (int ch = 0; ch * 64 < nsel; ++ch) {
            const bool more = (ch + 1) * 64 < nsel; int nnext = 0;
            if (more) { const int slot = (ch + 1) * 64 + lane; nnext = slot < nsel ? SEL[(size_t)t * 256 + slot] : 0; }
            kidx[lane] = nidx;
            asm volatile("s_waitcnt lgkmcnt(0)" ::: "memory");
#pragma unroll
            for (int it = 0; it < 16; ++it) { const int kap = it * 4 + fq; u32x4 v;
                if (it < 8 && havepre) v = pre[it & 7];
                else { const int ki = kidx[kap]; v = *(const u32x4*)(CKV + ((size_t)b * 8192 + ki) * 128 + fr * 8); }
                *(LAS u32x4*)(tile + off_b(rho_of(kap), fr)) = v; }
            asm volatile("s_waitcnt vmcnt(0) lgkmcnt(0)" ::: "memory");
            f32x4 sc[4];
#pragma unroll
            for (int rb = 0; rb < 4; ++rb) { sc[rb] = (f32x4){0.f, 0.f, 0.f, 0.f};
#pragma unroll
                for (int ks = 0; ks < 4; ++ks) { const bf16x8 a = *(const LAS bf16x8*)(tile + off_b(rho_of(16 * rb + fr), 4 * ks + fq)); sc[rb] = mfma16(a, qf[ks], sc[rb]); } }
            if (more) {
#pragma unroll
                for (int it = 0; it < 8; ++it) { const int ki = shi(nnext, it * 4 + fq); pre[it] = *(const u32x4*)(CKV + ((size_t)b * 8192 + ki) * 128 + fr * 8); } }
            havepre = more; nidx = nnext;
            float mx = -1e30f;
#pragma unroll
            for (int rb = 0; rb < 4; ++rb)
#pragma unroll
                for (int r = 0; r < 4; ++r) { const int kap = 16 * rb + 4 * fq + r; const int slot = ch * 64 + kap; int dist = s - kidx[kap]; dist = dist < 0 ? 0 : (dist > 128 ? 128 : dist);
                    float lg = sc[rb][r] * 0.125f + BT[dist * 8 + (fr & 7)]; lg = slot < nsel ? lg : -1e30f; sc[rb][r] = lg; mx = fmaxf(mx, lg); }
            mx = fmaxf(mx, shf(mx, lane ^ 16)); mx = fmaxf(mx, shf(mx, lane ^ 32));
            const float mnew = fmaxf(mrun, mx), alpha = __expf(mrun - mnew); mrun = mnew;
            float ps = 0.f; bf16x8 pf[2];
            { float pv[16];
#pragma unroll
              for (int rb = 0; rb < 4; ++rb)
#pragma unroll
                  for (int r = 0; r < 4; ++r) { const float p = sc[rb][r] > -1e29f ? __expf(sc[rb][r] - mnew) : 0.f; pv[rb * 4 + r] = p; ps += p; }
#pragma unroll
              for (int kk = 0; kk < 2; ++kk) { u32x4 pk; pk.x = cvt_pk_bf16(pv[kk * 8 + 0], pv[kk * 8 + 1]); pk.y = cvt_pk_bf16(pv[kk * 8 + 2], pv[kk * 8 + 3]); pk.z = cvt_pk_bf16(pv[kk * 8 + 4], pv[kk * 8 + 5]); pk.w = cvt_pk_bf16(pv[kk * 8 + 6], pv[kk * 8 + 7]);
                  pf[kk] = __builtin_bit_cast(bf16x8, pk); } }
            lrun = lrun * alpha + ps;
            float ar[4];
#pragma unroll
            for (int r = 0; r < 4; ++r) ar[r] = shf(alpha, (4 * fq + r) & 15);
#pragma unroll
            for (int cc = 0; cc < 8; ++cc) { ctx[cc][0] *= ar[0]; ctx[cc][1] *= ar[1]; ctx[cc][2] *= ar[2]; ctx[cc][3] *= ar[3]; }
#pragma unroll
            for (int kk = 0; kk < 2; ++kk)
#pragma unroll
                for (int c2 = 0; c2 < 4; ++c2) { bf16x8 b0, b1;
                    const unsigned q = fr >> 2, p = fr & 3;
                    const unsigned r0 = 32 * kk + 8 * fq + q, r1 = r0 + 4;
                    const unsigned a00 = tile_a + off_b(r0, 2 * (2 * c2) + (p >> 1)) + 8 * (p & 1), a01 = tile_a + off_b(r1, 2 * (2 * c2) + (p >> 1)) + 8 * (p & 1);
                    const unsigned a10 = tile_a + off_b(r0, 2 * (2 * c2 + 1) + (p >> 1)) + 8 * (p & 1), a11 = tile_a + off_b(r1, 2 * (2 * c2 + 1) + (p >> 1)) + 8 * (p & 1);
                    tr_read4(a00, a01, a10, a11, b0, b1);
                    ctx[2 * c2] = mfma16(pf[kk], b0, ctx[2 * c2]); ctx[2 * c2 + 1] = mfma16(pf[kk], b1, ctx[2 * c2 + 1]); }
        }
        lrun += shf(lrun, lane ^ 16); lrun += shf(lrun, lane ^ 32);
        const float linv = 1.0f / lrun; float li[4];
#pragma unroll
        for (int r = 0; r < 4; ++r) li[r] = shf(linv, (4 * fq + r) & 15);
        if (fq < 2) {
#pragma unroll
            for (int cc = 0; cc < 8; ++cc)
#pragma unroll
                for (int r = 0; r < 4; ++r) CTX[(size_t)t * 1024 + (4 * fq + r) * 128 + cc * 16 + fr] = f2bf(ctx[cc][r] * li[r]);
        }
    }
    __syncthreads();
}

__device__ __forceinline__ void phase_route(const Ctx& c, const Params& P, int l) {
    LAS int* LC = (LAS int*)c.lds;
    LAS int* LB = LC + 64;
    LAS int* LR = LC + 128;
    LAS int* LE = LC + 128 + 1024;
    const float* RL = (const float*)(P.ws + WS_RLOG); int* TOPI = (int*)(P.ws + WS_TOPI); float* TOPG = (float*)(P.ws + WS_TOPG); int* TOPR = (int*)(P.ws + WS_TOPR);
    unsigned* gcnt = (unsigned*)(P.ws + WS_CTL + CTL_MOECNT) + l * 64;
    const int lane = c.lane; const float rb = P.in[I_RTB][l * 64 + lane];
    for (int blk = c.wg; blk < NTOK / 128; blk += c.nwg) {
        if (c.tid < 64) LC[c.tid] = 0;
        __syncthreads();
        for (int i = 0; i < 16; ++i) { const int lt = c.wave * 16 + i, tok = blk * 128 + lt;
            const float sc = sigmoidf_(RL[(size_t)tok * 256 + lane]); float key = sc + rb; float mys = 0.f; int mye = 0; float ssum = 0.f;
#pragma unroll
            for (int j = 0; j < 8; ++j) { const float mx = wave_max(key); const unsigned long long m = __ballot(key == mx); const int src = m ? __ffsll((long long)m) - 1 : j;
                const float s = shf(sc, src); ssum += s; if (lane == j) { mys = s; mye = src; } if (lane == src) key = -1e30f; }
            if (lane < 8) { const int lr = __hip_atomic_fetch_add(&LC[mye], 1, __ATOMIC_RELAXED, __HIP_MEMORY_SCOPE_WORKGROUP); LR[lt * 8 + lane] = lr; LE[lt * 8 + lane] = mye;
                TOPI[(size_t)tok * 8 + lane] = mye; TOPG[(size_t)tok * 8 + lane] = mys / ssum * 2.5f; }
        }
        __syncthreads();
        if (c.tid < 64) LB[c.tid] = (int)atomicAdd(&gcnt[c.tid], (unsigned)LC[c.tid]);
        __syncthreads();
        for (int i = c.tid; i < 1024; i += 512) TOPR[(size_t)blk * 1024 + i] = LB[LE[i]] + LR[i];
        __syncthreads();
    }
}
__device__ __forceinline__ void phase_moe_book(const Ctx& c, const Params& P, int l) {
    LAS int* EB = (LAS int*)c.lds;
    const unsigned* gcnt = (const unsigned*)(P.ws + WS_CTL + CTL_MOECNT) + l * 64;
    int* SROW = (int*)(P.ws + WS_SROW); int* TEXP = (int*)(P.ws + WS_TEXP); int* EBASE = (int*)(P.ws + WS_EBASE);
    const int* TOPI = (const int*)(P.ws + WS_TOPI); const int* TOPR = (const int*)(P.ws + WS_TOPR);
    if (c.tid == 0) { int acc = 0; for (int e = 0; e < 64; ++e) { const int cnt = (int)__hip_atomic_load(&gcnt[e], __ATOMIC_RELAXED, __HIP_MEMORY_SCOPE_AGENT); EB[e] = acc; EB[64 + e] = cnt; acc += (cnt + 255) & ~255; } EB[128] = acc; }
    __syncthreads();
    if (c.wg == 0) { if (c.tid < 64) EBASE[c.tid] = EB[c.tid]; if (c.tid == 64) TEXP[MOE_TILES] = EB[128] >> 8; }
    for (int e = c.wg; e < 64; e += c.nwg) { const int base = EB[e], cnt = EB[64 + e], pad = (cnt + 255) & ~255;
        for (int i = cnt + c.tid; i < pad; i += 512) SROW[base + i] = 0;
        for (int i = c.tid; i < (pad >> 8); i += 512) TEXP[(base >> 8) + i] = e; }
    for (int i = c.wg * 512 + c.tid; i < NTOK * 8; i += c.nwg * 512) SROW[EB[TOPI[i]] + TOPR[i]] = i >> 3;
    __syncthreads();
}
__device__ __forceinline__ void phase_combine(const Ctx& c, const Params& P, int l, float* outF, bf16_t* outB) {
    const bf16_t* XMB = (const bf16_t*)(P.ws + WS_XMB); const bf16_t* YS = (const bf16_t*)(P.ws + WS_YS);
    const int* TOPI = (const int*)(P.ws + WS_TOPI); const int* TOPR = (const int*)(P.ws + WS_TOPR); const float* TOPG = (const float*)(P.ws + WS_TOPG); const int* EBASE = (const int*)(P.ws + WS_EBASE);
    const float* g = P.in[I_LN2G] + l * 1024; const float* bt = P.in[I_LN2B] + l * 1024; const int lane = c.lane;
    for (int tok = c.wg * 8 + c.wave; tok < NTOK; tok += c.nwg * 8) {
        f32x4 v[4];
#pragma unroll
        for (int q = 0; q < 4; ++q) { const u32x2 xw = *(const u32x2*)(XMB + (size_t)tok * 1024 + q * 256 + lane * 4); const f32x4 x = (f32x4){bflo(xw.x), bfhi(xw.x), bflo(xw.y), bfhi(xw.y)}; const u32x2 sh = *(const u32x2*)(YS + (size_t)tok * 1024 + q * 256 + lane * 4);
            v[q] = x * DN_ALPHA + (f32x4){bflo(sh.x), bfhi(sh.x), bflo(sh.y), bfhi(sh.y)}; }
        for (int k = 0; k < 8; ++k) { const int e = TOPI[(size_t)tok * 8 + k]; const size_t row = (size_t)NTOK + EBASE[e] + TOPR[(size_t)tok * 8 + k]; const float gt = TOPG[(size_t)tok * 8 + k];
#pragma unroll
            for (int q = 0; q < 4; ++q) { const u32x2 y = *(const u32x2*)(YS + row * 1024 + q * 256 + lane * 4); v[q] += (f32x4){bflo(y.x), bfhi(y.x), bflo(y.y), bfhi(y.y)} * gt; } }
        float s = 0.f;
#pragma unroll
        for (int q = 0; q < 4; ++q) s += (v[q][0] + v[q][1]) + (v[q][2] + v[q][3]);
        const float mu = wave_sum(s) * (1.0f / 1024.0f); float qq = 0.f;
#pragma unroll
        for (int q = 0; q < 4; ++q) { const f32x4 d = v[q] - mu; qq += (d[0] * d[0] + d[1] * d[1]) + (d[2] * d[2] + d[3] * d[3]); }
        const float rs = rsqrtf(wave_sum(qq) * (1.0f / 1024.0f) + LN_EPS);
#pragma unroll
        for (int q = 0; q < 4; ++q) { const f32x4 o = (v[q] - mu) * rs * *(const f32x4*)(g + q * 256 + lane * 4) + *(const f32x4*)(bt + q * 256 + lane * 4);
            if (outF) *(f32x4*)(outF + (size_t)tok * 1024 + q * 256 + lane * 4) = o;
            if (outB) { u32x2 wv; wv.x = cvt_pk_bf16(o[0], o[1]); wv.y = cvt_pk_bf16(o[2], o[3]); *(u32x2*)(outB + (size_t)tok * 1024 + q * 256 + lane * 4) = wv; } }
    }
}

constexpr int LDS_PARAM_OFF = LDS_BYTES - 1024;
__device__ __forceinline__ Params ld_params(LAS unsigned char* lds) {
    unsigned a_s = (unsigned)(size_t)lds + LDS_PARAM_OFF; asm volatile("" : "+s"(a_s) :: "memory");
    unsigned a_ = a_s; asm volatile("" : "+v"(a_));
    Params P; const LAS unsigned* src = (const LAS unsigned*)(size_t)a_;
#pragma unroll
    for (int i = 0; i < 33; ++i) { const unsigned lo = __builtin_amdgcn_readfirstlane(src[2 * i]), hi = __builtin_amdgcn_readfirstlane(src[2 * i + 1]); P.in[i] = (const float*)(const __attribute__((address_space(1))) float*)(((unsigned long long)hi << 32) | lo); }
    { const unsigned lo = __builtin_amdgcn_readfirstlane(src[66]), hi = __builtin_amdgcn_readfirstlane(src[67]); P.out = (float*)(__attribute__((address_space(1))) float*)(((unsigned long long)hi << 32) | lo); }
    { const unsigned lo = __builtin_amdgcn_readfirstlane(src[68]), hi = __builtin_amdgcn_readfirstlane(src[69]); P.ws = (unsigned char*)(__attribute__((address_space(1))) unsigned char*)(((unsigned long long)hi << 32) | lo); }
    return P;
}
__device__ __forceinline__ Ctx fresh_ctx(LAS unsigned char* lds, int wave) {
    Ctx c; int t = wave * 64 + (int)__builtin_amdgcn_mbcnt_hi(~0u, __builtin_amdgcn_mbcnt_lo(~0u, 0u)); asm volatile("" : "+v"(t)); c.tid = t; c.lane = t & 63; c.wave = __builtin_amdgcn_readfirstlane(t >> 6); c.wg = blockIdx.x; c.nwg = gridDim.x; c.lds = lds; return c;
}
#ifndef MK_DUMP_OFF
#define MK_DUMP_OFF WS_DNA
#define MK_DUMP_BF16 1
#define MK_DUMP_LD 1024
#endif
__device__ __forceinline__ void dbg_dump(const Ctx& c, const Params& P) {
    const size_t n = (size_t)NTOK * 1024;
    for (size_t i = (size_t)c.wg * 512 + c.tid; i < n; i += (size_t)c.nwg * 512)
    { const size_t row = i >> 10, col = i & 1023, j = row * MK_DUMP_LD + col;
        P.out[i] = col >= MK_DUMP_LD ? 0.f : (MK_DUMP_BF16 ? bf2f(((const bf16_t*)(P.ws + MK_DUMP_OFF))[j]) : ((const float*)(P.ws + MK_DUMP_OFF))[j]); }
}
#ifndef DUP_SEL
#define DUP_SEL 1
#define DUP_PREP 1
#define DUP_ATTN 1
#define DUP_P0 1
#define DUP_SCAN 1
#define DUP_SCORES 1
#endif
#ifndef MK_STOP_AFTER
#define MK_STOP_AFTER 100000
#endif
__global__ void __launch_bounds__(512, 2) hybrid_fwd(Params Pk) {
    extern __shared__ __attribute__((aligned(16))) unsigned char shm[];
    Ctx c0; c0.lds = (LAS unsigned char*)shm; c0.tid = threadIdx.x; c0.lane = c0.tid & 63; c0.wave = __builtin_amdgcn_readfirstlane(c0.tid >> 6); c0.wg = blockIdx.x; c0.nwg = gridDim.x;
#define CX (fresh_ctx(c0.lds, c0.wave))
    LAS unsigned* barw = (LAS unsigned*)(c0.lds + LDS_BYTES - 16);
    if (c0.tid == 0) { barw[0] = 0u; barw[1] = 0u; barw[2] = 0u; barw[3] = 0u; }
    if (c0.tid < 35) { LAS unsigned long long* d = (LAS unsigned long long*)(c0.lds + LDS_PARAM_OFF); d[c0.tid] = c0.tid < 33 ? (unsigned long long)Pk.in[c0.tid] : (c0.tid == 33 ? (unsigned long long)Pk.out : (unsigned long long)Pk.ws); }
    __syncthreads();
    XcdBarrier bar = xcd_barrier_post((unsigned*)(Pk.ws + WS_CTL + CTL_BAR), (volatile LAS unsigned*)barw, c0.tid);
#define PP (ld_params((CX).lds))
#define WSP (PP.ws)
#define GBAR() xcd_barrier_ni(bar.bar, bar.x, (unsigned)(size_t)bar.st, (CX).tid)
    phase_load_x(CX, PP);
    phase_p0(CX, PP, 0);
    GBAR();
#define LAYER_BODY(l) {\
        { const Ctx cc = CX; SchedPlain S; S.init(NTOK, NIN, 1024, WSP + WS_WIN, cc.nwg, cc.wg); EpiWin E; E.ws = WSP; pg8::gemm_phase(cc.lds, cc.wave, (const char*)(WSP + WS_XB), 1024, S, E); } \
        GBAR(); if ((l) * 100 + 2 >= MK_STOP_AFTER) { dbg_dump(CX, PP); return; } \
        phase_kvnorm(CX, PP, l); \
        for (int d_ = 0; d_ < DUP_PREP; ++d_) phase_dn_prep(CX, PP, l); \
        { const Ctx cc = CX; SchedGrouped S; S.init(32, 1024, 256, 512, WSP + WS_S5E, cc.nwg, cc.wg); S.lda = 640; EpiXloc E; E.O = (float*)(WSP + WS_XLOC); pg8::gemm_phase(cc.lds, cc.wave, (const char*)(WSP + WS_CUP), 512, S, E); } \
        GBAR(); if ((l) * 100 + 3 >= MK_STOP_AFTER) { dbg_dump(CX, PP); return; } \
          \
        if (c0.nwg > 64) { \
            if (c0.wg < 64) phase_dn_scan(CX, PP, 64); \
            else { phase_s5_carry(CX, PP, 64, c0.nwg - 64); Ctx c2 = CX; c2.wg -= 64; c2.nwg -= 64; phase_idx_scores(c2, PP, 0); } \
        } else { phase_dn_scan(CX, PP, c0.nwg); phase_s5_carry(CX, PP, 0, c0.nwg); phase_idx_scores(CX, PP, 0); } \
        phase_p0_experts(CX, PP, l); \
        GBAR(); if ((l) * 100 + 4 >= MK_STOP_AFTER) { dbg_dump(CX, PP); return; } \
        phase_dn_out(CX, PP, l); \
        { const Ctx cc = CX; SchedGrouped S; S.init(32, 1024, 512, 640, WSP + WS_S5TF, cc.nwg, cc.wg); S.lda = 640; EpiS5 E; E.O = (bf16_t*)(WSP + WS_YCPRE); pg8::gemm_phase(cc.lds, cc.wave, (const char*)(WSP + WS_CUP), 640, S, E); } \
        phase_select(CX, PP, 0); \
        GBAR(); if ((l) * 100 + 5 >= MK_STOP_AFTER) { dbg_dump(CX, PP); return; } \
          \
        phase_idx_scores(CX, PP, 1, WS_SCORES2); \
        GBAR(); if ((l) * 100 + 6 >= MK_STOP_AFTER) { dbg_dump(CX, PP); return; } \
        phase_idx_scores(CX, PP, 2, WS_SCORES); phase_select(CX, PP, 1, WS_SCORES2); \
        GBAR(); if ((l) * 100 + 7 >= MK_STOP_AFTER) { dbg_dump(CX, PP); return; } \
        phase_idx_scores(CX, PP, 3, WS_SCORES2); phase_select(CX, PP, 2, WS_SCORES); \
        GBAR(); if ((l) * 100 + 7 >= MK_STOP_AFTER) { dbg_dump(CX, PP); return; } \
        phase_select(CX, PP, 3, WS_SCORES2); \
        GBAR(); if ((l) * 100 + 7 >= MK_STOP_AFTER) { dbg_dump(CX, PP); return; } \
        for (int d_ = 0; d_ < DUP_ATTN; ++d_) phase_attn(CX, PP); \
        { const Ctx cc = CX; SchedPlain S; S.init(NTOK, 512, 512, WSP + WS_WGLU, cc.nwg, cc.wg); EpiGlu E; E.Y = (const bf16_t*)(WSP + WS_YCPRE); E.bias = PP.in[I_GLUB] + l * 512; E.O = (bf16_t*)(WSP + WS_YC); \
          pg8::gemm_phase(cc.lds, cc.wave, (const char*)(WSP + WS_YCPRE), 512, S, E); } \
        GBAR(); if ((l) * 100 + 8 >= MK_STOP_AFTER) { dbg_dump(CX, PP); return; } \
        { const Ctx cc = CX; SchedPlain S; S.init(NTOK, 1024, 1024, WSP + WS_WBRA, cc.nwg, cc.wg); EpiMerge<0> E; E.Mf = (float*)(WSP + WS_MERGED); E.Mb = (bf16_t*)(WSP + WS_MERGEDB); E.gates = (const bf16_t*)(WSP + WS_GATES); E.gcol0 = 0; \
          pg8::gemm_phase(cc.lds, cc.wave, (const char*)(WSP + WS_CTX), 1024, S, E); } \
        { const Ctx cc = CX; SchedMergeBC S; S.init(NTOK, 1024, 512, WSP + WS_WBRB, cc.nwg, cc.wg); S.offB = WS_YB; S.offC = WS_YC; S.BtB = (const char*)(WSP + WS_WBRB); S.BtC = (const char*)(WSP + WS_WBRC); \
          EpiMergeBC E; E.Mb = (bf16_t*)(WSP + WS_MERGEDB); E.gates = (const bf16_t*)(WSP + WS_GATES); pg8::gemm_phase(cc.lds, cc.wave, (const char*)WSP, 512, S, E); } \
        GBAR(); if ((l) * 100 + 9 >= MK_STOP_AFTER) { dbg_dump(CX, PP); return; } \
        { const Ctx cc = CX; SchedPlain S; S.init(NTOK, 1024, 1024, WSP + WS_WO, cc.nwg, cc.wg); EpiResid E; E.XB = (const bf16_t*)(WSP + WS_XB); E.O = (float*)(WSP + WS_XM); pg8::gemm_phase(cc.lds, cc.wave, (const char*)(WSP + WS_MERGEDB), 1024, S, E); } \
        GBAR(); if ((l) * 100 + 10 >= MK_STOP_AFTER) { dbg_dump(CX, PP); return; } \
        phase_ln(CX, (const float*)(WSP + WS_XM), PP.in[I_LN1G] + l * 1024, PP.in[I_LN1B] + l * 1024, (float*)nullptr, (bf16_t*)(WSP + WS_XMB)); \
        GBAR(); if ((l) * 100 + 11 >= MK_STOP_AFTER) { dbg_dump(CX, PP); return; } \
        { const Ctx cc = CX; SchedPlain S; S.init(NTOK, 256, 1024, WSP + WS_WRT, cc.nwg, cc.wg); EpiF32 E; E.O = (float*)(WSP + WS_RLOG); E.ld = 256; pg8::gemm_phase(cc.lds, cc.wave, (const char*)(WSP + WS_XMB), 1024, S, E); } \
        GBAR(); if ((l) * 100 + 12 >= MK_STOP_AFTER) { dbg_dump(CX, PP); return; } \
        phase_route(CX, PP, l); \
        GBAR(); if ((l) * 100 + 13 >= MK_STOP_AFTER) { dbg_dump(CX, PP); return; } \
        phase_moe_book(CX, PP, l); if ((l) + 1 < DEPTH) phase_p0(CX, PP, (l) + 1); \
        GBAR(); if ((l) * 100 + 14 >= MK_STOP_AFTER) { dbg_dump(CX, PP); return; } \
        { const Ctx cc = CX; SchedGU S; S.texp = (const int*)(WSP + WS_TEXP); S.srow = (const int*)(WSP + WS_SROW); S.ntiles = __builtin_amdgcn_readfirstlane(S.texp[MOE_TILES]); S.G = cc.nwg; S.c = cc.wg; S.Bt = (const char*)(WSP + WS_WGU); \
          EpiGU E; E.HS = (bf16_t*)(WSP + WS_HS); pg8::gemm_phase(cc.lds, cc.wave, (const char*)(WSP + WS_XMB), 1024, S, E); } \
        GBAR(); if ((l) * 100 + 15 >= MK_STOP_AFTER) { dbg_dump(CX, PP); return; } \
        { const Ctx cc = CX; SchedDown S; S.texp = (const int*)(WSP + WS_TEXP); S.ntiles = __builtin_amdgcn_readfirstlane(S.texp[MOE_TILES]); S.G = cc.nwg; S.c = cc.wg; S.Bt = (const char*)(WSP + WS_WDN); \
          EpiDown E; E.YS = (bf16_t*)(WSP + WS_YS); pg8::gemm_phase(cc.lds, cc.wave, (const char*)(WSP + WS_HS), 256, S, E); } \
        GBAR(); if ((l) * 100 + 16 >= MK_STOP_AFTER) { dbg_dump(CX, PP); return; } \
        if (l == DEPTH - 1) phase_combine(CX, PP, l, PP.out, (bf16_t*)nullptr); \
        else phase_combine(CX, PP, l, (float*)nullptr, (bf16_t*)(WSP + WS_XB)); \
        GBAR(); if ((l) * 100 + 17 >= MK_STOP_AFTER) { dbg_dump(CX, PP); return; } \
    }
    LAYER_BODY(0) LAYER_BODY(1) LAYER_BODY(2) LAYER_BODY(3)
#undef GBAR
#undef CX
#undef PP
#undef WSP
}

extern "C" void kernel_launch(void* const* d_in, const int* in_sizes, int n_in, void* d_out, int out_size, void* d_ws, size_t ws_size, hipStream_t stream) {
    static int grid = 0;
    if (grid == 0) {
        if (n_in != 33 || ws_size < WS_TOTAL) { fprintf(stderr, "kernel_launch: expected 33 inputs and >= %zu bytes of workspace; got %d inputs, %zu bytes\n", (size_t)WS_TOTAL, n_in, ws_size); grid = -1; return; }
        int dev = 0, cus = 0, per_cu = 0;
        if (hipGetDevice(&dev) != hipSuccess || hipDeviceGetAttribute(&cus, hipDeviceAttributeMultiprocessorCount, dev) != hipSuccess) { grid = -1; return; }
        if (hipFuncSetAttribute((const void*)hybrid_fwd, hipFuncAttributeMaxDynamicSharedMemorySize, LDS_BYTES) != hipSuccess) { fprintf(stderr, "kernel_launch: hipFuncSetAttribute failed\n"); grid = -1; return; }
        if (hipOccupancyMaxActiveBlocksPerMultiprocessor(&per_cu, (const void*)hybrid_fwd, 512, LDS_BYTES) != hipSuccess || per_cu < 1) { fprintf(stderr, "kernel_launch: occupancy query says %d\n", per_cu); per_cu = 1; }
        (void)hipGetLastError();
        grid = cus;
    }
    if (grid < 0) return;
    if (hipMemsetAsync((char*)d_ws + WS_CTL, 0, CTL_BYTES, stream) != hipSuccess) return;
    Params p{};
    for (int i = 0; i < 33; ++i) p.in[i] = (const float*)d_in[i];
    p.out = (float*)d_out; p.ws = (unsigned char*)d_ws;
    hipLaunchKernelGGL(hybrid_fwd, dim3(grid), dim3(512), LDS_BYTES, stream, p);
}
```

```cpp
#include <hip/hip_runtime.h>
#include <stdint.h>
#include <stdio.h>

#define LAS __attribute__((address_space(3)))
typedef unsigned short bf16_t;
typedef short bf16x8 __attribute__((ext_vector_type(8)));
typedef float f32x4 __attribute__((ext_vector_type(4)));
typedef float f32x16 __attribute__((ext_vector_type(16)));
typedef float f32x2 __attribute__((ext_vector_type(2)));
typedef unsigned u32x4 __attribute__((ext_vector_type(4)));
typedef unsigned u32x2 __attribute__((ext_vector_type(2)));

constexpr int D_MODEL = 1024, BATCH = 4, SEQ = 8192, DEPTH = 4, NTOK = BATCH * SEQ;
constexpr int D_IN = 6864;
constexpr float DN_ALPHA = 1.681792830507429f;
constexpr float LN_EPS = 1e-5f, RMS_EPS = 1e-6f;
constexpr int NWG_THREADS = 512;

typedef __bf16 bf16x2_t __attribute__((ext_vector_type(2)));
__device__ __forceinline__ unsigned cvt_pk_bf16(float lo, float hi) { const f32x2 v = {lo, hi}; const bf16x2_t r = __builtin_convertvector(v, bf16x2_t); return __builtin_bit_cast(unsigned, r); }
__device__ __forceinline__ bf16_t f2bf(float f) { unsigned u = __float_as_uint(f); u += 0x7FFFu + ((u >> 16) & 1u); return (bf16_t)(u >> 16); }
__device__ __forceinline__ float bf2f(bf16_t b) { return __uint_as_float(((unsigned)b) << 16); }
__device__ __forceinline__ float bflo(unsigned w) { return __uint_as_float(w << 16); }
__device__ __forceinline__ float bfhi(unsigned w) { return __uint_as_float(w & 0xffff0000u); }
__device__ __forceinline__ float sigmoidf_(float x) { return 1.0f / (1.0f + __expf(-x)); }
__device__ __forceinline__ float siluf_(float x) { return x / (1.0f + __expf(-x)); }
__device__ __forceinline__ int lane_opq() { int l = (int)__builtin_amdgcn_mbcnt_hi(~0u, __builtin_amdgcn_mbcnt_lo(~0u, 0u)); asm volatile("" : "+v"(l)); return l; }
__device__ __forceinline__ float shf(float v, int src) { return __int_as_float(__builtin_amdgcn_ds_bpermute(src << 2, __float_as_int(v))); }
__device__ __forceinline__ int shi(int v, int src) { return __builtin_amdgcn_ds_bpermute(src << 2, v); }
__device__ __forceinline__ float wave_sum(float v) {
    const int l = lane_opq();
#pragma unroll
    for (int o = 32; o >= 1; o >>= 1) v += shf(v, l ^ o);
    return v;
}
__device__ __forceinline__ float wave_max(float v) {
    const int l = lane_opq();
#pragma unroll
    for (int o = 32; o >= 1; o >>= 1) v = fmaxf(v, shf(v, l ^ o));
    return v;
}

#define XB_TMO      128
#define XB_XCNT(j)  (256  + 64 * (j))
#define XB_XSUB(j)  (1280 + 64 * (j))
#define XB_XGEN(j)  (2304 + 64 * (j))
#define XB_TOP      3328
#define XB_TOPGEN   3392
#define XCD_BAR_WORDS 3456
#define XB_SPIN_CAP (1u << 18)

__device__ __forceinline__ unsigned xb_ld(unsigned* p)              { return __hip_atomic_load(p, __ATOMIC_RELAXED, __HIP_MEMORY_SCOPE_AGENT); }
__device__ __forceinline__ unsigned xb_add(unsigned* p, unsigned v) { return __hip_atomic_fetch_add(p, v, __ATOMIC_RELAXED, __HIP_MEMORY_SCOPE_AGENT); }
__device__ __forceinline__ unsigned xb_xcc_id() { return (unsigned)__builtin_amdgcn_s_getreg((3 << 11) | 20) & 0xFu; }
#define XB_SPIN(cond, bar) do { unsigned _sp = 0; while (cond) { __builtin_amdgcn_s_sleep(1); \
    if ((++_sp & 255u) == 0u) { if (xb_ld(&(bar)[XB_TMO])) break; if (_sp > XB_SPIN_CAP) { atomicAdd(&(bar)[XB_TMO], 1u); break; } } } } while (0)

struct XcdBarrier { unsigned* bar; unsigned x; volatile LAS unsigned* st; };

__device__ __forceinline__ XcdBarrier xcd_barrier_post(unsigned* bar, volatile LAS unsigned* st, int tid) {
    XcdBarrier b; b.bar = bar; b.x = xb_xcc_id(); b.st = st;
    if (tid == 0) (void)xb_add(&bar[XB_XCNT(b.x)], 1u);
    return b;
}
__device__ __forceinline__ void xcd_barrier_complete(unsigned* bar, unsigned x, unsigned& nloc, unsigned& nx) {
    const unsigned G = gridDim.x * gridDim.y * gridDim.z;
    unsigned sum, cnt, mine, sp = 0u;
    for (;;) {
        sum = 0u; cnt = 0u; mine = 0u;
#pragma unroll
        for (unsigned j = 0; j < 16; ++j) { const unsigned c = xb_ld(&bar[XB_XCNT(j)]); sum += c; cnt += (c > 0u) ? 1u : 0u; mine = (j == x) ? c : mine; }
        if (sum == G) break;
        __builtin_amdgcn_s_sleep(1);
        if ((++sp & 255u) == 0u) { if (xb_ld(&bar[XB_TMO])) break; if (sp > XB_SPIN_CAP) { atomicAdd(&bar[XB_TMO], 1u); break; } }
    }
    nloc = mine > 0u ? mine : 1u; nx = cnt > 0u ? cnt : 1u;
}
__device__ __noinline__ void xcd_barrier_ni(unsigned* bar_, unsigned x_, unsigned st_, int tid) {
    XcdBarrier b; b.bar = bar_; b.x = x_; b.st = (volatile LAS unsigned*)(size_t)st_;
    asm volatile("s_waitcnt vmcnt(0)" ::: "memory");
    __syncthreads();
    if (tid == 0) {
        unsigned* bar = b.bar;
        __builtin_amdgcn_s_waitcnt(0);
        unsigned nloc = b.st[0], nx = b.st[1];
        if (nloc == 0u) { xcd_barrier_complete(bar, b.x, nloc, nx); b.st[0] = nloc; b.st[1] = nx; }
        const unsigned old = xb_add(&bar[XB_XSUB(b.x)], 1u);
        const unsigned gen = old / nloc;
        if (old + 1u == (gen + 1u) * nloc) {
            __builtin_amdgcn_fence(__ATOMIC_RELEASE, "agent");
            asm volatile("s_waitcnt vmcnt(0)" ::: "memory");
            const unsigned og = xb_add(&bar[XB_TOP], 1u);
            const unsigned tg = og / nx;
            if (og + 1u == (tg + 1u) * nx) xb_add(&bar[XB_TOPGEN], 1u);
            else XB_SPIN(xb_ld(&bar[XB_TOPGEN]) == tg, bar);
            __builtin_amdgcn_fence(__ATOMIC_ACQUIRE, "agent");
            xb_add(&bar[XB_XGEN(b.x)], 1u);
            asm volatile("s_waitcnt vmcnt(0)" ::: "memory");
        } else {
            XB_SPIN(xb_ld(&bar[XB_XGEN(b.x)]) == gen, bar);
            __builtin_amdgcn_fence(__ATOMIC_ACQUIRE, "agent");
            asm volatile("s_waitcnt vmcnt(0)" ::: "memory");
        }
    }
    __syncthreads();
}

namespace pg8 {
#ifndef PG8_A_AUX
#define PG8_A_AUX 0
#endif
constexpr int BM = 256, BK = 64, HALF = 128, HTB = HALF * BK * 2, STAGE_BYTES = 8 * HTB;
__device__ __forceinline__ int lds_byte(int r, int c) { const int st = (r >> 4) * 2 + (c >> 5), rr = r & 15, cc = c & 31, ob = rr * 64 + cc * 2; return st * 1024 + (ob ^ (((ob >> 9) & 1) << 5)); }
__device__ __forceinline__ void stage_rc(int b, int& R, int& C) { const int st = b / 1024, sb = b % 1024, swz = sb ^ (((sb >> 9) & 1) << 5); R = (st >> 1) * 16 + swz / 64; C = (st & 1) * 32 + (swz % 64) / 2; }
__device__ __forceinline__ int perm32(int rho) { const int n = rho >> 4, i = rho & 15; return 8 * (i >> 2) + 4 * n + (i & 3); }
struct Unit { int pm, pn; };

template <class Epi, class Sched>
__device__ __forceinline__ void gemm_phase(LAS unsigned char* lds, const int wave_, const char* Abase, const int K, const Sched& S, const Epi& E) {
    int tid_ = wave_ * 64 + (int)__builtin_amdgcn_mbcnt_hi(~0u, __builtin_amdgcn_mbcnt_lo(~0u, 0u)); asm volatile("" : "+v"(tid_));
    const int tid = tid_, wid = __builtin_amdgcn_readfirstlane(tid >> 6), lane = tid & 63, wr = wid >> 2, wc = wid & 3, fr = lane & 15, fq = lane >> 4;
    const int nt = K / BK;
    int RA[2], CA[2]; unsigned voffB[2];
#pragma unroll
    for (int i = 0; i < 2; ++i) { int R, C; stage_rc(tid * 16 + i * 8192, R, C); const int Rb = Epi::PERM ? ((R & ~31) + perm32(R & 31)) : R;
        RA[i] = R; CA[i] = C * 2; voffB[i] = (unsigned)(Rb * K + C) * 2u; }
    const size_t kstep = (size_t)(BK * 2);
    const size_t hstep = (size_t)HALF * K * 2;
    const unsigned ldsw = (unsigned)wid * 1024u;
    const int aoff = lds_byte(wr * 64 + fr, fq * 8), boff = lds_byte(wc * 32 + fr, fq * 8);
#define PG8_SA(b, h) (((b) * 2 + (h)) * HTB)
#define PG8_SB(b, h) ((4 + (b) * 2 + (h)) * HTB)
#define PG8_STAGE(bufoff, gbase, voff) do { _Pragma("unroll") for (int _i = 0; _i < 2; ++_i) \
        __builtin_amdgcn_global_load_lds((const unsigned*)((const char*)(gbase) + (voff)[_i]), (LAS unsigned*)(lds + (bufoff) + ldsw + _i * 8192), 16, 0, 0); } while (0)
#define PG8_STAGEA(bufoff, base, offs, kb) do { _Pragma("unroll") for (int _i = 0; _i < 2; ++_i) \
        __builtin_amdgcn_global_load_lds((const unsigned*)((base) + (size_t)(offs)[_i] + (size_t)(kb)), (LAS unsigned*)(lds + (bufoff) + ldsw + _i * 8192), 16, 0, PG8_A_AUX); } while (0)
#define PG8_LDA(dst, b, h) do { _Pragma("unroll") for (int m = 0; m < 4; ++m) _Pragma("unroll") for (int k = 0; k < 2; ++k) dst[m][k] = *(const LAS bf16x8*)(lds + PG8_SA(b, h) + aoff + m * 2048 + k * 1024); } while (0)
#define PG8_LDB(dst, b, h) do { _Pragma("unroll") for (int n = 0; n < 2; ++n) _Pragma("unroll") for (int k = 0; k < 2; ++k) dst[n][k] = *(const LAS bf16x8*)(lds + PG8_SB(b, h) + boff + n * 2048 + k * 1024); } while (0)
#define PG8_MMA(ai, bj, At, Bt) do { __builtin_amdgcn_s_setprio(1); _Pragma("unroll") for (int m = 0; m < 4; ++m) _Pragma("unroll") for (int n = 0; n < 2; ++n) _Pragma("unroll") for (int k = 0; k < 2; ++k) \
        acc[ai][bj][m][n] = __builtin_amdgcn_mfma_f32_16x16x32_bf16(Bt[n][k], At[m][k], acc[ai][bj][m][n], 0, 0, 0); __builtin_amdgcn_s_setprio(0); } while (0)
#define PG8_WAIT_V(n) asm volatile("s_waitcnt vmcnt(" #n ")" ::: "memory")
#define PG8_WAIT_L(n) asm volatile("s_waitcnt lgkmcnt(" #n ")" ::: "memory")
#define PG8_BAR __builtin_amdgcn_s_barrier()
#define PG8_SCHED __builtin_amdgcn_sched_barrier(0)
    Unit cur, nxt; int ui = 0;
    if (!S.next(0, cur)) return;
    f32x4 acc[2][2][4][2];
#pragma unroll
    for (int a = 0; a < 2; ++a)
#pragma unroll
        for (int b = 0; b < 2; ++b)
#pragma unroll
            for (int m = 0; m < 4; ++m)
#pragma unroll
                for (int n = 0; n < 2; ++n) acc[a][b][m][n] = (f32x4){0.f, 0.f, 0.f, 0.f};
    bf16x8 At[4][2], B0[2][2], B1[2][2];
    constexpr bool GA = Sched::GATHER;
    unsigned ac0[2], ac1[2];
    const size_t hstepA = GA ? (size_t)0 : (size_t)HALF * S.a_ld() * 2;
    const char* cA = Abase; const char* nA = Abase;
    if constexpr (GA) {
#pragma unroll
        for (int i = 0; i < 2; ++i) { ac0[i] = S.a_row_off(cur, RA[i]) + CA[i]; ac1[i] = S.a_row_off(cur, HALF + RA[i]) + CA[i]; }
    } else {
#pragma unroll
        for (int i = 0; i < 2; ++i) { ac0[i] = (unsigned)(RA[i] * S.a_ld() * 2 + CA[i]); ac1[i] = ac0[i]; }
        cA = Abase + (size_t)S.a_tile_off(cur);
    }
    const char* cB = S.b_ptr(cur);
    PG8_STAGE(PG8_SB(0, 0), cB, voffB); PG8_STAGEA(PG8_SA(0, 0), cA, ac0, 0); PG8_STAGE(PG8_SB(0, 1), cB + hstep, voffB); PG8_STAGEA(PG8_SA(0, 1), cA + hstepA, ac1, 0);
    if (wr == 1) PG8_BAR;
    PG8_WAIT_V(4); PG8_BAR;
    PG8_STAGE(PG8_SB(1, 0), cB + kstep, voffB); PG8_STAGEA(PG8_SA(1, 0), cA, ac0, kstep); PG8_STAGE(PG8_SB(1, 1), cB + hstep + kstep, voffB);
    PG8_WAIT_V(6); PG8_BAR;
    for (;;) {
        const bool has_next = S.next(ui + 1, nxt);
        const char* nB = has_next ? S.b_ptr(nxt) : cB;
        if constexpr (!GA) { nA = has_next ? Abase + (size_t)S.a_tile_off(nxt) : cA; }
        unsigned s0[2], s1[2];
        for (int t = 0; t < nt; t += 2) {
            const bool last = (t == nt - 2);
            const size_t k1 = (size_t)(t + 1) * kstep;
            const size_t k2 = last ? (size_t)0 : (size_t)(t + 2) * kstep;
            const char* b2 = last ? nB : cB + (size_t)(t + 2) * kstep;
            const char* b3 = b2 + kstep;
            const char* a2 = (last && !GA) ? nA : cA;
#pragma unroll
            for (int i = 0; i < 2; ++i) { s0[i] = ac0[i]; s1[i] = ac1[i]; }
            if constexpr (GA) { if (last && has_next) {
#pragma unroll
                for (int i = 0; i < 2; ++i) { int R, C; stage_rc(tid * 16 + i * 8192, R, C); s0[i] = S.a_row_off(nxt, R) + C * 2; s1[i] = S.a_row_off(nxt, HALF + R) + C * 2; } } }
            PG8_LDB(B0, 0, 0); PG8_SCHED; PG8_LDA(At, 0, 0); PG8_STAGEA(PG8_SA(1, 1), cA + hstepA, ac1, k1);
            PG8_WAIT_L(8); PG8_BAR; PG8_WAIT_L(0); PG8_MMA(0, 0, At, B0); PG8_BAR; PG8_SCHED;
            PG8_LDB(B1, 0, 1); PG8_STAGE(PG8_SB(0, 0), b2, voffB);
            PG8_BAR; PG8_WAIT_L(0); PG8_MMA(0, 1, At, B1); PG8_BAR;
            PG8_LDA(At, 0, 1); PG8_STAGEA(PG8_SA(0, 0), a2, s0, k2);
            PG8_BAR; PG8_WAIT_L(0); PG8_MMA(1, 0, At, B0); PG8_BAR; PG8_SCHED;
            PG8_STAGE(PG8_SB(0, 1), b2 + hstep, voffB);
            PG8_WAIT_V(6); PG8_BAR; PG8_MMA(1, 1, At, B1); PG8_BAR;
            PG8_LDB(B0, 1, 0); PG8_SCHED; PG8_LDA(At, 1, 0); PG8_STAGEA(PG8_SA(0, 1), a2 + hstepA, s1, k2);
            PG8_WAIT_L(8); PG8_BAR; PG8_WAIT_L(0); PG8_MMA(0, 0, At, B0); PG8_BAR; PG8_SCHED;
            PG8_LDB(B1, 1, 1); PG8_STAGE(PG8_SB(1, 0), b3, voffB);
            PG8_BAR; PG8_WAIT_L(0); PG8_MMA(0, 1, At, B1); PG8_BAR;
            PG8_LDA(At, 1, 1); PG8_STAGEA(PG8_SA(1, 0), a2, s0, k2 + kstep);
            PG8_BAR; PG8_WAIT_L(0); PG8_MMA(1, 0, At, B0); PG8_BAR; PG8_SCHED;
            PG8_STAGE(PG8_SB(1, 1), b3 + hstep, voffB);
            PG8_WAIT_V(6); PG8_BAR; PG8_MMA(1, 1, At, B1); PG8_BAR;
        }
        { int l2 = (int)__builtin_amdgcn_mbcnt_hi(~0u, __builtin_amdgcn_mbcnt_lo(~0u, 0u)); asm volatile("" : "+v"(l2)); E(acc, cur, wr, wc, l2 & 15, l2 >> 4); }
        if (!has_next) break;
#pragma unroll
        for (int a = 0; a < 2; ++a)
#pragma unroll
            for (int b = 0; b < 2; ++b)
#pragma unroll
                for (int m = 0; m < 4; ++m)
#pragma unroll
                    for (int n = 0; n < 2; ++n) acc[a][b][m][n] = (f32x4){0.f, 0.f, 0.f, 0.f};
        cur = nxt; cB = nB; cA = nA; ++ui;
        if constexpr (GA) {
#pragma unroll
            for (int i = 0; i < 2; ++i) { ac0[i] = s0[i]; ac1[i] = s1[i]; }
        }
    }
    PG8_WAIT_V(0);
    if (wr == 0) PG8_BAR;
    PG8_BAR;
#undef PG8_SA
#undef PG8_SB
#undef PG8_STAGE
#undef PG8_STAGEA
#undef PG8_LDA
#undef PG8_LDB
#undef PG8_MMA
#undef PG8_WAIT_V
#undef PG8_WAIT_L
#undef PG8_BAR
#undef PG8_SCHED
}
}
using pg8::Unit;

constexpr size_t al256(size_t x) { return (x + 255) & ~(size_t)255; }
constexpr size_t MB = 1024 * 1024;
constexpr size_t WS_CTL = 0;
constexpr size_t CTL_BAR = 0;
constexpr size_t CTL_MOECNT = 16384;
constexpr size_t CTL_BYTES = 32768;
constexpr int NIN = 7424;
constexpr size_t WS_WIN  = al256(WS_CTL + CTL_BYTES);
constexpr size_t WS_WBRA = WS_WIN  + (size_t)NIN * 1024 * 2;
constexpr size_t WS_WBRB = WS_WBRA + (size_t)1024 * 1024 * 2;
constexpr size_t WS_WBRC = WS_WBRB + (size_t)1024 * 512 * 2;
constexpr size_t WS_WO   = WS_WBRC + (size_t)1024 * 512 * 2;
constexpr size_t WS_WGLU = WS_WO   + (size_t)1024 * 1024 * 2;
constexpr size_t WS_WRT  = WS_WGLU + (size_t)512 * 512 * 2;
constexpr size_t WS_WGU  = WS_WRT  + (size_t)256 * 1024 * 2;
constexpr size_t WS_WDN  = WS_WGU  + (size_t)65 * 512 * 1024 * 2;
constexpr size_t WS_S5TF = WS_WDN  + (size_t)65 * 1024 * 256 * 2;
constexpr size_t WS_S5E  = WS_S5TF + (size_t)32 * 512 * 640 * 2;
constexpr size_t WS_S5A32 = WS_S5E + (size_t)32 * 256 * 512 * 2;
constexpr size_t WS_WEND = al256(WS_S5A32 + 32 * 64 * 8);
constexpr size_t WS_X   = WS_WEND;
constexpr size_t WS_XB  = WS_X  + (size_t)NTOK * 1024 * 4;
constexpr size_t WS_XM  = WS_XB + (size_t)NTOK * 1024 * 2;
constexpr size_t WS_XMB = WS_XM + (size_t)NTOK * 1024 * 4;
constexpr size_t WS_R   = WS_XMB + (size_t)NTOK * 1024 * 2;
constexpr size_t WS_QT    = WS_R;
constexpr size_t WS_IDXQ  = WS_QT    + (size_t)NTOK * 1024 * 2;
constexpr size_t WS_BQKV  = WS_IDXQ  + (size_t)NTOK * 512 * 2;
constexpr size_t WS_BZ    = WS_BQKV  + (size_t)NTOK * 1536 * 2;
constexpr size_t WS_CUP   = WS_BZ    + (size_t)NTOK * 512 * 2;
constexpr size_t WS_GATES = WS_CUP   + (size_t)32 * 1024 * 640 * 2;
constexpr size_t WS_MISC  = WS_GATES + (size_t)NTOK * 3072 * 2;
constexpr size_t WS_CKV   = WS_MISC  + (size_t)NTOK * 256 * 4;
constexpr size_t WS_IDXK  = WS_CKV   + (size_t)NTOK * 128 * 2;
constexpr size_t WS_SEL   = WS_IDXK  + (size_t)NTOK * 64 * 2;
constexpr size_t WS_CTX   = WS_SEL   + (size_t)NTOK * 256 * 4;
constexpr size_t WS_YB    = WS_CTX   + (size_t)NTOK * 1024 * 2;
constexpr size_t WS_XLOC  = WS_YB    + (size_t)NTOK * 512 * 2;
constexpr size_t WS_YCPRE = WS_XLOC  + (size_t)32 * 1024 * 256 * 4;
constexpr size_t WS_YC    = WS_YCPRE + (size_t)NTOK * 512 * 2;
constexpr size_t WS_U     = WS_YC    + (size_t)NTOK * 512 * 2;
constexpr size_t WS_DNA   = WS_U;
constexpr size_t WS_DNB   = WS_DNA + (size_t)2048 * 128 * 128 * 2;
constexpr size_t WS_DNQ   = WS_DNB + (size_t)2048 * 128 * 128 * 4;
constexpr size_t WS_DNO   = WS_DNQ + (size_t)2048 * 64 * 128 * 2;
constexpr size_t WS_DNS   = WS_DNO + (size_t)2048 * 64 * 128 * 4;
constexpr size_t WS_UEND  = WS_DNS + (size_t)2048 * 128 * 128 * 2;
constexpr size_t WS_SCORES = WS_UEND;
constexpr size_t WS_MERGED = WS_U;
constexpr size_t WS_MERGEDB = WS_MERGED + (size_t)NTOK * 1024 * 4;
static_assert(WS_MERGEDB + (size_t)NTOK * 1024 * 2 <= WS_UEND, "union");
constexpr size_t WS_SCORES2 = WS_U;
static_assert((size_t)8192 * 8192 * 4 <= WS_UEND - WS_U, "scores2");
constexpr size_t WS_MIXEND = WS_SCORES + (size_t)8192 * 8192 * 4;
constexpr int MOE_ROWS = NTOK * 8 + 64 * 256;
constexpr int MOE_TILES = MOE_ROWS / 256;
constexpr size_t WS_RLOG  = WS_R;
constexpr size_t WS_TOPI  = WS_RLOG + (size_t)NTOK * 256 * 4;
constexpr size_t WS_TOPG  = WS_TOPI + (size_t)NTOK * 8 * 4;
constexpr size_t WS_TOPR  = WS_TOPG + (size_t)NTOK * 8 * 4;
constexpr size_t WS_SROW  = WS_TOPR + (size_t)NTOK * 8 * 4;
constexpr size_t WS_TEXP  = WS_SROW + (size_t)MOE_ROWS * 4;
constexpr size_t WS_EBASE = WS_TEXP + al256((MOE_TILES + 8) * 4);
constexpr size_t WS_HS    = al256(WS_EBASE + 256);
constexpr size_t WS_YS    = WS_HS + (size_t)(NTOK + MOE_ROWS) * 256 * 2;
constexpr size_t WS_MOEEND = WS_YS + (size_t)(NTOK + MOE_ROWS) * 1024 * 2;
constexpr size_t WS_TOTAL = WS_MIXEND > WS_MOEEND ? WS_MIXEND : WS_MOEEND;
static_assert(WS_TOTAL < (size_t)2040 * MB, "workspace budget");

constexpr int LDS_BYTES = 147456;

struct Params {
    const float* in[33];
    float* out;
    unsigned char* ws;
};
enum { I_X = 0, I_RELB, I_WIN, I_KVN, I_KVUP, I_BCONV, I_BALOG, I_BDTB, I_BONORM, I_CLRE, I_CLIM, I_CLOGDT, I_CBRE, I_CBIM, I_CCRE, I_CCIM, I_CD,
       I_GLUW, I_GLUB, I_WBRA, I_WBRB, I_WBRC, I_WO, I_LN1G, I_LN1B, I_RTW, I_RTB, I_EGU, I_EDN, I_SGU, I_SDN, I_LN2G, I_LN2B };

struct Ctx {
    LAS unsigned char* lds; int tid, lane, wave, wg, nwg;
};

template <class Map>
__device__ __forceinline__ void cvt_tile(const Ctx& c, const float* __restrict__ src, int ld, bf16_t* __restrict__ dst, int K, int n0, int k0, const Map& map) {
    LAS float* t = (LAS float*)c.lds;
    const int n = c.tid & 63, kq = c.tid >> 6;
    const int sc = map(n0 + n);
#pragma unroll
    for (int i = 0; i < 8; ++i) { const int k = i * 8 + kq; t[k * 65 + n] = sc >= 0 ? src[(size_t)(k0 + k) * ld + sc] : 0.f; }
    __syncthreads();
    { const int nn = c.tid >> 3, kc = (c.tid & 7) * 8; u32x4 w;
      w.x = cvt_pk_bf16(t[(kc + 0) * 65 + nn], t[(kc + 1) * 65 + nn]); w.y = cvt_pk_bf16(t[(kc + 2) * 65 + nn], t[(kc + 3) * 65 + nn]);
      w.z = cvt_pk_bf16(t[(kc + 4) * 65 + nn], t[(kc + 5) * 65 + nn]); w.w = cvt_pk_bf16(t[(kc + 6) * 65 + nn], t[(kc + 7) * 65 + nn]);
      *(u32x4*)(dst + (size_t)(n0 + nn) * K + k0 + kc) = w; }
    __syncthreads();
}
template <class Map>
__device__ __forceinline__ void cvt_tile4(const Ctx& c, const float* __restrict__ src, int ld, bf16_t* __restrict__ dst, int K, int n0, int k0, const Map& map) {
    LAS float* t = (LAS float*)c.lds;
    const int n = c.tid & 63, kq = c.tid >> 6;
    const int sc = map(n0 + n);
    float v[32];
#pragma unroll
    for (int i = 0; i < 32; ++i) { const int k = i * 8 + kq; v[i] = sc >= 0 ? src[(size_t)(k0 + k) * ld + sc] : 0.f; }
#pragma unroll
    for (int i = 0; i < 32; ++i) { const int k = i * 8 + kq; t[(k >> 6) * (64 * 65) + (k & 63) * 65 + n] = v[i]; }
    __syncthreads();
    { const int nn = c.tid >> 3, kc = (c.tid & 7) * 8;
#pragma unroll
      for (int sb = 0; sb < 4; ++sb) { const LAS float* tt = t + sb * (64 * 65); u32x4 w;
        w.x = cvt_pk_bf16(tt[(kc + 0) * 65 + nn], tt[(kc + 1) * 65 + nn]); w.y = cvt_pk_bf16(tt[(kc + 2) * 65 + nn], tt[(kc + 3) * 65 + nn]);
        w.z = cvt_pk_bf16(tt[(kc + 4) * 65 + nn], tt[(kc + 5) * 65 + nn]); w.w = cvt_pk_bf16(tt[(kc + 6) * 65 + nn], tt[(kc + 7) * 65 + nn]);
        *(u32x4*)(dst + (size_t)(n0 + nn) * K + k0 + sb * 64 + kc) = w; } }
    __syncthreads();
}
struct MapIdent { __device__ int operator()(int n) const { return n; } };
struct MapLimit { int lim; __device__ int operator()(int n) const { return n < lim ? n : -1; } };
struct MapWin {
    __device__ int operator()(int n) const {
        if (n < 512) return 640 + n;
        if (n < 2048) return 1224 + (n - 512);
        if (n < 2560) return 2760 + (n - 2048);
        if (n < 3072) return 3280 + (n - 2560);
        if (n < 6144) return 3792 + (n - 3072);
        if (n < 6272) return 512 + (n - 6144);
        if (n < 6336) return 1152 + (n - 6272);
        if (n < 6344) return 1216 + (n - 6336);
        if (n < 6348) return 3272 + (n - 6344);
        if (n < 6352) return 3276 + (n - 6348);
        return -1;
    }
};
struct MapGU { __device__ int operator()(int n) const { const int j = n >> 8, p = n & 255; return p < 128 ? 128 * j + p : 256 + 128 * j + (p - 128); } };

__device__ __forceinline__ void sincos_rev(float phi, float& s, float& c) {
    float r = phi * 0.15915494309189535f; r -= rintf(r);
    s = __builtin_amdgcn_sinf(r); c = __builtin_amdgcn_cosf(r);
}

template <class Map>
__device__ __forceinline__ void cvt_direct(const Ctx& c, const float* __restrict__ src, int ld, bf16_t* __restrict__ dst, int K, int n0, int k0, const Map& map) {
    const int kb = (c.tid >> 6) * 8, n4 = (c.tid & 63) * 4; const int sc = map(n0 + n4);
    f32x4 v[8];
#pragma unroll
    for (int i = 0; i < 8; ++i) v[i] = *(const f32x4*)(src + (size_t)(k0 + kb + i) * ld + sc);
#pragma unroll
    for (int q = 0; q < 4; ++q) { u32x4 w; w.x = cvt_pk_bf16(v[0][q], v[1][q]); w.y = cvt_pk_bf16(v[2][q], v[3][q]); w.z = cvt_pk_bf16(v[4][q], v[5][q]); w.w = cvt_pk_bf16(v[6][q], v[7][q]);
        *(u32x4*)(dst + (size_t)(n0 + n4 + q) * K + k0 + kb) = w; }
}
__device__ __forceinline__ void p0_small_tile(const Ctx& c, const Params& P, int l, int j) {
    unsigned char* ws = P.ws;
    constexpr int J0 = 400, J1 = J0 + 32, J2 = J1 + 32, J3 = J2 + 64, J4 = J3 + 16, J5 = J4 + 16;
    if (j < J0) {}
        else if (j < J1) { const int q = j - J0, nt = q >> 1, kt = q & 1;
            cvt_tile4(c, P.in[I_WBRB] + (size_t)l * 512 * 1024, 1024, (bf16_t*)(ws + WS_WBRB), 512, nt * 64, kt * 256, MapIdent()); }
        else if (j < J2) { const int q = j - J1, nt = q >> 1, kt = q & 1;
            cvt_tile4(c, P.in[I_WBRC] + (size_t)l * 512 * 1024, 1024, (bf16_t*)(ws + WS_WBRC), 512, nt * 64, kt * 256, MapIdent()); }
        else if (j < J3) { const int q = j - J2, nt = q >> 2, kt = q & 3;
            cvt_tile4(c, P.in[I_WO] + (size_t)l * 1024 * 1024, 1024, (bf16_t*)(ws + WS_WO), 1024, nt * 64, kt * 256, MapIdent()); }
        else if (j < J4) { const int q = j - J3, nt = q >> 1, kt = q & 1;
            cvt_tile4(c, P.in[I_GLUW] + (size_t)l * 512 * 512, 512, (bf16_t*)(ws + WS_WGLU), 512, nt * 64, kt * 256, MapIdent()); }
        else if (j < J5) { const int q = j - J4, nt = q >> 2, kt = q & 3; MapLimit m; m.lim = 64;
            cvt_tile4(c, P.in[I_RTW] + (size_t)l * 1024 * 64, 64, (bf16_t*)(ws + WS_WRT), 1024, nt * 64, kt * 256, m); }
}
__device__ __forceinline__ void p0_wbra_job(const Ctx& c, const Params& P, int l, int h, int blk) {
    unsigned char* ws = P.ws;
    LAS float* tA = (LAS float*)c.lds; LAS float* tB = tA + 64 * 65;
    const float* kvup = P.in[I_KVUP] + (size_t)l * 128 * 1024;
                const float* wbr = P.in[I_WBRA] + (size_t)l * 512 * 1024;
                for (int i = c.tid; i < 64 * 64; i += 512) { const int e = i >> 6, cc = i & 63; tA[cc * 65 + e] = wbr[(size_t)(h * 64 + e) * 1024 + blk * 64 + cc]; }
                for (int i = c.tid; i < 128 * 64; i += 512) { const int r = i >> 6, e = i & 63; tB[r * 65 + e] = kvup[(size_t)r * 1024 + 512 + h * 64 + e]; }
                __syncthreads();
#pragma unroll
                for (int it = 0; it < 2; ++it) { const int o = c.tid + it * 512, cc = o >> 4, r8 = (o & 15) * 8; float a[8];
#pragma unroll
                    for (int q = 0; q < 8; ++q) a[q] = 0.f;
                    for (int e = 0; e < 64; ++e) { const float b = tA[cc * 65 + e];
#pragma unroll
                        for (int q = 0; q < 8; ++q) a[q] += tB[(r8 + q) * 65 + e] * b; }
                    u32x4 w; w.x = cvt_pk_bf16(a[0], a[1]); w.y = cvt_pk_bf16(a[2], a[3]); w.z = cvt_pk_bf16(a[4], a[5]); w.w = cvt_pk_bf16(a[6], a[7]);
                    *(u32x4*)((bf16_t*)(ws + WS_WBRA) + (size_t)(blk * 64 + cc) * 1024 + h * 128 + r8) = w; }
                __syncthreads();
}
constexpr int P0X_SMALL = 128 + 160;
constexpr int P0X_JOBS = P0X_SMALL + 2080 + 1040;
__device__ __forceinline__ void phase_p0_experts(const Ctx& c, const Params& P, int l) {
    unsigned char* ws = P.ws; unsigned* ctr = (unsigned*)(ws + WS_CTL + 20480) + 64 * l;
    LAS int* slot = (LAS int*)(c.lds + 70000);
    for (;;) {
        if (c.tid == 0) slot[0] = (int)atomicAdd(ctr, 1u);
        __syncthreads();
        const int qa = __builtin_amdgcn_readfirstlane(slot[0]);
        if (qa >= P0X_JOBS) break;
        __syncthreads();
        const int q0 = qa - P0X_SMALL;
        if (qa < 128) p0_wbra_job(c, P, l, qa >> 4, qa & 15);
        else if (qa < P0X_SMALL) p0_small_tile(c, P, l, 400 + qa - 128);
        else if (q0 < 2080) { const int e = q0 >> 5, r = q0 & 31, nt = r >> 4, kt = r & 15;
            const float* src = e < 64 ? P.in[I_EGU] + ((size_t)l * 64 + e) * 1024 * 512 : P.in[I_SGU] + (size_t)l * 1024 * 512;
            cvt_direct(c, src, 512, (bf16_t*)(ws + WS_WGU) + (size_t)e * 512 * 1024, 1024, nt * 256, kt * 64, MapGU()); }
        else { const int q = q0 - 2080, e = q >> 4, nt = (q >> 2) & 3, kt = q & 3;
            const float* src = e < 64 ? P.in[I_EDN] + ((size_t)l * 64 + e) * 256 * 1024 : P.in[I_SDN] + (size_t)l * 256 * 1024;
            cvt_direct(c, src, 1024, (bf16_t*)(ws + WS_WDN) + (size_t)e * 1024 * 256, 256, nt * 256, kt * 64, MapIdent()); }
    }
    __syncthreads();
}
__device__ __forceinline__ void phase_p0(const Ctx& c, const Params& P, int l) {
    unsigned char* ws = P.ws;
    constexpr int J0 = 400, J1 = J0 + 32, J2 = J1 + 32, J3 = J2 + 64, J4 = J3 + 16, J5 = J4 + 16;
    for (int j = c.wg; j < J0; j += c.nwg) {
        if (j < J0) { const int nt = j >> 2, kt = j & 3;
            cvt_tile4(c, P.in[I_WIN] + (size_t)l * 1024 * D_IN, D_IN, (bf16_t*)(ws + WS_WIN) + (size_t)1024 * 1024, 1024, nt * 64, kt * 256, MapWin()); }
    }
    {
        LAS float* tA = (LAS float*)c.lds;
        LAS float* tB = tA + 64 * 65;
        const float* kvup = P.in[I_KVUP] + (size_t)l * 128 * 1024;
        for (int j = c.wg; j < 128; j += c.nwg) {
            const int h = (j & 127) >> 4, blk = j & 15;
            {
                const float* win = P.in[I_WIN] + (size_t)l * 1024 * D_IN;
                for (int i = c.tid; i < 64 * 64; i += 512) { const int dm = i >> 6, e = i & 63; tA[dm * 65 + e] = win[(size_t)(blk * 64 + dm) * D_IN + h * 64 + e]; }
                for (int i = c.tid; i < 128 * 64; i += 512) { const int r = i >> 6, e = i & 63; tB[r * 65 + e] = kvup[(size_t)r * 1024 + h * 64 + e]; }
                __syncthreads();
#pragma unroll
                for (int it = 0; it < 2; ++it) { const int o = c.tid + it * 512, r = o >> 3, d8 = (o & 7) * 8; float a[8];
#pragma unroll
                    for (int q = 0; q < 8; ++q) a[q] = 0.f;
                    for (int e = 0; e < 64; ++e) { const float b = tB[r * 65 + e];
#pragma unroll
                        for (int q = 0; q < 8; ++q) a[q] += tA[(d8 + q) * 65 + e] * b; }
                    u32x4 w; w.x = cvt_pk_bf16(a[0], a[1]); w.y = cvt_pk_bf16(a[2], a[3]); w.z = cvt_pk_bf16(a[4], a[5]); w.w = cvt_pk_bf16(a[6], a[7]);
                    *(u32x4*)((bf16_t*)(ws + WS_WIN) + (size_t)(h * 128 + r) * 1024 + blk * 64 + d8) = w; }
                __syncthreads();
            }
        }
    }
    for (int g = c.wg; g < 32; g += c.nwg) {
        LAS float* AP = (LAS float*)c.lds;
        LAS float* BB = AP + 33 * 128;
        LAS float* CC = BB + 64 * 32;
        LAS float* KT = CC + 16 * 128;
        const float dt = __expf(P.in[I_CLOGDT][l * 32 + g]);
        if (c.tid < 64) { const int p = c.tid;
            const float lr = P.in[I_CLRE][(l * 32 + g) * 64 + p], li = P.in[I_CLIM][(l * 32 + g) * 64 + p];
            const float mag = __expf(lr * dt); float sn, cs; sincos_rev(li * dt, sn, cs);
            const float are = mag * cs, aim = mag * sn, den = lr * lr + li * li;
            const float fre = ((are - 1.0f) * lr + aim * li) / den, fim = (aim * lr - (are - 1.0f) * li) / den;
            float pr = 1.f, pi = 0.f;
            for (int k = 0; k <= 32; ++k) { AP[(k * 64 + p) * 2] = pr; AP[(k * 64 + p) * 2 + 1] = pi; const float nr = pr * are - pi * aim, ni = pr * aim + pi * are; pr = nr; pi = ni; }
            ((float*)(ws + WS_S5A32))[(g * 64 + p) * 2] = AP[(32 * 64 + p) * 2]; ((float*)(ws + WS_S5A32))[(g * 64 + p) * 2 + 1] = AP[(32 * 64 + p) * 2 + 1];
            for (int j = 0; j < 16; ++j) { const float br = P.in[I_CBRE][((size_t)(l * 32 + g) * 64 + p) * 16 + j], bi = P.in[I_CBIM][((size_t)(l * 32 + g) * 64 + p) * 16 + j];
                BB[(p * 16 + j) * 2] = fre * br - fim * bi; BB[(p * 16 + j) * 2 + 1] = fre * bi + fim * br; }
        }
        for (int i = c.tid; i < 16 * 64; i += 512) { const int ii = i >> 6, p = i & 63;
            CC[i * 2] = P.in[I_CCRE][((size_t)(l * 32 + g) * 16 + ii) * 64 + p]; CC[i * 2 + 1] = P.in[I_CCIM][((size_t)(l * 32 + g) * 16 + ii) * 64 + p]; }
        __syncthreads();
        for (int o = c.tid; o < 32 * 256; o += 512) { const int tau = o >> 8, i = (o >> 4) & 15, j = o & 15; float s = 0.f;
            for (int p = 0; p < 64; ++p) { const float cr = CC[(i * 64 + p) * 2], ci = CC[(i * 64 + p) * 2 + 1], ar = AP[(tau * 64 + p) * 2], ai = AP[(tau * 64 + p) * 2 + 1];
                const float xr = cr * ar - ci * ai, xi = cr * ai + ci * ar; s += xr * BB[(p * 16 + j) * 2] - xi * BB[(p * 16 + j) * 2 + 1]; }
            if (tau == 0 && i == j) s += P.in[I_CD][(l * 32 + g) * 16 + i];
            KT[o] = s; }
        __syncthreads();
        bf16_t* TF = (bf16_t*)(ws + WS_S5TF) + (size_t)g * 512 * 640;
        for (int o = c.tid; o < 512 * 80; o += 512) { const int n = o / 80, k8 = (o % 80) * 8, tp = n >> 4, i = n & 15; float v[8];
            if (k8 < 512) { const int sp = k8 >> 4, j0 = k8 & 15;
#pragma unroll
                for (int q = 0; q < 8; ++q) v[q] = tp >= sp ? KT[(tp - sp) * 256 + i * 16 + j0 + q] : 0.f; }
            else { const int p0 = (k8 - 512) >> 1;
#pragma unroll
                for (int q = 0; q < 4; ++q) { const int p = p0 + q; const float cr = CC[(i * 64 + p) * 2], ci = CC[(i * 64 + p) * 2 + 1], ar = AP[((tp + 1) * 64 + p) * 2], ai = AP[((tp + 1) * 64 + p) * 2 + 1];
                    v[2 * q] = cr * ar - ci * ai; v[2 * q + 1] = -(cr * ai + ci * ar); } }
            u32x4 w; w.x = cvt_pk_bf16(v[0], v[1]); w.y = cvt_pk_bf16(v[2], v[3]); w.z = cvt_pk_bf16(v[4], v[5]); w.w = cvt_pk_bf16(v[6], v[7]);
            *(u32x4*)(TF + (size_t)n * 640 + k8) = w; }
        bf16_t* EE = (bf16_t*)(ws + WS_S5E) + (size_t)g * 256 * 512;
        for (int o = c.tid; o < 256 * 64; o += 512) { const int n = o >> 6, k8 = (o & 63) * 8; float v[8];
            if (n < 128) { const int p = n >> 1, cpx = n & 1, sp = k8 >> 4, j0 = k8 & 15; const float ar = AP[((31 - sp) * 64 + p) * 2], ai = AP[((31 - sp) * 64 + p) * 2 + 1];
#pragma unroll
                for (int q = 0; q < 8; ++q) { const float br = BB[(p * 16 + j0 + q) * 2], bi = BB[(p * 16 + j0 + q) * 2 + 1]; v[q] = cpx ? (ar * bi + ai * br) : (ar * br - ai * bi); } }
            else {
#pragma unroll
                for (int q = 0; q < 8; ++q) v[q] = 0.f; }
            u32x4 w; w.x = cvt_pk_bf16(v[0], v[1]); w.y = cvt_pk_bf16(v[2], v[3]); w.z = cvt_pk_bf16(v[4], v[5]); w.w = cvt_pk_bf16(v[6], v[7]);
            *(u32x4*)(EE + (size_t)n * 512 + k8) = w; }
        __syncthreads();
    }
}

struct SchedPlain {
    int nM, nN, nwg, G, c, K; const char* Bt;
    __device__ __forceinline__ void init(int M, int N, int K_, const void* Bt_, int G_, int c_) { nM = M / 256; nN = N / 256; nwg = nM * nN; G = G_; c = c_; K = K_; Bt = (const char*)Bt_; }
    __device__ __forceinline__ bool next(int i, Unit& u) const {
        const long L = (long)i * G + c; if (L >= nwg) return false;
        int wgid = (int)L; { const int q = nwg / 8, r = nwg % 8, xcd = wgid % 8, off = wgid / 8; wgid = (xcd < r ? xcd * (q + 1) : r * (q + 1) + (xcd - r) * q) + off; }
        const int nig = 8 * nN, gid = wgid / nig, fm = gid * 8, gsz = (nM - fm) < 8 ? (nM - fm) : 8;
        u.pm = fm + ((wgid % nig) % gsz); u.pn = (wgid % nig) / gsz; return true;
    }
    static constexpr bool GATHER = false;
    __device__ __forceinline__ int a_ld() const { return K; }
    __device__ __forceinline__ size_t a_tile_off(const Unit& u) const { return (size_t)u.pm * 256 * K * 2; }
    __device__ __forceinline__ unsigned a_row_off(const Unit& u, int r) const { return 0u; }
    __device__ __forceinline__ const char* b_ptr(const Unit& u) const { return Bt + (size_t)u.pn * 256 * K * 2; }
};
struct SchedGrouped {
    int nMg, nNg, ngr, nwg, G, c, K, lda; const char* Bt;
    __device__ __forceinline__ void init(int ngr_, int Mg, int Ng, int K_, const void* Bt_, int G_, int c_) { ngr = ngr_; nMg = Mg / 256; nNg = Ng / 256; nwg = ngr * nMg * nNg; G = G_; c = c_; K = K_; lda = K_; Bt = (const char*)Bt_; }
    __device__ __forceinline__ bool next(int i, Unit& u) const {
        const int L = i * G + c; if (L >= nwg) return false;
        const int per = nMg * nNg, g = L / per, r = L % per;
        u.pm = g * nMg + r / nNg; u.pn = g * nNg + r % nNg; return true;
    }
    static constexpr bool GATHER = false;
    __device__ __forceinline__ int a_ld() const { return lda; }
    __device__ __forceinline__ size_t a_tile_off(const Unit& u) const { return (size_t)u.pm * 256 * lda * 2; }
    __device__ __forceinline__ unsigned a_row_off(const Unit& u, int r) const { return 0u; }
    __device__ __forceinline__ const char* b_ptr(const Unit& u) const { return Bt + (size_t)u.pn * 256 * K * 2; }
};
#define EPI_LOOP_BEGIN \
    _Pragma("unroll") for (int ai = 0; ai < 2; ++ai) _Pragma("unroll") for (int m = 0; m < 4; ++m) { const int r = ai * 128 + wr * 64 + m * 16 + fr; \
    _Pragma("unroll") for (int bj = 0; bj < 2; ++bj) { const int c8 = bj * 128 + wc * 32 + fq * 8; const f32x4 v0 = acc[ai][bj][m][0], v1 = acc[ai][bj][m][1];
#define EPI_LOOP_END } asm volatile("" ::: "memory"); }
__device__ __forceinline__ u32x4 pack8(const f32x4 a, const f32x4 b) { u32x4 w; w.x = cvt_pk_bf16(a[0], a[1]); w.y = cvt_pk_bf16(a[2], a[3]); w.z = cvt_pk_bf16(b[0], b[1]); w.w = cvt_pk_bf16(b[2], b[3]); return w; }
__device__ __forceinline__ void unpack8(const u32x4 w, f32x4& a, f32x4& b) { a = (f32x4){bflo(w.x), bfhi(w.x), bflo(w.y), bfhi(w.y)}; b = (f32x4){bflo(w.z), bfhi(w.z), bflo(w.w), bfhi(w.w)}; }

struct EpiWin {
    static constexpr bool PERM = true;
    unsigned char* ws;
    __device__ __forceinline__ void operator()(const f32x4 (&acc)[2][2][4][2], const Unit& u, int wr, int wc, int fr, int fq) const {
        asm volatile("" : "+v"(fr), "+v"(fq));
        const int pn = u.pn; const int row0 = u.pm * 256;
        if (pn == 28) {
            float* M = (float*)(ws + WS_MISC);
            EPI_LOOP_BEGIN
                float* p = M + (size_t)(row0 + r) * 256 + c8; *(f32x4*)p = v0; *(f32x4*)(p + 4) = v1;
            EPI_LOOP_END
        } else if (pn == 14 || pn == 15) {
            bf16_t* C = (bf16_t*)(ws + WS_CUP);
            EPI_LOOP_BEGIN
                const int t = row0 + r, b = t >> 13, s = t & 8191, n = s >> 5, sp = s & 31, cc = (pn - 14) * 256 + c8, g = cc >> 4, j0 = cc & 15;
                *(u32x4*)(C + ((size_t)(g * 1024 + b * 256 + n) * 640) + sp * 16 + j0) = pack8(v0, v1);
            EPI_LOOP_END
        } else {
            bf16_t* base; int ld, ct;
            if (pn < 4) { base = (bf16_t*)(ws + WS_QT); ld = 1024; ct = pn; }
            else if (pn < 6) { base = (bf16_t*)(ws + WS_IDXQ); ld = 512; ct = pn - 4; }
            else if (pn < 12) { base = (bf16_t*)(ws + WS_BQKV); ld = 1536; ct = pn - 6; }
            else if (pn < 14) { base = (bf16_t*)(ws + WS_BZ); ld = 512; ct = pn - 12; }
            else { base = (bf16_t*)(ws + WS_GATES); ld = 3072; ct = pn - 16; }
            EPI_LOOP_BEGIN
                __builtin_nontemporal_store(pack8(v0, v1), (u32x4*)(base + (size_t)(row0 + r) * ld + ct * 256 + c8));
            EPI_LOOP_END
        }
    }
};
struct EpiBf16 {
    static constexpr bool PERM = true;
    bf16_t* O; int ld;
    __device__ __forceinline__ void operator()(const f32x4 (&acc)[2][2][4][2], const Unit& u, int wr, int wc, int fr, int fq) const {
        asm volatile("" : "+v"(fr), "+v"(fq));
        EPI_LOOP_BEGIN
            *(u32x4*)(O + (size_t)(u.pm * 256 + r) * ld + u.pn * 256 + c8) = pack8(v0, v1);
        EPI_LOOP_END
    }
};
struct EpiF32 {
    static constexpr bool PERM = true;
    float* O; int ld;
    __device__ __forceinline__ void operator()(const f32x4 (&acc)[2][2][4][2], const Unit& u, int wr, int wc, int fr, int fq) const {
        asm volatile("" : "+v"(fr), "+v"(fq));
        EPI_LOOP_BEGIN
            float* p = O + (size_t)(u.pm * 256 + r) * ld + u.pn * 256 + c8; *(f32x4*)p = v0; *(f32x4*)(p + 4) = v1;
        EPI_LOOP_END
    }
};
template <int MODE> struct EpiMerge {
    static constexpr bool PERM = true;
    float* Mf; bf16_t* Mb; const bf16_t* gates; int gcol0;
    __device__ __forceinline__ void operator()(const f32x4 (&acc)[2][2][4][2], const Unit& u, int wr, int wc, int fr, int fq) const {
        asm volatile("" : "+v"(fr), "+v"(fq));
        EPI_LOOP_BEGIN
            const size_t row = (size_t)(u.pm * 256 + r); const int col = u.pn * 256 + c8;
            const u32x4 gw = *(const u32x4*)(gates + row * 3072 + gcol0 + col); f32x4 g0, g1; unpack8(gw, g0, g1);
#pragma unroll
            for (int q = 0; q < 4; ++q) { g0[q] = sigmoidf_(g0[q]); g1[q] = sigmoidf_(g1[q]); }
            f32x4 a = v0 * g0, b = v1 * g1; bf16_t* p = Mb + row * 1024 + col;
            if (MODE != 0) { f32x4 m0, m1; unpack8(*(const u32x4*)p, m0, m1); a += m0; b += m1; }
            *(u32x4*)p = pack8(a, b);
        EPI_LOOP_END
    }
};
struct SchedMergeBC : SchedPlain {
    size_t offB, offC; const char* BtB; const char* BtC;
    __device__ __forceinline__ bool next(int i, Unit& u) const {
        Unit t; if (!SchedPlain::next(i >> 1, t)) return false;
        u.pm = t.pm; u.pn = (i & 1) * 4 + t.pn; return true;
    }
    __device__ __forceinline__ size_t a_tile_off(const Unit& u) const { return ((u.pn >> 2) ? offC : offB) + (size_t)u.pm * 256 * 512 * 2; }
    __device__ __forceinline__ const char* b_ptr(const Unit& u) const { return ((u.pn >> 2) ? BtC : BtB) + (size_t)(u.pn & 3) * 256 * 512 * 2; }
};
struct EpiMergeBC {
    static constexpr bool PERM = true;
    bf16_t* Mb; const bf16_t* gates;
    __device__ __forceinline__ void operator()(const f32x4 (&acc)[2][2][4][2], const Unit& u, int wr, int wc, int fr, int fq) const {
        asm volatile("" : "+v"(fr), "+v"(fq));
        const int gcol0 = 1024 + 1024 * (u.pn >> 2), pn = u.pn & 3;
        EPI_LOOP_BEGIN
            const size_t row = (size_t)(u.pm * 256 + r); const int col = pn * 256 + c8;
            const u32x4 gw = *(const u32x4*)(gates + row * 3072 + gcol0 + col); f32x4 g0, g1; unpack8(gw, g0, g1);
#pragma unroll
            for (int q = 0; q < 4; ++q) { g0[q] = sigmoidf_(g0[q]); g1[q] = sigmoidf_(g1[q]); }
            f32x4 a = v0 * g0, b = v1 * g1; bf16_t* p = Mb + row * 1024 + col;
            { f32x4 m0, m1; unpack8(*(const u32x4*)p, m0, m1); a += m0; b += m1; }
            *(u32x4*)p = pack8(a, b);
        EPI_LOOP_END
    }
};
struct EpiResid {
    static constexpr bool PERM = true;
    const bf16_t* XB; float* O;
    __device__ __forceinline__ void operator()(const f32x4 (&acc)[2][2][4][2], const Unit& u, int wr, int wc, int fr, int fq) const {
        asm volatile("" : "+v"(fr), "+v"(fq));
        EPI_LOOP_BEGIN
            const size_t o = (size_t)(u.pm * 256 + r) * 1024 + u.pn * 256 + c8;
            f32x4 x0, x1; unpack8(*(const u32x4*)(XB + o), x0, x1);
            *(f32x4*)(O + o) = x0 * DN_ALPHA + v0; *(f32x4*)(O + o + 4) = x1 * DN_ALPHA + v1;
        EPI_LOOP_END
    }
};
struct EpiGlu {
    static constexpr bool PERM = true;
    const bf16_t* Y; const float* bias; bf16_t* O;
    __device__ __forceinline__ void operator()(const f32x4 (&acc)[2][2][4][2], const Unit& u, int wr, int wc, int fr, int fq) const {
        asm volatile("" : "+v"(fr), "+v"(fq));
        EPI_LOOP_BEGIN
            const size_t o = (size_t)(u.pm * 256 + r) * 512 + u.pn * 256 + c8; const int col = u.pn * 256 + c8;
            f32x4 y0, y1; unpack8(*(const u32x4*)(Y + o), y0, y1);
            const f32x4 b0 = *(const f32x4*)(bias + col), b1 = *(const f32x4*)(bias + col + 4); f32x4 a, b;
#pragma unroll
            for (int q = 0; q < 4; ++q) { a[q] = y0[q] * sigmoidf_(v0[q] + b0[q]); b[q] = y1[q] * sigmoidf_(v1[q] + b1[q]); }
            *(u32x4*)(O + o) = pack8(a, b);
        EPI_LOOP_END
    }
};
__device__ __forceinline__ float gelu_f(float v) {
    const float av = fabsf(v), t = __builtin_amdgcn_rcpf(av * 0.2316418882f + 1.0f);
    float q = t * 0.5307027145f + (-0.7265760135f); q = q * t + 0.7107068705f; q = q * t + (-0.142248368f); q = q * t + 0.127414796f; q = q * t;
    const float e = __builtin_amdgcn_exp2f((v * v) * (-0.72134752044f));
    const float mm = v * (q * e); return v < 0.f ? mm : v - mm;
}
struct EpiS5 {
    static constexpr bool PERM = true;
    bf16_t* O;
    __device__ __forceinline__ void operator()(const f32x4 (&acc)[2][2][4][2], const Unit& u, int wr, int wc, int fr, int fq) const {
        asm volatile("" : "+v"(fr), "+v"(fq));
        const int g = u.pm >> 2, rb = (u.pm & 3) * 256, cb = (u.pn & 1) * 256;
        EPI_LOOP_BEGIN
            const int rr = rb + r, b = rr >> 8, n = rr & 255, cc = cb + c8, tp = cc >> 4, i0 = cc & 15; f32x4 a, bb;
#pragma unroll
            for (int q = 0; q < 4; ++q) { a[q] = gelu_f(v0[q]); bb[q] = gelu_f(v1[q]); }
            *(u32x4*)(O + (size_t)(b * 8192 + n * 32 + tp) * 512 + g * 16 + i0) = pack8(a, bb);
        EPI_LOOP_END
    }
};
struct EpiXloc {
    static constexpr bool PERM = true;
    float* O;
    __device__ __forceinline__ void operator()(const f32x4 (&acc)[2][2][4][2], const Unit& u, int wr, int wc, int fr, int fq) const {
        asm volatile("" : "+v"(fr), "+v"(fq));
        EPI_LOOP_BEGIN
            float* p = O + (size_t)(u.pm * 256 + r) * 256 + c8; *(f32x4*)p = v0; *(f32x4*)(p + 4) = v1;
        EPI_LOOP_END
    }
};
struct EpiGU {
    static constexpr bool PERM = true;
    bf16_t* HS;
    __device__ __forceinline__ void operator()(const f32x4 (&acc)[2][2][4][2], const Unit& u, int wr, int wc, int fr, int fq) const {
        asm volatile("" : "+v"(fr), "+v"(fq));
#pragma unroll
        for (int ai = 0; ai < 2; ++ai)
#pragma unroll
            for (int m = 0; m < 4; ++m) { const int r = ai * 128 + wr * 64 + m * 16 + fr; const int c8 = wc * 32 + fq * 8; f32x4 a, b;
                const f32x4 g0 = acc[ai][0][m][0], g1 = acc[ai][0][m][1], u0 = acc[ai][1][m][0], u1 = acc[ai][1][m][1];
#pragma unroll
                for (int q = 0; q < 4; ++q) { a[q] = siluf_(g0[q]) * u0[q]; b[q] = siluf_(g1[q]) * u1[q]; }
                __builtin_nontemporal_store(pack8(a, b), (u32x4*)(HS + (size_t)(u.pm * 256 + r) * 256 + (u.pn & 1) * 128 + c8)); }
    }
};
struct EpiDown {
    static constexpr bool PERM = true;
    bf16_t* YS;
    __device__ __forceinline__ void operator()(const f32x4 (&acc)[2][2][4][2], const Unit& u, int wr, int wc, int fr, int fq) const {
        asm volatile("" : "+v"(fr), "+v"(fq));
        EPI_LOOP_BEGIN
            __builtin_nontemporal_store(pack8(v0, v1), (u32x4*)(YS + (size_t)(u.pm * 256 + r) * 1024 + (u.pn & 3) * 256 + c8));
        EPI_LOOP_END
    }
};
struct SchedGU {
    const int* texp; const int* srow; int ntiles, G, c; const char* Bt;
    __device__ __forceinline__ bool next(int i, Unit& u) const {
        const int L = i * G + c, pm = ((L >> 4) << 3) | (L & 7); if (pm >= 128 + ntiles) return false;
        const int e = pm < 128 ? 64 : __builtin_amdgcn_readfirstlane(texp[pm - 128]);
        u.pm = pm; u.pn = e * 2 + ((L >> 3) & 1); return true;
    }
    static constexpr bool GATHER = true;
    __device__ __forceinline__ int a_ld() const { return 1024; }
    __device__ __forceinline__ size_t a_tile_off(const Unit& u) const { return 0; }
    __device__ __forceinline__ unsigned a_row_off(const Unit& u, int r) const {
        const int tok = u.pm < 128 ? u.pm * 256 + r : srow[(u.pm - 128) * 256 + r];
        return (unsigned)tok * 2048u;
    }
    __device__ __forceinline__ const char* b_ptr(const Unit& u) const { return Bt + (size_t)u.pn * 256 * 1024 * 2; }
};
struct SchedDown {
    const int* texp; int ntiles, G, c; const char* Bt;
    __device__ __forceinline__ bool next(int i, Unit& u) const {
        const int L = i * G + c, pm = ((L >> 5) << 3) | (L & 7); if (pm >= 128 + ntiles) return false;
        const int e = pm < 128 ? 64 : __builtin_amdgcn_readfirstlane(texp[pm - 128]);
        u.pm = pm; u.pn = e * 4 + ((L >> 3) & 3); return true;
    }
    static constexpr bool GATHER = false;
    __device__ __forceinline__ int a_ld() const { return 256; }
    __device__ __forceinline__ size_t a_tile_off(const Unit& u) const { return (size_t)u.pm * 256 * 512; }
    __device__ __forceinline__ unsigned a_row_off(const Unit& u, int r) const { return 0u; }
    __device__ __forceinline__ const char* b_ptr(const Unit& u) const { return Bt + (size_t)u.pn * 256 * 256 * 2; }
};

__device__ __forceinline__ void phase_load_x(const Ctx& c, const Params& P) {
    const float* x = P.in[I_X]; float* X = (float*)(P.ws + WS_X); bf16_t* XB = (bf16_t*)(P.ws + WS_XB);
    const size_t n8 = (size_t)NTOK * 1024 / 8;
    for (size_t i = (size_t)c.wg * 512 + c.tid; i < n8; i += (size_t)c.nwg * 512) {
        const f32x4 a = *(const f32x4*)(x + i * 8), b = *(const f32x4*)(x + i * 8 + 4);
        *(u32x4*)(XB + i * 8) = pack8(a, b);
    }
}
__device__ __forceinline__ void phase_ln(const Ctx& c, const float* in, const float* g, const float* bta, float* outF, bf16_t* outB) {
    const int gw = c.wg * 8 + c.wave, nw = c.nwg * 8;
    f32x4 gg[4], bb[4];
#pragma unroll
    for (int q = 0; q < 4; ++q) { gg[q] = *(const f32x4*)(g + q * 256 + c.lane * 4); bb[q] = *(const f32x4*)(bta + q * 256 + c.lane * 4); }
    for (int row = gw; row < NTOK; row += nw) {
        const float* p = in + (size_t)row * 1024; f32x4 v[4]; float s = 0.f;
#pragma unroll
        for (int q = 0; q < 4; ++q) { v[q] = *(const f32x4*)(p + q * 256 + c.lane * 4); s += (v[q][0] + v[q][1]) + (v[q][2] + v[q][3]); }
        const float mu = wave_sum(s) * (1.0f / 1024.0f); float qq = 0.f;
#pragma unroll
        for (int q = 0; q < 4; ++q) { const f32x4 d = v[q] - mu; qq += (d[0] * d[0] + d[1] * d[1]) + (d[2] * d[2] + d[3] * d[3]); }
        const float rs = rsqrtf(wave_sum(qq) * (1.0f / 1024.0f) + LN_EPS);
#pragma unroll
        for (int q = 0; q < 4; ++q) { const f32x4 o = (v[q] - mu) * rs * gg[q] + bb[q];
            if (outF) *(f32x4*)(outF + (size_t)row * 1024 + q * 256 + c.lane * 4) = o;
            u32x2 w; w.x = cvt_pk_bf16(o[0], o[1]); w.y = cvt_pk_bf16(o[2], o[3]); *(u32x2*)(outB + (size_t)row * 1024 + q * 256 + c.lane * 4) = w; }
    }
}
__device__ __forceinline__ void phase_kvnorm(const Ctx& c, const Params& P, int l) {
    const float* M = (const float*)(P.ws + WS_MISC); bf16_t* CKV = (bf16_t*)(P.ws + WS_CKV); bf16_t* IK = (bf16_t*)(P.ws + WS_IDXK);
    const float* g = P.in[I_KVN] + l * 128; const float g0 = g[c.lane * 2], g1 = g[c.lane * 2 + 1];
    const int gw = c.wg * 8 + c.wave, nw = c.nwg * 8;
    for (int t = gw; t < NTOK; t += nw) {
        const f32x2 v = *(const f32x2*)(M + (size_t)t * 256 + c.lane * 2);
        const float ms = wave_sum(v[0] * v[0] + v[1] * v[1]) * (1.0f / 128.0f); const float rs = rsqrtf(ms + RMS_EPS);
        *(unsigned*)(CKV + (size_t)t * 128 + c.lane * 2) = cvt_pk_bf16(v[0] * rs * g0, v[1] * rs * g1);
        const float k = M[(size_t)t * 256 + 128 + c.lane]; IK[(size_t)t * 64 + c.lane] = f2bf(k);
    }
}
__device__ __forceinline__ void phase_s5_carry(const Ctx& c, const Params& P, int wg0, int nwgs) {
    if (c.wg < wg0 || c.wg >= wg0 + nwgs) return;
    LAS float* SE = (LAS float*)c.lds;
    const float* XL = (const float*)(P.ws + WS_XLOC); bf16_t* CUP = (bf16_t*)(P.ws + WS_CUP); const float* A32 = (const float*)(P.ws + WS_S5A32);
    for (int task = c.wg - wg0; task < 128; task += nwgs) {
        const int b = task >> 5, g = task & 31, p = c.tid & 63, seg = c.tid >> 6;
        const float ar = A32[(g * 64 + p) * 2], ai = A32[(g * 64 + p) * 2 + 1];
        const size_t rowb = (size_t)g * 1024 + b * 256 + seg * 32;
        float Lr[32], Li[32]; float sr = 0.f, si = 0.f;
#pragma unroll
        for (int i = 0; i < 32; ++i) { Lr[i] = sr; Li[i] = si; const f32x2 x = *(const f32x2*)(XL + (rowb + i) * 256 + p * 2);
            const float nr = ar * sr - ai * si + x[0], ni = ar * si + ai * sr + x[1]; sr = nr; si = ni; }
        SE[(seg * 64 + p) * 2] = sr; SE[(seg * 64 + p) * 2 + 1] = si;
        float br = ar, bi = ai;
#pragma unroll
        for (int q = 0; q < 5; ++q) { const float nr = br * br - bi * bi, ni = 2.f * br * bi; br = nr; bi = ni; }
        __syncthreads();
        float xr = 0.f, xi = 0.f;
        for (int s = 0; s < seg; ++s) { const float er = SE[(s * 64 + p) * 2], ei = SE[(s * 64 + p) * 2 + 1]; const float nr = br * xr - bi * xi + er, ni = br * xi + bi * xr + ei; xr = nr; xi = ni; }
        float pr = 1.f, pi = 0.f;
#pragma unroll
        for (int i = 0; i < 32; ++i) { const float vr = pr * xr - pi * xi + Lr[i], vi = pr * xi + pi * xr + Li[i];
            *(unsigned*)(CUP + (rowb + i) * 640 + 512 + p * 2) = cvt_pk_bf16(vr, vi);
            const float nr = pr * ar - pi * ai, ni = pr * ai + pi * ar; pr = nr; pi = ni; }
        __syncthreads();
    }
}

__device__ __forceinline__ bf16x8 ldfragL(const LAS bf16_t* base, int stride, int row, int k0) { return *(const LAS bf16x8*)(base + row * stride + k0); }
__device__ __forceinline__ bf16x8 ldfragG(const bf16_t* base, int stride, int row, int k0) { return *(const bf16x8*)(base + (size_t)row * stride + k0); }
__device__ __forceinline__ f32x4 mfma16(bf16x8 a, bf16x8 b, f32x4 c) { return __builtin_amdgcn_mfma_f32_16x16x32_bf16(a, b, c, 0, 0, 0); }

#ifndef DBG_TID
#define DBG_TID 0
#endif
constexpr int DN_QS = 136, DN_TS = 72, DN_MS = 68;
constexpr int DL_QN = 0;
constexpr int DL_KN = DL_QN + 64 * DN_QS * 2;
constexpr int DL_KTBG = DL_KN + 128 * DN_TS * 2;
constexpr int DL_KTDEC = DL_KTBG + 128 * DN_TS * 2;
constexpr int DL_VTB = DL_KTDEC + 128 * DN_TS * 2;
constexpr int DL_MF = DL_VTB + 128 * DN_TS * 2;
constexpr int DL_QK = DL_MF + 128 * DN_TS * 2;
constexpr int DL_TB = DL_QK + 64 * DN_TS * 2;
constexpr int DL_SC = DL_TB + 64 * DN_TS * 2;
constexpr int DL_END = DL_SC + 5 * 64 * 4;
static_assert(64 * DN_MS * 4 <= 128 * DN_TS * 2 && 64 * DN_QS * 2 <= 128 * DN_TS * 2 && DL_END <= LDS_BYTES, "deltanet LDS map");

__device__ __forceinline__ void phase_dn_prep(const Ctx& c, const Params& P, int l) {
    LAS bf16_t* QN = (LAS bf16_t*)(c.lds + DL_QN); LAS bf16_t* KN = (LAS bf16_t*)(c.lds + DL_KN); LAS bf16_t* WT = KN;
    LAS bf16_t* KTBG = (LAS bf16_t*)(c.lds + DL_KTBG); LAS bf16_t* KTDEC = (LAS bf16_t*)(c.lds + DL_KTDEC); LAS bf16_t* VTB = (LAS bf16_t*)(c.lds + DL_VTB);
    LAS float* MF = (LAS float*)(c.lds + DL_MF); LAS bf16_t* UT = (LAS bf16_t*)(c.lds + DL_MF);
    LAS bf16_t* QK = (LAS bf16_t*)(c.lds + DL_QK); LAS bf16_t* TB = (LAS bf16_t*)(c.lds + DL_TB);
    LAS float* GC = (LAS float*)(c.lds + DL_SC); LAS float* BETA = GC + 64; LAS float* EGC = GC + 128; LAS float* EDEC = GC + 192; LAS float* GLAST = GC + 256;
    const bf16_t* BQKV = (const bf16_t*)(P.ws + WS_BQKV); const float* MISC = (const float*)(P.ws + WS_MISC);
    const float* conv = P.in[I_BCONV] + (size_t)l * 4 * 1536;
    const int lane = c.lane, w = c.wave, fr = lane & 15, fq = lane >> 4;
    for (int unit = c.wg; unit < 2048; unit += c.nwg) {
        const int b = unit >> 9, h = (unit >> 7) & 3, n = unit & 127;
        const size_t tok0 = (size_t)b * 8192 + n * 64;
        if (w == 0) {
            const float a = MISC[(tok0 + lane) * 256 + 200 + h], bb = MISC[(tok0 + lane) * 256 + 204 + h];
            const float xx = a + P.in[I_BDTB][l * 4 + h];
            const float sp = fmaxf(xx, 0.f) + log1pf(__expf(-fabsf(xx)));
            const float g = -__expf(P.in[I_BALOG][l * 4 + h]) * sp;
            float cs = g;
#pragma unroll
            for (int o = 1; o < 64; o <<= 1) { const float t = shf(cs, lane - o); if (lane >= o) cs += t; }
            const float last = shf(cs, 63);
            GC[lane] = cs; BETA[lane] = sigmoidf_(bb); EGC[lane] = __expf(cs); EDEC[lane] = __expf(last - cs); if (lane == 0) GLAST[0] = __expf(last);
        }
        __syncthreads();
        {
            float cw[3][4][2], hx[3][3][2];
#pragma unroll
            for (int s = 0; s < 3; ++s) { const int col = s * 512 + h * 128 + 2 * lane;
#pragma unroll
                for (int j = 0; j < 4; ++j) { cw[s][j][0] = conv[j * 1536 + col]; cw[s][j][1] = conv[j * 1536 + col + 1]; }
#pragma unroll
                for (int d = 0; d < 3; ++d) { const int pos = n * 64 + 8 * w - 3 + d; unsigned v = 0u;
                    if (pos >= 0) v = *(const unsigned*)(BQKV + ((size_t)b * 8192 + pos) * 1536 + col);
                    hx[s][d][0] = bflo(v); hx[s][d][1] = bfhi(v); } }
#pragma unroll
            for (int i = 0; i < 8; ++i) { const int t = 8 * w + i; float y[3][2];
#pragma unroll
                for (int s = 0; s < 3; ++s) { const int col = s * 512 + h * 128 + 2 * lane; const unsigned v = *(const unsigned*)(BQKV + (tok0 + t) * 1536 + col); const float c0 = bflo(v), c1 = bfhi(v);
                    const float z0 = cw[s][0][0] * hx[s][0][0] + cw[s][1][0] * hx[s][1][0] + cw[s][2][0] * hx[s][2][0] + cw[s][3][0] * c0;
                    const float z1 = cw[s][0][1] * hx[s][0][1] + cw[s][1][1] * hx[s][1][1] + cw[s][2][1] * hx[s][2][1] + cw[s][3][1] * c1;
                    y[s][0] = siluf_(z0); y[s][1] = siluf_(z1);
                    hx[s][0][0] = hx[s][1][0]; hx[s][0][1] = hx[s][1][1]; hx[s][1][0] = hx[s][2][0]; hx[s][1][1] = hx[s][2][1]; hx[s][2][0] = c0; hx[s][2][1] = c1; }
                const float rq = rsqrtf(wave_sum(y[0][0] * y[0][0] + y[0][1] * y[0][1]) + RMS_EPS) * 0.08838834764831845f;
                const float rk = rsqrtf(wave_sum(y[1][0] * y[1][0] + y[1][1] * y[1][1]) + RMS_EPS);
                const float q0 = y[0][0] * rq, q1 = y[0][1] * rq, k0 = y[1][0] * rk, k1 = y[1][1] * rk;
                const float bt = BETA[t], eg = EGC[t], ed = EDEC[t];
                *(LAS unsigned*)(QN + t * DN_QS + 2 * lane) = cvt_pk_bf16(q0, q1);
                *(LAS unsigned*)(KN + t * DN_QS + 2 * lane) = cvt_pk_bf16(k0, k1);
                KTBG[(2 * lane) * DN_TS + t] = f2bf(k0 * bt * eg); KTBG[(2 * lane + 1) * DN_TS + t] = f2bf(k1 * bt * eg);
                KTDEC[(2 * lane) * DN_TS + t] = f2bf(k0 * ed); KTDEC[(2 * lane + 1) * DN_TS + t] = f2bf(k1 * ed);
                VTB[(2 * lane) * DN_TS + t] = f2bf(y[2][0] * bt); VTB[(2 * lane + 1) * DN_TS + t] = f2bf(y[2][1] * bt);
            }
        }
        __syncthreads();
        {
            const int rt = w & 3; const bool isqk = w >= 4; const LAS bf16_t* Asrc = isqk ? QN : KN;
            bf16x8 af[4];
#pragma unroll
            for (int ks = 0; ks < 4; ++ks) af[ks] = ldfragL(Asrc, DN_QS, rt * 16 + fr, ks * 32 + fq * 8);
            for (int ct = 0; ct < 4; ++ct) {
                f32x4 acc = (f32x4){0.f, 0.f, 0.f, 0.f};
                if (ct <= rt) {
#pragma unroll
                    for (int ks = 0; ks < 4; ++ks) acc = mfma16(af[ks], ldfragL(KN, DN_QS, ct * 16 + fr, ks * 32 + fq * 8), acc);
                }
                const int j = ct * 16 + fr; const float gj = GC[j];
#pragma unroll
                for (int r = 0; r < 4; ++r) { const int i = rt * 16 + 4 * fq + r; const float dec = __expf(fminf(GC[i] - gj, 0.f));
                    if (isqk) QK[i * DN_TS + j] = f2bf(i >= j ? acc[r] * dec : 0.f);
                    else MF[i * DN_MS + j] = (i > j) ? BETA[i] * acc[r] * dec : 0.f; }
            }
        }
        __syncthreads();
        {
            LAS float* TF = (LAS float*)KN;
            LAS float* SW = (LAS float*)(c.lds + DL_END + 64) + w * 272;
            if (w < 4) {
                const int I = w; float t[16];
#pragma unroll
                for (int i = 0; i < 16; ++i) { float sacc = (i == fr) ? 1.f : 0.f;
#pragma unroll
                    for (int j = 0; j < i; ++j) sacc -= MF[(16 * I + i) * DN_MS + 16 * I + j] * t[j];
                    t[i] = sacc; }
                if (fq == 0) {
#pragma unroll
                    for (int i = 0; i < 16; ++i) { TF[(16 * I + i) * DN_MS + 16 * I + fr] = t[i]; TB[(16 * I + i) * DN_TS + 16 * I + fr] = f2bf(t[i]); } }
            } else {
                for (int e = (w - 4) * 64 + lane; e < 4096; e += 256) { const int i = e >> 6, j = e & 63; if ((j >> 4) > (i >> 4)) TB[i * DN_TS + j] = 0; }
            }
            __syncthreads();
#pragma unroll
            for (int d = 1; d < 4; ++d) {
                if (w < 4 - d) {
                    const int J = w, I = w + d; f32x4 acc = (f32x4){0.f, 0.f, 0.f, 0.f};
                    for (int K = J; K < I; ++K)
#pragma unroll
                        for (int ks = 0; ks < 4; ++ks) acc = __builtin_amdgcn_mfma_f32_16x16x4f32(MF[(16 * I + fr) * DN_MS + 16 * K + 4 * ks + fq], TF[(16 * K + 4 * ks + fq) * DN_MS + 16 * J + fr], acc, 0, 0, 0);
#pragma unroll
                    for (int r = 0; r < 4; ++r) SW[(4 * fq + r) * 17 + fr] = acc[r];
                    asm volatile("s_waitcnt lgkmcnt(0)" ::: "memory");
                    f32x4 acc2 = (f32x4){0.f, 0.f, 0.f, 0.f};
#pragma unroll
                    for (int ks = 0; ks < 4; ++ks) acc2 = __builtin_amdgcn_mfma_f32_16x16x4f32(TF[(16 * I + fr) * DN_MS + 16 * I + 4 * ks + fq], SW[(4 * ks + fq) * 17 + fr], acc2, 0, 0, 0);
#pragma unroll
                    for (int r = 0; r < 4; ++r) { TF[(16 * I + 4 * fq + r) * DN_MS + 16 * J + fr] = -acc2[r]; TB[(16 * I + 4 * fq + r) * DN_TS + 16 * J + fr] = f2bf(-acc2[r]); }
                }
                __syncthreads();
            }
        }
#if DBG_TID
        {
            LAS int* FL = (LAS int*)(c.lds + DL_END);
            if (c.tid == 0) FL[0] = 0;
            __syncthreads();
            int f = 0;
            auto bad16 = [](bf16_t v) { return (v & 0x7f80) == 0x7f80; };
            auto bad32 = [](float v) { return (__float_as_uint(v) & 0x7f800000u) == 0x7f800000u; };
            for (int i = c.tid; i < 64; i += 512) { if (bad32(GC[i]) || bad32(EGC[i]) || bad32(EDEC[i]) || bad32(BETA[i])) f |= 1; }
            for (int i = c.tid; i < 64 * 128; i += 512) { const int r = i >> 7, cc = i & 127; if (bad16(QN[r * DN_QS + cc])) f |= 2; }
            for (int i = c.tid; i < 128 * 64; i += 512) { const int r = i >> 6, cc = i & 63; if (bad16(KTBG[r * DN_TS + cc])) f |= 4; if (bad16(KTDEC[r * DN_TS + cc])) f |= 8; if (bad16(VTB[r * DN_TS + cc])) f |= 16; }
            for (int i = c.tid; i < 64 * 64; i += 512) { const int r = i >> 6, cc = i & 63; if (bad32(MF[r * DN_MS + cc])) f |= 32; if (bad16(QK[r * DN_TS + cc])) f |= 64; if (bad16(TB[r * DN_TS + cc])) f |= 128; }
            if (f) __hip_atomic_fetch_or(&FL[0], f, __ATOMIC_RELAXED, __HIP_MEMORY_SCOPE_WORKGROUP);
            __syncthreads();
        }
#endif
        {
#pragma unroll
            for (int q = 0; q < 8; ++q) { const int tile = w * 8 + q, which = tile >> 5, it = (tile >> 3) & 3, dt = tile & 7;
                const LAS bf16_t* Bsrc = which ? VTB : KTBG; f32x4 acc = (f32x4){0.f, 0.f, 0.f, 0.f};
#pragma unroll
                for (int ks = 0; ks < 2; ++ks) acc = mfma16(ldfragL(TB, DN_TS, it * 16 + fr, ks * 32 + fq * 8), ldfragL(Bsrc, DN_TS, dt * 16 + fr, ks * 32 + fq * 8), acc);
                LAS bf16_t* dst = (which ? UT : WT) + (dt * 16 + fr) * DN_TS + it * 16 + 4 * fq;
                u32x2 pk; pk.x = cvt_pk_bf16(acc[0], acc[1]); pk.y = cvt_pk_bf16(acc[2], acc[3]); *(LAS u32x2*)dst = pk; }
        }
        __syncthreads();
        {
            bf16_t* DNA = (bf16_t*)(P.ws + WS_DNA) + (size_t)unit * 128 * 128; float* DNB = (float*)(P.ws + WS_DNB) + (size_t)unit * 128 * 128;
            bf16_t* DNQ = (bf16_t*)(P.ws + WS_DNQ) + (size_t)unit * 64 * 128; float* DNO = (float*)(P.ws + WS_DNO) + (size_t)unit * 64 * 128;
            const float glast = GLAST[0];
            for (int q = 0; q < 24; ++q) { const int tile = w * 24 + q; f32x4 acc = (f32x4){0.f, 0.f, 0.f, 0.f};
                if (tile < 64) {
                    const int mt = tile >> 3, nt = tile & 7;
#pragma unroll
                    for (int ks = 0; ks < 2; ++ks) acc = mfma16(ldfragL(WT, DN_TS, mt * 16 + fr, ks * 32 + fq * 8), ldfragL(KTDEC, DN_TS, nt * 16 + fr, ks * 32 + fq * 8), acc);
                    const int d1 = nt * 16 + fr, d2 = mt * 16 + 4 * fq; float v[4];
#pragma unroll
                    for (int r = 0; r < 4; ++r) v[r] = ((d1 == d2 + r) ? glast : 0.f) - acc[r];
#if DBG_TID
                    { const float fl = (float)((LAS int*)(c.lds + DL_END))[0]; v[0] = fl; v[1] = fl; v[2] = fl; v[3] = fl; }
#endif
                    u32x2 pk; pk.x = cvt_pk_bf16(v[0], v[1]); pk.y = cvt_pk_bf16(v[2], v[3]); *(u32x2*)(DNA + (size_t)d1 * 128 + d2) = pk;
                } else if (tile < 128) {
                    const int tt = tile - 64, mt = tt >> 3, nt = tt & 7;
#pragma unroll
                    for (int ks = 0; ks < 2; ++ks) acc = mfma16(ldfragL(KTDEC, DN_TS, mt * 16 + fr, ks * 32 + fq * 8), ldfragL(UT, DN_TS, nt * 16 + fr, ks * 32 + fq * 8), acc);
                    *(f32x4*)(DNB + (size_t)(tt * 64 + lane) * 4) = acc;
                } else if (tile < 160) {
                    const int tt = tile - 128, mt = tt >> 2, nt = tt & 3;
#pragma unroll
                    for (int ks = 0; ks < 2; ++ks) acc = mfma16(ldfragL(WT, DN_TS, mt * 16 + fr, ks * 32 + fq * 8), ldfragL(QK, DN_TS, nt * 16 + fr, ks * 32 + fq * 8), acc);
                    const int i = nt * 16 + fr, d = mt * 16 + 4 * fq; const float eg = EGC[i];
                    const u32x2 qw = *(const LAS u32x2*)(QN + i * DN_QS + d);
                    u32x2 pk; pk.x = cvt_pk_bf16(bflo(qw.x) * eg - acc[0], bfhi(qw.x) * eg - acc[1]); pk.y = cvt_pk_bf16(bflo(qw.y) * eg - acc[2], bfhi(qw.y) * eg - acc[3]);
                    *(u32x2*)(DNQ + (size_t)i * 128 + d) = pk;
                } else {
                    const int tt = tile - 160, mt = tt >> 2, nt = tt & 3;
#pragma unroll
                    for (int ks = 0; ks < 2; ++ks) acc = mfma16(ldfragL(UT, DN_TS, mt * 16 + fr, ks * 32 + fq * 8), ldfragL(QK, DN_TS, nt * 16 + fr, ks * 32 + fq * 8), acc);
                    *(f32x4*)(DNO + (size_t)(tt * 64 + lane) * 4) = acc;
                }
            }
        }
        __syncthreads();
    }
}

__device__ __forceinline__ void phase_dn_scan(const Ctx& c, const Params& P, int nwgs) {
    if (c.wg >= nwgs) return;
    LAS bf16_t* ST = (LAS bf16_t*)c.lds;
    const int lane = c.lane, w = c.wave, fr = lane & 15, fq = lane >> 4;
    for (int task = c.wg; task < 64; task += nwgs) {
        const int bh = task >> 2, sl = task & 3;
        for (int i = c.tid; i < 2 * 32 * DN_QS / 2; i += 512) ((LAS unsigned*)ST)[i] = 0u;
        __syncthreads();
        const bf16_t* DNA = (const bf16_t*)(P.ws + WS_DNA) + (size_t)bh * 128 * 128 * 128; const float* DNB = (const float*)(P.ws + WS_DNB) + (size_t)bh * 128 * 128 * 128;
        bf16_t* DNS = (bf16_t*)(P.ws + WS_DNS) + (size_t)bh * 128 * 128 * 128;
        { const int dvl = fr + 16 * (w & 1), d1 = 32 * (w >> 1) + fq * 8;
          *(u32x4*)(DNS + (size_t)(sl * 32 + dvl) * 128 + d1) = (u32x4){0u, 0u, 0u, 0u}; }
        constexpr int PF = 4;
        bf16x8 af[PF][4]; f32x4 bi[PF][2];
#pragma unroll
        for (int p = 0; p < PF; ++p) {
#pragma unroll
            for (int ks = 0; ks < 4; ++ks) af[p][ks] = ldfragG(DNA + (size_t)p * 128 * 128, 128, w * 16 + fr, ks * 32 + fq * 8);
#pragma unroll
            for (int nt = 0; nt < 2; ++nt) bi[p][nt] = *(const f32x4*)(DNB + (size_t)p * 128 * 128 + (size_t)((w * 8 + sl * 2 + nt) * 64 + lane) * 4);
        }
#pragma unroll
        for (int n = 0; n < 127; ++n) {
            const int p = n % PF;
            const LAS bf16_t* cur = ST + (n & 1) * 32 * DN_QS; LAS bf16_t* nxt = ST + ((n + 1) & 1) * 32 * DN_QS;
            f32x4 acc[2] = {bi[p][0], bi[p][1]};
            bf16x8 a2[4];
#pragma unroll
            for (int ks = 0; ks < 4; ++ks) a2[ks] = af[p][ks];
            if (n + PF < 127) {
                const bf16_t* An = DNA + (size_t)(n + PF) * 128 * 128; const float* Bn = DNB + (size_t)(n + PF) * 128 * 128;
#pragma unroll
                for (int ks = 0; ks < 4; ++ks) af[p][ks] = ldfragG(An, 128, w * 16 + fr, ks * 32 + fq * 8);
#pragma unroll
                for (int nt = 0; nt < 2; ++nt) bi[p][nt] = *(const f32x4*)(Bn + (size_t)((w * 8 + sl * 2 + nt) * 64 + lane) * 4);
            }
            __builtin_amdgcn_sched_barrier(0);
#pragma unroll
            for (int nt = 0; nt < 2; ++nt)
#pragma unroll
                for (int ks = 0; ks < 4; ++ks) acc[nt] = mfma16(a2[ks], ldfragL(cur, DN_QS, nt * 16 + fr, ks * 32 + fq * 8), acc[nt]);
            bf16_t* Sg = DNS + (size_t)(n + 1) * 128 * 128;
#pragma unroll
            for (int nt = 0; nt < 2; ++nt) { u32x2 pk; pk.x = cvt_pk_bf16(acc[nt][0], acc[nt][1]); pk.y = cvt_pk_bf16(acc[nt][2], acc[nt][3]);
                *(LAS u32x2*)(nxt + (nt * 16 + fr) * DN_QS + w * 16 + 4 * fq) = pk;
                *(u32x2*)(Sg + (size_t)(sl * 32 + nt * 16 + fr) * 128 + w * 16 + 4 * fq) = pk; }
            asm volatile("s_waitcnt lgkmcnt(0)" ::: "memory"); __builtin_amdgcn_s_barrier(); asm volatile("" ::: "memory");
        }
        __syncthreads();
    }
}

__device__ __forceinline__ void phase_dn_out(const Ctx& c, const Params& P, int l) {
    const int lane = c.lane, fr = lane & 15, fq = lane >> 4;
    const bf16_t* BZ = (const bf16_t*)(P.ws + WS_BZ); bf16_t* YB = (bf16_t*)(P.ws + WS_YB); const float* gn = P.in[I_BONORM] + l * 128;
    for (int task = c.wg * 8 + c.wave; task < 2048 * 4; task += c.nwg * 8) {
        const int unit = task >> 2, it = task & 3, b = unit >> 9, h = (unit >> 7) & 3, n = unit & 127;
        const bf16_t* S = (const bf16_t*)(P.ws + WS_DNS) + (size_t)unit * 128 * 128; const bf16_t* Q = (const bf16_t*)(P.ws + WS_DNQ) + (size_t)unit * 64 * 128;
        const float* O = (const float*)(P.ws + WS_DNO) + (size_t)unit * 64 * 128;
        bf16x8 bq[4];
#pragma unroll
        for (int ks = 0; ks < 4; ++ks) bq[ks] = ldfragG(Q, 128, it * 16 + fr, ks * 32 + fq * 8);
        f32x4 acc[8]; float ss = 0.f;
#pragma unroll
        for (int mt = 0; mt < 8; ++mt) { acc[mt] = *(const f32x4*)(O + (size_t)((mt * 4 + it) * 64 + lane) * 4);
#pragma unroll
            for (int ks = 0; ks < 4; ++ks) acc[mt] = mfma16(ldfragG(S, 128, mt * 16 + fr, ks * 32 + fq * 8), bq[ks], acc[mt]);
            ss += (acc[mt][0] * acc[mt][0] + acc[mt][1] * acc[mt][1]) + (acc[mt][2] * acc[mt][2] + acc[mt][3] * acc[mt][3]); }
        ss += shf(ss, lane ^ 16); ss += shf(ss, lane ^ 32);
        const float rs = rsqrtf(ss * (1.0f / 128.0f) + RMS_EPS);
        const size_t tok = (size_t)b * 8192 + n * 64 + it * 16 + fr;
#pragma unroll
        for (int mt = 0; mt < 8; ++mt) { const int dv = mt * 16 + 4 * fq; const u32x2 zw = *(const u32x2*)(BZ + tok * 512 + h * 128 + dv); const f32x4 g4 = *(const f32x4*)(gn + dv);
            u32x2 pk; pk.x = cvt_pk_bf16(acc[mt][0] * rs * g4[0] * siluf_(bflo(zw.x)), acc[mt][1] * rs * g4[1] * siluf_(bfhi(zw.x)));
            pk.y = cvt_pk_bf16(acc[mt][2] * rs * g4[2] * siluf_(bflo(zw.y)), acc[mt][3] * rs * g4[3] * siluf_(bfhi(zw.y)));
            *(u32x2*)(YB + tok * 512 + h * 128 + dv) = pk; }
    }
}

__device__ __forceinline__ f32x16 mfma32(bf16x8 a, bf16x8 b, f32x16 c) { return __builtin_amdgcn_mfma_f32_32x32x16_bf16(a, b, c, 0, 0, 0); }

constexpr int IX_KS = 72;
__device__ __forceinline__ void phase_idx_scores(const Ctx& c, const Params& P, int b, size_t sc_off = WS_SCORES) {
    LAS bf16_t* KL = (LAS bf16_t*)c.lds;
    const bf16_t* IQ = (const bf16_t*)(P.ws + WS_IDXQ) + (size_t)b * 8192 * 512; const bf16_t* IK = (const bf16_t*)(P.ws + WS_IDXK) + (size_t)b * 8192 * 64;
    const float* MISC = (const float*)(P.ws + WS_MISC) + (size_t)b * 8192 * 256; float* SC = (float*)(P.ws + sc_off);
    const int lane = c.lane, w = c.wave, l31 = lane & 31, lh = lane >> 5;
    constexpr int NBLK = 64 * 65 / 2;
    const int blk0 = (int)((long)c.wg * NBLK / c.nwg), blk1 = (int)((long)(c.wg + 1) * NBLK / c.nwg);
    int qt = 0; while ((qt + 1) * (qt + 2) / 2 <= blk0) ++qt;
    int kb = blk0 - qt * (qt + 1) / 2;
    for (int blk = blk0; blk < blk1; ++blk) {
        LAS bf16_t* kl = KL + (blk & 1) * 128 * IX_KS;
        { const int key = c.tid >> 2, pc = c.tid & 3; const bf16_t* src = IK + (size_t)(kb * 128 + key) * 64 + pc * 16;
          const u32x4 a = *(const u32x4*)src, bq = *(const u32x4*)(src + 8);
          *(LAS u32x4*)(kl + key * IX_KS + pc * 16) = a; *(LAS u32x4*)(kl + key * IX_KS + pc * 16 + 8) = bq; }
        __syncthreads();
        for (int hp = 0; hp < 2; ++hp) {
            const int qlo = qt * 128 + w * 16 + hp * 8;
            bf16x8 af[2][4]; float wq[2][2][8];
#pragma unroll
            for (int at = 0; at < 2; ++at) { const int qq = ((l31 >> 2) & 1) + 2 * (l31 >> 4), hd = (l31 & 3) + 4 * ((l31 >> 3) & 1);
#pragma unroll
                for (int ks = 0; ks < 4; ++ks) af[at][ks] = *(const bf16x8*)(IQ + (size_t)(qlo + 4 * at + qq) * 512 + hd * 64 + ks * 16 + lh * 8);
#pragma unroll
                for (int sub = 0; sub < 2; ++sub) { const float* wp = MISC + (size_t)(qlo + 4 * at + lh + 2 * sub) * 256 + 192; const f32x4 w0 = *(const f32x4*)wp, w1 = *(const f32x4*)(wp + 4);
                    wq[at][sub][0] = w0[0]; wq[at][sub][1] = w0[1]; wq[at][sub][2] = w0[2]; wq[at][sub][3] = w0[3]; wq[at][sub][4] = w1[0]; wq[at][sub][5] = w1[1]; wq[at][sub][6] = w1[2]; wq[at][sub][7] = w1[3]; } }
            for (int kt = 0; kt < 4; ++kt) {
                const int key0 = kb * 128 + kt * 32;
                if (key0 > qlo + 7) break;
                bf16x8 bf[4];
#pragma unroll
                for (int ks = 0; ks < 4; ++ks) bf[ks] = *(const LAS bf16x8*)(kl + (kt * 32 + l31) * IX_KS + ks * 16 + lh * 8);
#pragma unroll
                for (int at = 0; at < 2; ++at) {
                    f32x16 acc;
#pragma unroll
                    for (int q = 0; q < 16; ++q) acc[q] = 0.f;
#pragma unroll
                    for (int ks = 0; ks < 4; ++ks) acc = mfma32(af[at][ks], bf[ks], acc);
                    float s0 = 0.f, s1 = 0.f;
#pragma unroll
                    for (int hd = 0; hd < 8; ++hd) { s0 += wq[at][0][hd] * fmaxf(acc[hd], 0.f); s1 += wq[at][1][hd] * fmaxf(acc[8 + hd], 0.f); }
                    const int q0 = qlo + 4 * at + lh;
                    SC[(size_t)q0 * 8192 + key0 + l31] = s0; SC[(size_t)(q0 + 2) * 8192 + key0 + l31] = s1;
                }
            }
        }
        ++kb; if (kb > qt) { kb = 0; ++qt; }
    }
    __syncthreads();
}

__device__ __forceinline__ unsigned ord_key(float v) { const unsigned bits = __float_as_uint(v + 0.0f); return bits ^ ((bits >> 31) ? 0xFFFFFFFFu : 0x80000000u); }
__device__ __forceinline__ int mbcnt64(unsigned long long m) { return (int)__builtin_amdgcn_mbcnt_hi((unsigned)(m >> 32), __builtin_amdgcn_mbcnt_lo((unsigned)m, 0u)); }
constexpr int SEL_CAP = 1024;
__device__ __forceinline__ void phase_select(const Ctx& c, const Params& P, int b, size_t sc_off = WS_SCORES) {
    const float* SC = (const float*)(P.ws + sc_off); int* SEL = (int*)(P.ws + WS_SEL) + (size_t)b * 8192 * 256;
    const int lane = c.lane;
    LAS unsigned* CU = (LAS unsigned*)(c.lds + c.wave * (SEL_CAP * 8)); LAS int* CI = (LAS int*)(CU + SEL_CAP);
    for (int t = c.wg * 8 + c.wave; t < 8192; t += c.nwg * 8) {
        int* out = SEL + (size_t)t * 256;
        if (t < 256) { for (int i = lane; i < 256; i += 64) out[i] = i <= t ? i : 0; continue; }
        const float* row = SC + (size_t)t * 8192; const int n = t + 1, ngrp = (n + 63) >> 6;
        unsigned tau0 = 1u; int ks = 0, msamp = 0; unsigned su[8];
        if (n > SEL_CAP) {
            msamp = 512;
#pragma unroll
            for (int q = 0; q < 8; ++q) { const int sidx = (int)(((long)(lane + 64 * q) * n) >> 9); su[q] = ord_key(row[sidx]); }
            ks = (int)((448l * 512 + n - 1) / n); if (ks < 1) ks = 1;
        }
        int C = 0; bool ok = false;
        for (int attempt = 0; attempt < 5 && !ok; ++attempt) {
            if (n > SEL_CAP) {
                unsigned prefix = 0u;
                for (int bit = 31; bit >= 0; --bit) { const unsigned cand = prefix | (1u << bit); int cnt = 0;
#pragma unroll
                    for (int q = 0; q < 8; ++q) cnt += __popcll(__ballot(su[q] >= cand));
                    if (cnt >= ks) prefix = cand; }
                tau0 = prefix;
            }
            C = 0; bool over = false;
            const int nv4 = (n + 255) >> 8;
            for (int g0 = 0; g0 < nv4; g0 += 16) {
                f32x4 v4[16];
#pragma unroll
                for (int k = 0; k < 16; ++k) { v4[k] = (f32x4){0.f, 0.f, 0.f, 0.f}; if (g0 + k < nv4) v4[k] = *(const f32x4*)(row + (g0 + k) * 256 + lane * 4); }
#pragma unroll
                for (int k = 0; k < 16; ++k) {
                    if (g0 + k < nv4) {
                        const int idx0 = (g0 + k) * 256 + lane * 4; unsigned uq[4]; bool f[4]; int pre = 0, tot = 0;
#pragma unroll
                        for (int q = 0; q < 4; ++q) { uq[q] = (idx0 + q <= t) ? ord_key(v4[k][q]) : 0u; f[q] = uq[q] >= tau0; const unsigned long long m = __ballot(f[q]); pre += mbcnt64(m); tot += __popcll(m); }
                        int pos = C + pre;
#pragma unroll
                        for (int q = 0; q < 4; ++q) { if (f[q]) { if (pos < SEL_CAP) { CU[pos] = uq[q]; CI[pos] = idx0 + q; } ++pos; } }
                        C += tot;
                    }
                }
            }
            over = C > SEL_CAP;
            if (over) { ks = ks > 1 ? ks >> 1 : 1; if (n <= SEL_CAP) break; }
            else if (C < 256) { ks = ks * 2 + 8; if (ks > msamp) ks = msamp; if (n <= SEL_CAP) break; }
            else ok = true;
        }
        asm volatile("s_waitcnt lgkmcnt(0)" ::: "memory");
        if (ok) {
            unsigned cu[16];
#pragma unroll
            for (int q = 0; q < 16; ++q) { const int ci = lane + 64 * q; cu[q] = ci < C ? CU[ci] : 0u; }
            unsigned prefix = 0u;
            for (int bit = 31; bit >= 0; --bit) { const unsigned cand = prefix | (1u << bit); int cnt = 0;
#pragma unroll
                for (int q = 0; q < 16; ++q) cnt += __popcll(__ballot(cu[q] >= cand));
                if (cnt >= 256) prefix = cand;
                if (cnt == 256) break; }
            int cgt = 0;
#pragma unroll
            for (int q = 0; q < 16; ++q) cgt += __popcll(__ballot(cu[q] > prefix));
            const int need_eq = 256 - cgt; int obase = 0, eqseen = 0;
#pragma unroll
            for (int q = 0; q < 16; ++q) { const bool gt = cu[q] > prefix, eq = cu[q] == prefix; const unsigned long long meq = __ballot(eq);
                const bool take = gt || (eq && (eqseen + mbcnt64(meq)) < need_eq); const unsigned long long mt = __ballot(take);
                if (take) out[obase + mbcnt64(mt)] = CI[lane + 64 * q];
                obase += __popcll(mt); eqseen += __popcll(meq); }
        } else {
            unsigned prefix = 0u;
            for (int bit = 31; bit >= 0; --bit) { const unsigned cand = prefix | (1u << bit); int cnt = 0;
                for (int g = 0; g < ngrp; ++g) { const int idx = g * 64 + lane; const unsigned u = idx <= t ? ord_key(row[idx]) : 0u; cnt += __popcll(__ballot(u >= cand)); }
                if (cnt >= 256) prefix = cand;
                if (cnt == 256) break; }
            int cgt = 0;
            for (int g = 0; g < ngrp; ++g) { const int idx = g * 64 + lane; const unsigned u = idx <= t ? ord_key(row[idx]) : 0u; cgt += __popcll(__ballot(u > prefix)); }
            const int need_eq = 256 - cgt; int obase = 0, eqseen = 0;
            for (int g = 0; g < ngrp; ++g) { const int idx = g * 64 + lane; const unsigned u = idx <= t ? ord_key(row[idx]) : 0u;
                const bool gt = u > prefix, eq = u == prefix; const unsigned long long meq = __ballot(eq);
                const bool take = gt || (eq && (eqseen + mbcnt64(meq)) < need_eq); const unsigned long long mt = __ballot(take);
                if (take) out[obase + mbcnt64(mt)] = idx;
                obase += __popcll(mt); eqseen += __popcll(meq); }
        }
    }
    __syncthreads();
}

__device__ __forceinline__ unsigned off_b(unsigned row, unsigned ch) { return 256u * row + 16u * (ch ^ (((row & 3u) << 2) | ((row >> 2) & 3u))); }
__device__ __forceinline__ unsigned rho_of(unsigned kap) { return (kap & 32u) | (((kap >> 2) & 3u) << 3) | (((kap >> 4) & 1u) << 2) | (kap & 3u); }
__device__ __forceinline__ void tr_read4(unsigned a0, unsigned a1, unsigned a2, unsigned a3, bf16x8& x, bf16x8& y) {
    u32x2 r0, r1, r2, r3;
    asm volatile("ds_read_b64_tr_b16 %0, %4\n\tds_read_b64_tr_b16 %1, %5\n\tds_read_b64_tr_b16 %2, %6\n\tds_read_b64_tr_b16 %3, %7\n\ts_waitcnt lgkmcnt(0)"
                 : "=&v"(r0), "=&v"(r1), "=&v"(r2), "=&v"(r3) : "v"(a0), "v"(a1), "v"(a2), "v"(a3) : "memory");
    u32x4 xx; xx.x = r0.x; xx.y = r0.y; xx.z = r1.x; xx.w = r1.y; u32x4 yy; yy.x = r2.x; yy.y = r2.y; yy.z = r3.x; yy.w = r3.y;
    x = __builtin_bit_cast(bf16x8, xx); y = __builtin_bit_cast(bf16x8, yy);
}
constexpr int AT_TILE = 16384, AT_WAVE = AT_TILE + 256, AT_BIAS = 8 * AT_WAVE;
__device__ __forceinline__ void phase_attn(const Ctx& c, const Params& P) {
    const int lane = c.lane, w = c.wave, fr = lane & 15, fq = lane >> 4;
    LAS unsigned char* tile = c.lds + w * AT_WAVE; LAS int* kidx = (LAS int*)(tile + AT_TILE); LAS float* BT = (LAS float*)(c.lds + AT_BIAS);
    const unsigned tile_a = (unsigned)(size_t)tile;
    for (int i = c.tid; i < 129 * 8; i += 512) { const int d = i >> 3, h = i & 7; int bk;
        if (d < 16) bk = d; else { const int lg = 16 + (int)(logf((float)d / 16.0f) / 2.0794415416798357f * 16.0f); bk = lg < 31 ? lg : 31; }
        BT[i] = P.in[I_RELB][bk * 8 + h]; }
    __syncthreads();
    const bf16_t* QT = (const bf16_t*)(P.ws + WS_QT); const bf16_t* CKV = (const bf16_t*)(P.ws + WS_CKV); const int* SEL = (const int*)(P.ws + WS_SEL); bf16_t* CTX = (bf16_t*)(P.ws + WS_CTX);
    for (int t = c.wg * 8 + w; t < NTOK; t += c.nwg * 8) {
        const int b = t >> 13, s = t & 8191, nsel = s + 1 < 256 ? s + 1 : 256;
        bf16x8 qf[4];
#pragma unroll
        for (int ks = 0; ks < 4; ++ks) { u32x4 z = (u32x4){0u, 0u, 0u, 0u}; if (fr < 8) z = *(const u32x4*)(QT + (size_t)t * 1024 + fr * 128 + ks * 32 + fq * 8); qf[ks] = __builtin_bit_cast(bf16x8, z); }
        f32x4 ctx[8];
#pragma unroll
        for (int cc = 0; cc < 8; ++cc) ctx[cc] = (f32x4){0.f, 0.f, 0.f, 0.f};
        float mrun = -1e30f, lrun = 0.f;
        int nidx = lane < nsel ? SEL[(size_t)t * 256 + lane] : 0;
        u32x4 pre[8]; bool havepre = false;
        for (int ch = 0; ch * 64 < nsel; ++ch) {
            const bool more = (ch + 1) * 64 < nsel; int nnext = 0;
            if (more) { const int slot = (ch + 1) * 64 + lane; nnext = slot < nsel ? SEL[(size_t)t * 256 + slot] : 0; }
            kidx[lane] = nidx;
            asm volatile("s_waitcnt lgkmcnt(0)" ::: "memory");
#pragma unroll
            for (int it = 0; it < 16; ++it) { const int kap = it * 4 + fq; u32x4 v;
                if (it < 8 && havepre) v = pre[it & 7];
                else { const int ki = kidx[kap]; v = *(const u32x4*)(CKV + ((size_t)b * 8192 + ki) * 128 + fr * 8); }
                *(LAS u32x4*)(tile + off_b(rho_of(kap), fr)) = v; }
            asm volatile("s_waitcnt vmcnt(0) lgkmcnt(0)" ::: "memory");
            f32x4 sc[4];
#pragma unroll
            for (int rb = 0; rb < 4; ++rb) { sc[rb] = (f32x4){0.f, 0.f, 0.f, 0.f};
#pragma unroll
                for (int ks = 0; ks < 4; ++ks) { const bf16x8 a = *(const LAS bf16x8*)(tile + off_b(rho_of(16 * rb + fr), 4 * ks + fq)); sc[rb] = mfma16(a, qf[ks], sc[rb]); } }
            if (more) {
#pragma unroll
                for (int it = 0; it < 8; ++it) { const int ki = shi(nnext, it * 4 + fq); pre[it] = *(const u32x4*)(CKV + ((size_t)b * 8192 + ki) * 128 + fr * 8); } }
            havepre = more; nidx = nnext;
            float mx = -1e30f;
#pragma unroll
            for (int rb = 0; rb < 4; ++rb)
#pragma unroll
                for (int r = 0; r < 4; ++r) { const int kap = 16 * rb + 4 * fq + r; const int slot = ch * 64 + kap; int dist = s - kidx[kap]; dist = dist < 0 ? 0 : (dist > 128 ? 128 : dist);
                    float lg = sc[rb][r] * 0.125f + BT[dist * 8 + (fr & 7)]; lg = slot < nsel ? lg : -1e30f; sc[rb][r] = lg; mx = fmaxf(mx, lg); }
            mx = fmaxf(mx, shf(mx, lane ^ 16)); mx = fmaxf(mx, shf(mx, lane ^ 32));
            const float mnew = fmaxf(mrun, mx), alpha = __expf(mrun - mnew); mrun = mnew;
            float ps = 0.f; bf16x8 pf[2];
            { float pv[16];
#pragma unroll
              for (int rb = 0; rb < 4; ++rb)
#pragma unroll
                  for (int r = 0; r < 4; ++r) { const float p = sc[rb][r] > -1e29f ? __expf(sc[rb][r] - mnew) : 0.f; pv[rb * 4 + r] = p; ps += p; }
#pragma unroll
              for (int kk = 0; kk < 2; ++kk) { u32x4 pk; pk.x = cvt_pk_bf16(pv[kk * 8 + 0], pv[kk * 8 + 1]); pk.y = cvt_pk_bf16(pv[kk * 8 + 2], pv[kk * 8 + 3]); pk.z = cvt_pk_bf16(pv[kk * 8 + 4], pv[kk * 8 + 5]); pk.w = cvt_pk_bf16(pv[kk * 8 + 6], pv[kk * 8 + 7]);
                  pf[kk] = __builtin_bit_cast(bf16x8, pk); } }
            lrun = lrun * alpha + ps;
            float ar[4];
#pragma unroll
            for (int r = 0; r < 4; ++r) ar[r] = shf(alpha, (4 * fq + r) & 15);
#pragma unroll
            for (int cc = 0; cc < 8; ++cc) { ctx[cc][0] *= ar[0]; ctx[cc][1] *= ar[1]; ctx[cc][2] *= ar[2]; ctx[cc][3] *= ar[3]; }
#pragma unroll
            for (int kk = 0; kk < 2; ++kk)
#pragma unroll
                for (int c2 = 0; c2 < 4; ++c2) { bf16x8 b0, b1;
                    const unsigned q = fr >> 2, p = fr & 3;
                    const unsigned r0 = 32 * kk + 8 * fq + q, r1 = r0 + 4;
                    const unsigned a00 = tile_a + off_b(r0, 2 * (2 * c2) + (p >> 1)) + 8 * (p & 1), a01 = tile_a + off_b(r1, 2 * (2 * c2) + (p >> 1)) + 8 * (p & 1);
                    const unsigned a10 = tile_a + off_b(r0, 2 * (2 * c2 + 1) + (p >> 1)) + 8 * (p & 1), a11 = tile_a + off_b(r1, 2 * (2 * c2 + 1) + (p >> 1)) + 8 * (p & 1);
                    tr_read4(a00, a01, a10, a11, b0, b1);
                    ctx[2 * c2] = mfma16(pf[kk], b0, ctx[2 * c2]); ctx[2 * c2 + 1] = mfma16(pf[kk], b1, ctx[2 * c2 + 1]); }
        }
        lrun += shf(lrun, lane ^ 16); lrun += shf(lrun, lane ^ 32);
        const float linv = 1.0f / lrun; float li[4];
#pragma unroll
        for (int r = 0; r < 4; ++r) li[r] = shf(linv, (4 * fq + r) & 15);
        if (fq < 2) {
#pragma unroll
            for (int cc = 0; cc < 8; ++cc)
#pragma unroll
                for (int r = 0; r < 4; ++r) CTX[(size_t)t * 1024 + (4 * fq + r) * 128 + cc * 16 + fr] = f2bf(ctx[cc][r] * li[r]);
        }
    }
    __syncthreads();
}

__device__ __forceinline__ void phase_route(const Ctx& c, const Params& P, int l) {
    LAS int* LC = (LAS int*)c.lds;
    LAS int* LB = LC + 64;
    LAS int* LR = LC + 128;
    LAS int* LE = LC + 128 + 1024;
    const float* RL = (const float*)(P.ws + WS_RLOG); int* TOPI = (int*)(P.ws + WS_TOPI); float* TOPG = (float*)(P.ws + WS_TOPG); int* TOPR = (int*)(P.ws + WS_TOPR);
    unsigned* gcnt = (unsigned*)(P.ws + WS_CTL + CTL_MOECNT) + l * 64;
    const int lane = c.lane; const float rb = P.in[I_RTB][l * 64 + lane];
    for (int blk = c.wg; blk < NTOK / 128; blk += c.nwg) {
        if (c.tid < 64) LC[c.tid] = 0;
        __syncthreads();
        for (int i = 0; i < 16; ++i) { const int lt = c.wave * 16 + i, tok = blk * 128 + lt;
            const float sc = sigmoidf_(RL[(size_t)tok * 256 + lane]); float key = sc + rb; float mys = 0.f; int mye = 0; float ssum = 0.f;
#pragma unroll
            for (int j = 0; j < 8; ++j) { const float mx = wave_max(key); const unsigned long long m = __ballot(key == mx); const int src = m ? __ffsll((long long)m) - 1 : j;
                const float s = shf(sc, src); ssum += s; if (lane == j) { mys = s; mye = src; } if (lane == src) key = -1e30f; }
            if (lane < 8) { const int lr = __hip_atomic_fetch_add(&LC[mye], 1, __ATOMIC_RELAXED, __HIP_MEMORY_SCOPE_WORKGROUP); LR[lt * 8 + lane] = lr; LE[lt * 8 + lane] = mye;
                TOPI[(size_t)tok * 8 + lane] = mye; TOPG[(size_t)tok * 8 + lane] = mys / ssum * 2.5f; }
        }
        __syncthreads();
        if (c.tid < 64) LB[c.tid] = (int)atomicAdd(&gcnt[c.tid], (unsigned)LC[c.tid]);
        __syncthreads();
        for (int i = c.tid; i < 1024; i += 512) TOPR[(size_t)blk * 1024 + i] = LB[LE[i]] + LR[i];
        __syncthreads();
    }
}
__device__ __forceinline__ void phase_moe_book(const Ctx& c, const Params& P, int l) {
    LAS int* EB = (LAS int*)c.lds;
    const unsigned* gcnt = (const unsigned*)(P.ws + WS_CTL + CTL_MOECNT) + l * 64;
    int* SROW = (int*)(P.ws + WS_SROW); int* TEXP = (int*)(P.ws + WS_TEXP); int* EBASE = (int*)(P.ws + WS_EBASE);
    const int* TOPI = (const int*)(P.ws + WS_TOPI); const int* TOPR = (const int*)(P.ws + WS_TOPR);
    if (c.tid == 0) { int acc = 0; for (int e = 0; e < 64; ++e) { const int cnt = (int)__hip_atomic_load(&gcnt[e], __ATOMIC_RELAXED, __HIP_MEMORY_SCOPE_AGENT); EB[e] = acc; EB[64 + e] = cnt; acc += (cnt + 255) & ~255; } EB[128] = acc; }
    __syncthreads();
    if (c.wg == 0) { if (c.tid < 64) EBASE[c.tid] = EB[c.tid]; if (c.tid == 64) TEXP[MOE_TILES] = EB[128] >> 8; }
    for (int e = c.wg; e < 64; e += c.nwg) { const int base = EB[e], cnt = EB[64 + e], pad = (cnt + 255) & ~255;
        for (int i = cnt + c.tid; i < pad; i += 512) SROW[base + i] = 0;
        for (int i = c.tid; i < (pad >> 8); i += 512) TEXP[(base >> 8) + i] = e; }
    for (int i = c.wg * 512 + c.tid; i < NTOK * 8; i += c.nwg * 512) SROW[EB[TOPI[i]] + TOPR[i]] = i >> 3;
    __syncthreads();
}
__device__ __forceinline__ void phase_combine(const Ctx& c, const Params& P, int l, float* outF, bf16_t* outB) {
    const bf16_t* XMB = (const bf16_t*)(P.ws + WS_XMB); const bf16_t* YS = (const bf16_t*)(P.ws + WS_YS);
    const int* TOPI = (const int*)(P.ws + WS_TOPI); const int* TOPR = (const int*)(P.ws + WS_TOPR); const float* TOPG = (const float*)(P.ws + WS_TOPG); const int* EBASE = (const int*)(P.ws + WS_EBASE);
    const float* g = P.in[I_LN2G] + l * 1024; const float* bt = P.in[I_LN2B] + l * 1024; const int lane = c.lane;
    for (int tok = c.wg * 8 + c.wave; tok < NTOK; tok += c.nwg * 8) {
        f32x4 v[4];
#pragma unroll
        for (int q = 0; q < 4; ++q) { const u32x2 xw = *(const u32x2*)(XMB + (size_t)tok * 1024 + q * 256 + lane * 4); const f32x4 x = (f32x4){bflo(xw.x), bfhi(xw.x), bflo(xw.y), bfhi(xw.y)}; const u32x2 sh = *(const u32x2*)(YS + (size_t)tok * 1024 + q * 256 + lane * 4);
            v[q] = x * DN_ALPHA + (f32x4){bflo(sh.x), bfhi(sh.x), bflo(sh.y), bfhi(sh.y)}; }
        for (int k = 0; k < 8; ++k) { const int e = TOPI[(size_t)tok * 8 + k]; const size_t row = (size_t)NTOK + EBASE[e] + TOPR[(size_t)tok * 8 + k]; const float gt = TOPG[(size_t)tok * 8 + k];
#pragma unroll
            for (int q = 0; q < 4; ++q) { const u32x2 y = *(const u32x2*)(YS + row * 1024 + q * 256 + lane * 4); v[q] += (f32x4){bflo(y.x), bfhi(y.x), bflo(y.y), bfhi(y.y)} * gt; } }
        float s = 0.f;
#pragma unroll
        for (int q = 0; q < 4; ++q) s += (v[q][0] + v[q][1]) + (v[q][2] + v[q][3]);
        const float mu = wave_sum(s) * (1.0f / 1024.0f); float qq = 0.f;
#pragma unroll
        for (int q = 0; q < 4; ++q) { const f32x4 d = v[q] - mu; qq += (d[0] * d[0] + d[1] * d[1]) + (d[2] * d[2] + d[3] * d[3]); }
        const float rs = rsqrtf(wave_sum(qq) * (1.0f / 1024.0f) + LN_EPS);
#pragma unroll
        for (int q = 0; q < 4; ++q) { const f32x4 o = (v[q] - mu) * rs * *(const f32x4*)(g + q * 256 + lane * 4) + *(const f32x4*)(bt + q * 256 + lane * 4);
            if (outF) *(f32x4*)(outF + (size_t)tok * 1024 + q * 256 + lane * 4) = o;
            if (outB) { u32x2 wv; wv.x = cvt_pk_bf16(o[0], o[1]); wv.y = cvt_pk_bf16(o[2], o[3]); *(u32x2*)(outB + (size_t)tok * 1024 + q * 256 + lane * 4) = wv; } }
    }
}

constexpr int LDS_PARAM_OFF = LDS_BYTES - 1024;
__device__ __forceinline__ Params ld_params(LAS unsigned char* lds) {
    unsigned a_s = (unsigned)(size_t)lds + LDS_PARAM_OFF; asm volatile("" : "+s"(a_s) :: "memory");
    unsigned a_ = a_s; asm volatile("" : "+v"(a_));
    Params P; const LAS unsigned* src = (const LAS unsigned*)(size_t)a_;
#pragma unroll
    for (int i = 0; i < 33; ++i) { const unsigned lo = __builtin_amdgcn_readfirstlane(src[2 * i]), hi = __builtin_amdgcn_readfirstlane(src[2 * i + 1]); P.in[i] = (const float*)(const __attribute__((address_space(1))) float*)(((unsigned long long)hi << 32) | lo); }
    { const unsigned lo = __builtin_amdgcn_readfirstlane(src[66]), hi = __builtin_amdgcn_readfirstlane(src[67]); P.out = (float*)(__attribute__((address_space(1))) float*)(((unsigned long long)hi << 32) | lo); }
    { const unsigned lo = __builtin_amdgcn_readfirstlane(src[68]), hi = __builtin_amdgcn_readfirstlane(src[69]); P.ws = (unsigned char*)(__attribute__((address_space(1))) unsigned char*)(((unsigned long long)hi << 32) | lo); }
    return P;
}
__device__ __forceinline__ Ctx fresh_ctx(LAS unsigned char* lds, int wave) {
    Ctx c; int t = wave * 64 + (int)__builtin_amdgcn_mbcnt_hi(~0u, __builtin_amdgcn_mbcnt_lo(~0u, 0u)); asm volatile("" : "+v"(t)); c.tid = t; c.lane = t & 63; c.wave = __builtin_amdgcn_readfirstlane(t >> 6); c.wg = blockIdx.x; c.nwg = gridDim.x; c.lds = lds; return c;
}
#ifndef MK_DUMP_OFF
#define MK_DUMP_OFF WS_DNA
#define MK_DUMP_BF16 1
#define MK_DUMP_LD 1024
#endif
__device__ __forceinline__ void dbg_dump(const Ctx& c, const Params& P) {
    const size_t n = (size_t)NTOK * 1024;
    for (size_t i = (size_t)c.wg * 512 + c.tid; i < n; i += (size_t)c.nwg * 512)
    { const size_t row = i >> 10, col = i & 1023, j = row * MK_DUMP_LD + col;
        P.out[i] = col >= MK_DUMP_LD ? 0.f : (MK_DUMP_BF16 ? bf2f(((const bf16_t*)(P.ws + MK_DUMP_OFF))[j]) : ((const float*)(P.ws + MK_DUMP_OFF))[j]); }
}
#ifndef DUP_SEL
#define DUP_SEL 1
#define DUP_PREP 1
#define DUP_ATTN 1
#define DUP_P0 1
#define DUP_SCAN 1
#define DUP_SCORES 1
#endif
#ifndef MK_STOP_AFTER
#define MK_STOP_AFTER 100000
#endif
__global__ void __launch_bounds__(512, 2) hybrid_fwd(Params Pk) {
    extern __shared__ __attribute__((aligned(16))) unsigned char shm[];
    Ctx c0; c0.lds = (LAS unsigned char*)shm; c0.tid = threadIdx.x; c0.lane = c0.tid & 63; c0.wave = __builtin_amdgcn_readfirstlane(c0.tid >> 6); c0.wg = blockIdx.x; c0.nwg = gridDim.x;
#define CX (fresh_ctx(c0.lds, c0.wave))
    LAS unsigned* barw = (LAS unsigned*)(c0.lds + LDS_BYTES - 16);
    if (c0.tid == 0) { barw[0] = 0u; barw[1] = 0u; barw[2] = 0u; barw[3] = 0u; }
    if (c0.tid < 35) { LAS unsigned long long* d = (LAS unsigned long long*)(c0.lds + LDS_PARAM_OFF); d[c0.tid] = c0.tid < 33 ? (unsigned long long)Pk.in[c0.tid] : (c0.tid == 33 ? (unsigned long long)Pk.out : (unsigned long long)Pk.ws); }
    __syncthreads();
    XcdBarrier bar = xcd_barrier_post((unsigned*)(Pk.ws + WS_CTL + CTL_BAR), (volatile LAS unsigned*)barw, c0.tid);
#define PP (ld_params((CX).lds))
#define WSP (PP.ws)
#define GBAR() xcd_barrier_ni(bar.bar, bar.x, (unsigned)(size_t)bar.st, (CX).tid)
    phase_load_x(CX, PP);
    phase_p0(CX, PP, 0);
    GBAR();
#define LAYER_BODY(l) {\
        { const Ctx cc = CX; SchedPlain S; S.init(NTOK, NIN, 1024, WSP + WS_WIN, cc.nwg, cc.wg); EpiWin E; E.ws = WSP; pg8::gemm_phase(cc.lds, cc.wave, (const char*)(WSP + WS_XB), 1024, S, E); } \
        GBAR(); if ((l) * 100 + 2 >= MK_STOP_AFTER) { dbg_dump(CX, PP); return; } \
        phase_kvnorm(CX, PP, l); \
        for (int d_ = 0; d_ < DUP_PREP; ++d_) phase_dn_prep(CX, PP, l); \
        { const Ctx cc = CX; SchedGrouped S; S.init(32, 1024, 256, 512, WSP + WS_S5E, cc.nwg, cc.wg); S.lda = 640; EpiXloc E; E.O = (float*)(WSP + WS_XLOC); pg8::gemm_phase(cc.lds, cc.wave, (const char*)(WSP + WS_CUP), 512, S, E); } \
        GBAR(); if ((l) * 100 + 3 >= MK_STOP_AFTER) { dbg_dump(CX, PP); return; } \
          \
        if (c0.nwg > 64) { \
            if (c0.wg < 64) phase_dn_scan(CX, PP, 64); \
            else { phase_s5_carry(CX, PP, 64, c0.nwg - 64); Ctx c2 = CX; c2.wg -= 64; c2.nwg -= 64; phase_idx_scores(c2, PP, 0); } \
        } else { phase_dn_scan(CX, PP, c0.nwg); phase_s5_carry(CX, PP, 0, c0.nwg); phase_idx_scores(CX, PP, 0); } \
        phase_p0_experts(CX, PP, l); \
        GBAR(); if ((l) * 100 + 4 >= MK_STOP_AFTER) { dbg_dump(CX, PP); return; } \
        phase_dn_out(CX, PP, l); \
        { const Ctx cc = CX; SchedGrouped S; S.init(32, 1024, 512, 640, WSP + WS_S5TF, cc.nwg, cc.wg); S.lda = 640; EpiS5 E; E.O = (bf16_t*)(WSP + WS_YCPRE); pg8::gemm_phase(cc.lds, cc.wave, (const char*)(WSP + WS_CUP), 640, S, E); } \
        phase_select(CX, PP, 0); \
        GBAR(); if ((l) * 100 + 5 >= MK_STOP_AFTER) { dbg_dump(CX, PP); return; } \
          \
        phase_idx_scores(CX, PP, 1, WS_SCORES2); \
        GBAR(); if ((l) * 100 + 6 >= MK_STOP_AFTER) { dbg_dump(CX, PP); return; } \
        phase_idx_scores(CX, PP, 2, WS_SCORES); phase_select(CX, PP, 1, WS_SCORES2); \
        GBAR(); if ((l) * 100 + 7 >= MK_STOP_AFTER) { dbg_dump(CX, PP); return; } \
        phase_idx_scores(CX, PP, 3, WS_SCORES2); phase_select(CX, PP, 2, WS_SCORES); \
        GBAR(); if ((l) * 100 + 7 >= MK_STOP_AFTER) { dbg_dump(CX, PP); return; } \
        phase_select(CX, PP, 3, WS_SCORES2); \
        GBAR(); if ((l) * 100 + 7 >= MK_STOP_AFTER) { dbg_dump(CX, PP); return; } \
        for (int d_ = 0; d_ < DUP_ATTN; ++d_) phase_attn(CX, PP); \
        { const Ctx cc = CX; SchedPlain S; S.init(NTOK, 512, 512, WSP + WS_WGLU, cc.nwg, cc.wg); EpiGlu E; E.Y = (const bf16_t*)(WSP + WS_YCPRE); E.bias = PP.in[I_GLUB] + l * 512; E.O = (bf16_t*)(WSP + WS_YC); \
          pg8::gemm_phase(cc.lds, cc.wave, (const char*)(WSP + WS_YCPRE), 512, S, E); } \
        GBAR(); if ((l) * 100 + 8 >= MK_STOP_AFTER) { dbg_dump(CX, PP); return; } \
        { const Ctx cc = CX; SchedPlain S; S.init(NTOK, 1024, 1024, WSP + WS_WBRA, cc.nwg, cc.wg); EpiMerge<0> E; E.Mf = (float*)(WSP + WS_MERGED); E.Mb = (bf16_t*)(WSP + WS_MERGEDB); E.gates = (const bf16_t*)(WSP + WS_GATES); E.gcol0 = 0; \
          pg8::gemm_phase(cc.lds, cc.wave, (const char*)(WSP + WS_CTX), 1024, S, E); } \
        { const Ctx cc = CX; SchedMergeBC S; S.init(NTOK, 1024, 512, WSP + WS_WBRB, cc.nwg, cc.wg); S.offB = WS_YB; S.offC = WS_YC; S.BtB = (const char*)(WSP + WS_WBRB); S.BtC = (const char*)(WSP + WS_WBRC); \
          EpiMergeBC E; E.Mb = (bf16_t*)(WSP + WS_MERGEDB); E.gates = (const bf16_t*)(WSP + WS_GATES); pg8::gemm_phase(cc.lds, cc.wave, (const char*)WSP, 512, S, E); } \
        GBAR(); if ((l) * 100 + 9 >= MK_STOP_AFTER) { dbg_dump(CX, PP); return; } \
        { const Ctx cc = CX; SchedPlain S; S.init(NTOK, 1024, 1024, WSP + WS_WO, cc.nwg, cc.wg); EpiResid E; E.XB = (const bf16_t*)(WSP + WS_XB); E.O = (float*)(WSP + WS_XM); pg8::gemm_phase(cc.lds, cc.wave, (const char*)(WSP + WS_MERGEDB), 1024, S, E); } \
        GBAR(); if ((l) * 100 + 10 >= MK_STOP_AFTER) { dbg_dump(CX, PP); return; } \
        phase_ln(CX, (const float*)(WSP + WS_XM), PP.in[I_LN1G] + l * 1024, PP.in[I_LN1B] + l * 1024, (float*)nullptr, (bf16_t*)(WSP + WS_XMB)); \
        GBAR(); if ((l) * 100 + 11 >= MK_STOP_AFTER) { dbg_dump(CX, PP); return; } \
        { const Ctx cc = CX; SchedPlain S; S.init(NTOK, 256, 1024, WSP + WS_WRT, cc.nwg, cc.wg); EpiF32 E; E.O = (float*)(WSP + WS_RLOG); E.ld = 256; pg8::gemm_phase(cc.lds, cc.wave, (const char*)(WSP + WS_XMB), 1024, S, E); } \
        GBAR(); if ((l) * 100 + 12 >= MK_STOP_AFTER) { dbg_dump(CX, PP); return; } \
        phase_route(CX, PP, l); \
        GBAR(); if ((l) * 100 + 13 >= MK_STOP_AFTER) { dbg_dump(CX, PP); return; } \
        phase_moe_book(CX, PP, l); if ((l) + 1 < DEPTH) phase_p0(CX, PP, (l) + 1); \
        GBAR(); if ((l) * 100 + 14 >= MK_STOP_AFTER) { dbg_dump(CX, PP); return; } \
        { const Ctx cc = CX; SchedGU S; S.texp = (const int*)(WSP + WS_TEXP); S.srow = (const int*)(WSP + WS_SROW); S.ntiles = __builtin_amdgcn_readfirstlane(S.texp[MOE_TILES]); S.G = cc.nwg; S.c = cc.wg; S.Bt = (const char*)(WSP + WS_WGU); \
          EpiGU E; E.HS = (bf16_t*)(WSP + WS_HS); pg8::gemm_phase(cc.lds, cc.wave, (const char*)(WSP + WS_XMB), 1024, S, E); } \
        GBAR(); if ((l) * 100 + 15 >= MK_STOP_AFTER) { dbg_dump(CX, PP); return; } \
        { const Ctx cc = CX; SchedDown S; S.texp = (const int*)(WSP + WS_TEXP); S.ntiles = __builtin_amdgcn_readfirstlane(S.texp[MOE_TILES]); S.G = cc.nwg; S.c = cc.wg; S.Bt = (const char*)(WSP + WS_WDN); \
          EpiDown E; E.YS = (bf16_t*)(WSP + WS_YS); pg8::gemm_phase(cc.lds, cc.wave, (const char*)(WSP + WS_HS), 256, S, E); } \
        GBAR(); if ((l) * 100 + 16 >= MK_STOP_AFTER) { dbg_dump(CX, PP); return; } \
        if (l == DEPTH - 1) phase_combine(CX, PP, l, PP.out, (bf16_t*)nullptr); \
        else phase_combine(CX, PP, l, (float*)nullptr, (bf16_t*)(WSP + WS_XB)); \
        GBAR(); if ((l) * 100 + 17 >= MK_STOP_AFTER) { dbg_dump(CX, PP); return; } \
    }
    LAYER_BODY(0) LAYER_BODY(1) LAYER_BODY(2) LAYER_BODY(3)
#undef GBAR
#undef CX
#undef PP
#undef WSP
}

extern "C" void kernel_launch(void* const* d_in, const int* in_sizes, int n_in, void* d_out, int out_size, void* d_ws, size_t ws_size, hipStream_t stream) {
    static int grid = 0;
    if (grid == 0) {
        if (n_in != 33 || ws_size < WS_TOTAL) { fprintf(stderr, "kernel_launch: expected 33 inputs and >= %zu bytes of workspace; got %d inputs, %zu bytes\n", (size_t)WS_TOTAL, n_in, ws_size); grid = -1; return; }
        int dev = 0, cus = 0, per_cu = 0;
        if (hipGetDevice(&dev) != hipSuccess || hipDeviceGetAttribute(&cus, hipDeviceAttributeMultiprocessorCount, dev) != hipSuccess) { grid = -1; return; }
        if (hipFuncSetAttribute((const void*)hybrid_fwd, hipFuncAttributeMaxDynamicSharedMemorySize, LDS_BYTES) != hipSuccess) { fprintf(stderr, "kernel_launch: hipFuncSetAttribute failed\n"); grid = -1; return; }
        if (hipOccupancyMaxActiveBlocksPerMultiprocessor(&per_cu, (const void*)hybrid_fwd, 512, LDS_BYTES) != hipSuccess || per_cu < 1) { fprintf(stderr, "kernel_launch: occupancy query says %d\n", per_cu); per_cu = 1; }
        (void)hipGetLastError();
        grid = cus;
    }
    if (grid < 0) return;
    if (hipMemsetAsync((char*)d_ws + WS_CTL, 0, CTL_BYTES, stream) != hipSuccess) return;
    Params p{};
    for (int i = 0; i < 33; ++i) p.in[i] = (const float*)d_in[i];
    p.out = (float*)d_out; p.ws = (unsigned char*)d_ws;
    hipLaunchKernelGGL(hybrid_fwd, dim3(grid), dim3(512), LDS_BYTES, stream, p);
}
```

```cpp
#include <hip/hip_runtime.h>
#include <stdint.h>
#include <stdio.h>

#define LAS __attribute__((address_space(3)))
typedef unsigned short bf16_t;
typedef short bf16x8 __attribute__((ext_vector_type(8)));
typedef float f32x4 __attribute__((ext_vector_type(4)));
typedef float f32x16 __attribute__((ext_vector_type(16)));
typedef float f32x2 __attribute__((ext_vector_type(2)));
typedef unsigned u32x4 __attribute__((ext_vector_type(4)));
typedef unsigned u32x2 __attribute__((ext_vector_type(2)));

constexpr int D_MODEL = 1024, BATCH = 4, SEQ = 8192, DEPTH = 4, NTOK = BATCH * SEQ;
constexpr int D_IN = 6864;
constexpr float DN_ALPHA = 1.681792830507429f;
constexpr float LN_EPS = 1e-5f, RMS_EPS = 1e-6f;
constexpr int NWG_THREADS = 512;

typedef __bf16 bf16x2_t __attribute__((ext_vector_type(2)));
__device__ __forceinline__ unsigned cvt_pk_bf16(float lo, float hi) { const f32x2 v = {lo, hi}; const bf16x2_t r = __builtin_convertvector(v, bf16x2_t); return __builtin_bit_cast(unsigned, r); }
__device__ __forceinline__ bf16_t f2bf(float f) { unsigned u = __float_as_uint(f); u += 0x7FFFu + ((u >> 16) & 1u); return (bf16_t)(u >> 16); }
__device__ __forceinline__ float bf2f(bf16_t b) { return __uint_as_float(((unsigned)b) << 16); }
__device__ __forceinline__ float bflo(unsigned w) { return __uint_as_float(w << 16); }
__device__ __forceinline__ float bfhi(unsigned w) { return __uint_as_float(w & 0xffff0000u); }
__device__ __forceinline__ float sigmoidf_(float x) { return 1.0f / (1.0f + __expf(-x)); }
__device__ __forceinline__ float siluf_(float x) { return x / (1.0f + __expf(-x)); }
__device__ __forceinline__ int lane_opq() { int l = (int)__builtin_amdgcn_mbcnt_hi(~0u, __builtin_amdgcn_mbcnt_lo(~0u, 0u)); asm volatile("" : "+v"(l)); return l; }
__device__ __forceinline__ float shf(float v, int src) { return __int_as_float(__builtin_amdgcn_ds_bpermute(src << 2, __float_as_int(v))); }
__device__ __forceinline__ int shi(int v, int src) { return __builtin_amdgcn_ds_bpermute(src << 2, v); }
__device__ __forceinline__ float wave_sum(float v) {
    const int l = lane_opq();
#pragma unroll
    for (int o = 32; o >= 1; o >>= 1) v += shf(v, l ^ o);
    return v;
}
__device__ __forceinline__ float wave_max(float v) {
    const int l = lane_opq();
#pragma unroll
    for (int o = 32; o >= 1; o >>= 1) v = fmaxf(v, shf(v, l ^ o));
    return v;
}

#define XB_TMO      128
#define XB_XCNT(j)  (256  + 64 * (j))
#define XB_XSUB(j)  (1280 + 64 * (j))
#define XB_XGEN(j)  (2304 + 64 * (j))
#define XB_TOP      3328
#define XB_TOPGEN   3392
#define XCD_BAR_WORDS 3456
#define XB_SPIN_CAP (1u << 18)

__device__ __forceinline__ unsigned xb_ld(unsigned* p)              { return __hip_atomic_load(p, __ATOMIC_RELAXED, __HIP_MEMORY_SCOPE_AGENT); }
__device__ __forceinline__ unsigned xb_add(unsigned* p, unsigned v) { return __hip_atomic_fetch_add(p, v, __ATOMIC_RELAXED, __HIP_MEMORY_SCOPE_AGENT); }
__device__ __forceinline__ unsigned xb_xcc_id() { return (unsigned)__builtin_amdgcn_s_getreg((3 << 11) | 20) & 0xFu; }
#define XB_SPIN(cond, bar) do { unsigned _sp = 0; while (cond) { __builtin_amdgcn_s_sleep(1); \
    if ((++_sp & 255u) == 0u) { if (xb_ld(&(bar)[XB_TMO])) break; if (_sp > XB_SPIN_CAP) { atomicAdd(&(bar)[XB_TMO], 1u); break; } } } } while (0)

struct XcdBarrier { unsigned* bar; unsigned x; volatile LAS unsigned* st; };

__device__ __forceinline__ XcdBarrier xcd_barrier_post(unsigned* bar, volatile LAS unsigned* st, int tid) {
    XcdBarrier b; b.bar = bar; b.x = xb_xcc_id(); b.st = st;
    if (tid == 0) (void)xb_add(&bar[XB_XCNT(b.x)], 1u);
    return b;
}
__device__ __forceinline__ void xcd_barrier_complete(unsigned* bar, unsigned x, unsigned& nloc, unsigned& nx) {
    const unsigned G = gridDim.x * gridDim.y * gridDim.z;
    unsigned sum, cnt, mine, sp = 0u;
    for (;;) {
        sum = 0u; cnt = 0u; mine = 0u;
#pragma unroll
        for (unsigned j = 0; j < 16; ++j) { const unsigned c = xb_ld(&bar[XB_XCNT(j)]); sum += c; cnt += (c > 0u) ? 1u : 0u; mine = (j == x) ? c : mine; }
        if (sum == G) break;
        __builtin_amdgcn_s_sleep(1);
        if ((++sp & 255u) == 0u) { if (xb_ld(&bar[XB_TMO])) break; if (sp > XB_SPIN_CAP) { atomicAdd(&bar[XB_TMO], 1u); break; } }
    }
    nloc = mine > 0u ? mine : 1u; nx = cnt > 0u ? cnt : 1u;
}
__device__ __noinline__ void xcd_barrier_ni(unsigned* bar_, unsigned x_, unsigned st_, int tid) {
    XcdBarrier b; b.bar = bar_; b.x = x_; b.st = (volatile LAS unsigned*)(size_t)st_;
    asm volatile("s_waitcnt vmcnt(0)" ::: "memory");
    __syncthreads();
    if (tid == 0) {
        unsigned* bar = b.bar;
        __builtin_amdgcn_s_waitcnt(0);
        unsigned nloc = b.st[0], nx = b.st[1];
        if (nloc == 0u) { xcd_barrier_complete(bar, b.x, nloc, nx); b.st[0] = nloc; b.st[1] = nx; }
        const unsigned old = xb_add(&bar[XB_XSUB(b.x)], 1u);
        const unsigned gen = old / nloc;
        if (old + 1u == (gen + 1u) * nloc) {
            __builtin_amdgcn_fence(__ATOMIC_RELEASE, "agent");
            asm volatile("s_waitcnt vmcnt(0)" ::: "memory");
            const unsigned og = xb_add(&bar[XB_TOP], 1u);
            const unsigned tg = og / nx;
            if (og + 1u == (tg + 1u) * nx) xb_add(&bar[XB_TOPGEN], 1u);
            else XB_SPIN(xb_ld(&bar[XB_TOPGEN]) == tg, bar);
            __builtin_amdgcn_fence(__ATOMIC_ACQUIRE, "agent");
            xb_add(&bar[XB_XGEN(b.x)], 1u);
            asm volatile("s_waitcnt vmcnt(0)" ::: "memory");
        } else {
            XB_SPIN(xb_ld(&bar[XB_XGEN(b.x)]) == gen, bar);
            __builtin_amdgcn_fence(__ATOMIC_ACQUIRE, "agent");
            asm volatile("s_waitcnt vmcnt(0)" ::: "memory");
        }
    }
    __syncthreads();
}

namespace pg8 {
#ifndef PG8_A_AUX
#define PG8_A_AUX 0
#endif
constexpr int BM = 256, BK = 64, HALF = 128, HTB = HALF * BK * 2, STAGE_BYTES = 8 * HTB;
__device__ __forceinline__ int lds_byte(int r, int c) { const int st = (r >> 4) * 2 + (c >> 5), rr = r & 15, cc = c & 31, ob = rr * 64 + cc * 2; return st * 1024 + (ob ^ (((ob >> 9) & 1) << 5)); }
__device__ __forceinline__ void stage_rc(int b, int& R, int& C) { const int st = b / 1024, sb = b % 1024, swz = sb ^ (((sb >> 9) & 1) << 5); R = (st >> 1) * 16 + swz / 64; C = (st & 1) * 32 + (swz % 64) / 2; }
__device__ __forceinline__ int perm32(int rho) { const int n = rho >> 4, i = rho & 15; return 8 * (i >> 2) + 4 * n + (i & 3); }
struct Unit { int pm, pn; };

template <class Epi, class Sched>
__device__ __forceinline__ void gemm_phase(LAS unsigned char* lds, const int wave_, const char* Abase, const int K, const Sched& S, const Epi& E) {
    int tid_ = wave_ * 64 + (int)__builtin_amdgcn_mbcnt_hi(~0u, __builtin_amdgcn_mbcnt_lo(~0u, 0u)); asm volatile("" : "+v"(tid_));
    const int tid = tid_, wid = __builtin_amdgcn_readfirstlane(tid >> 6), lane = tid & 63, wr = wid >> 2, wc = wid & 3, fr = lane & 15, fq = lane >> 4;
    const int nt = K / BK;
    int RA[2], CA[2]; unsigned voffB[2];
#pragma unroll
    for (int i = 0; i < 2; ++i) { int R, C; stage_rc(tid * 16 + i * 8192, R, C); const int Rb = Epi::PERM ? ((R & ~31) + perm32(R & 31)) : R;
        RA[i] = R; CA[i] = C * 2; voffB[i] = (unsigned)(Rb * K + C) * 2u; }
    const size_t kstep = (size_t)(BK * 2);
    const size_t hstep = (size_t)HALF * K * 2;
    const unsigned ldsw = (unsigned)wid * 1024u;
    const int aoff = lds_byte(wr * 64 + fr, fq * 8), boff = lds_byte(wc * 32 + fr, fq * 8);
#define PG8_SA(b, h) (((b) * 2 + (h)) * HTB)
#define PG8_SB(b, h) ((4 + (b) * 2 + (h)) * HTB)
#define PG8_STAGE(bufoff, gbase, voff) do { _Pragma("unroll") for (int _i = 0; _i < 2; ++_i) \
        __builtin_amdgcn_global_load_lds((const unsigned*)((const char*)(gbase) + (voff)[_i]), (LAS unsigned*)(lds + (bufoff) + ldsw + _i * 8192), 16, 0, 0); } while (0)
#define PG8_STAGEA(bufoff, base, offs, kb) do { _Pragma("unroll") for (int _i = 0; _i < 2; ++_i) \
        __builtin_amdgcn_global_load_lds((const unsigned*)((base) + (size_t)(offs)[_i] + (size_t)(kb)), (LAS unsigned*)(lds + (bufoff) + ldsw + _i * 8192), 16, 0, PG8_A_AUX); } while (0)
#define PG8_LDA(dst, b, h) do { _Pragma("unroll") for (int m = 0; m < 4; ++m) _Pragma("unroll") for (int k = 0; k < 2; ++k) dst[m][k] = *(const LAS bf16x8*)(lds + PG8_SA(b, h) + aoff + m * 2048 + k * 1024); } while (0)
#define PG8_LDB(dst, b, h) do { _Pragma("unroll") for (int n = 0; n < 2; ++n) _Pragma("unroll") for (int k = 0; k < 2; ++k) dst[n][k] = *(const LAS bf16x8*)(lds + PG8_SB(b, h) + boff + n * 2048 + k * 1024); } while (0)
#define PG8_MMA(ai, bj, At, Bt) do { __builtin_amdgcn_s_setprio(1); _Pragma("unroll") for (int m = 0; m < 4; ++m) _Pragma("unroll") for (int n = 0; n < 2; ++n) _Pragma("unroll") for (int k = 0; k < 2; ++k) \
        acc[ai][bj][m][n] = __builtin_amdgcn_mfma_f32_16x16x32_bf16(Bt[n][k], At[m][k], acc[ai][bj][m][n], 0, 0, 0); __builtin_amdgcn_s_setprio(0); } while (0)
#define PG8_WAIT_V(n) asm volatile("s_waitcnt vmcnt(" #n ")" ::: "memory")
#define PG8_WAIT_L(n) asm volatile("s_waitcnt lgkmcnt(" #n ")" ::: "memory")
#define PG8_BAR __builtin_amdgcn_s_barrier()
#define PG8_SCHED __builtin_amdgcn_sched_barrier(0)
    Unit cur, nxt; int ui = 0;
    if (!S.next(0, cur)) return;
    f32x4 acc[2][2][4][2];
#pragma unroll
    for (int a = 0; a < 2; ++a)
#pragma unroll
        for (int b = 0; b < 2; ++b)
#pragma unroll
            for (int m = 0; m < 4; ++m)
#pragma unroll
                for (int n = 0; n < 2; ++n) acc[a][b][m][n] = (f32x4){0.f, 0.f, 0.f, 0.f};
    bf16x8 At[4][2], B0[2][2], B1[2][2];
    constexpr bool GA = Sched::GATHER;
    unsigned ac0[2], ac1[2];
    const size_t hstepA = GA ? (size_t)0 : (size_t)HALF * S.a_ld() * 2;
    const char* cA = Abase; const char* nA = Abase;
    if constexpr (GA) {
#pragma unroll
        for (int i = 0; i < 2; ++i) { ac0[i] = S.a_row_off(cur, RA[i]) + CA[i]; ac1[i] = S.a_row_off(cur, HALF + RA[i]) + CA[i]; }
    } else {
#pragma unroll
        for (int i = 0; i < 2; ++i) { ac0[i] = (unsigned)(RA[i] * S.a_ld() * 2 + CA[i]); ac1[i] = ac0[i]; }
        cA = Abase + (size_t)S.a_tile_off(cur);
    }
    const char* cB = S.b_ptr(cur);
    PG8_STAGE(PG8_SB(0, 0), cB, voffB); PG8_STAGEA(PG8_SA(0, 0), cA, ac0, 0); PG8_STAGE(PG8_SB(0, 1), cB + hstep, voffB); PG8_STAGEA(PG8_SA(0, 1), cA + hstepA, ac1, 0);
    if (wr == 1) PG8_BAR;
    PG8_WAIT_V(4); PG8_BAR;
    PG8_STAGE(PG8_SB(1, 0), cB + kstep, voffB); PG8_STAGEA(PG8_SA(1, 0), cA, ac0, kstep); PG8_STAGE(PG8_SB(1, 1), cB + hstep + kstep, voffB);
    PG8_WAIT_V(6); PG8_BAR;
    for (;;) {
        const bool has_next = S.next(ui + 1, nxt);
        const char* nB = has_next ? S.b_ptr(nxt) : cB;
        if constexpr (!GA) { nA = has_next ? Abase + (size_t)S.a_tile_off(nxt) : cA; }
        unsigned s0[2], s1[2];
        for (int t = 0; t < nt; t += 2) {
            const bool last = (t == nt - 2);
            const size_t k1 = (size_t)(t + 1) * kstep;
            const size_t k2 = last ? (size_t)0 : (size_t)(t + 2) * kstep;
            const char* b2 = last ? nB : cB + (size_t)(t + 2) * kstep;
            const char* b3 = b2 + kstep;
            const char* a2 = (last && !GA) ? nA : cA;
#pragma unroll
            for (int i = 0; i < 2; ++i) { s0[i] = ac0[i]; s1[i] = ac1[i]; }
            if constexpr (GA) { if (last && has_next) {
#pragma unroll
                for (int i = 0; i < 2; ++i) { int R, C; stage_rc(tid * 16 + i * 8192, R, C); s0[i] = S.a_row_off(nxt, R) + C * 2; s1[i] = S.a_row_off(nxt, HALF + R) + C * 2; } } }
            PG8_LDB(B0, 0, 0); PG8_SCHED; PG8_LDA(At, 0, 0); PG8_STAGEA(PG8_SA(1, 1), cA + hstepA, ac1, k1);
            PG8_WAIT_L(8); PG8_BAR; PG8_WAIT_L(0); PG8_MMA(0, 0, At, B0); PG8_BAR; PG8_SCHED;
            PG8_LDB(B1, 0, 1); PG8_STAGE(PG8_SB(0, 0), b2, voffB);
            PG8_BAR; PG8_WAIT_L(0); PG8_MMA(0, 1, At, B1); PG8_BAR;
            PG8_LDA(At, 0, 1); PG8_STAGEA(PG8_SA(0, 0), a2, s0, k2);
            PG8_BAR; PG8_WAIT_L(0); PG8_MMA(1, 0, At, B0); PG8_BAR; PG8_SCHED;
            PG8_STAGE(PG8_SB(0, 1), b2 + hstep, voffB);
            PG8_WAIT_V(6); PG8_BAR; PG8_MMA(1, 1, At, B1); PG8_BAR;
            PG8_LDB(B0, 1, 0); PG8_SCHED; PG8_LDA(At, 1, 0); PG8_STAGEA(PG8_SA(0, 1), a2 + hstepA, s1, k2);
            PG8_WAIT_L(8); PG8_BAR; PG8_WAIT_L(0); PG8_MMA(0, 0, At, B0); PG8_BAR; PG8_SCHED;
            PG8_LDB(B1, 1, 1); PG8_STAGE(PG8_SB(1, 0), b3, voffB);
            PG8_BAR; PG8_WAIT_L(0); PG8_MMA(0, 1, At, B1); PG8_BAR;
            PG8_LDA(At, 1, 1); PG8_STAGEA(PG8_SA(1, 0), a2, s0, k2 + kstep);
            PG8_BAR; PG8_WAIT_L(0); PG8_MMA(1, 0, At, B0); PG8_BAR; PG8_SCHED;
            PG8_STAGE(PG8_SB(1, 1), b3 + hstep, voffB);
            PG8_WAIT_V(6); PG8_BAR; PG8_MMA(1, 1, At, B1); PG8_BAR;
        }
        { int l2 = (int)__builtin_amdgcn_mbcnt_hi(~0u, __builtin_amdgcn_mbcnt_lo(~0u, 0u)); asm volatile("" : "+v"(l2)); E(acc, cur, wr, wc, l2 & 15, l2 >> 4); }
        if (!has_next) break;
#pragma unroll
        for (int a = 0; a < 2; ++a)
#pragma unroll
            for (int b = 0; b < 2; ++b)
#pragma unroll
                for (int m = 0; m < 4; ++m)
#pragma unroll
                    for (int n = 0; n < 2; ++n) acc[a][b][m][n] = (f32x4){0.f, 0.f, 0.f, 0.f};
        cur = nxt; cB = nB; cA = nA; ++ui;
        if constexpr (GA) {
#pragma unroll
            for (int i = 0; i < 2; ++i) { ac0[i] = s0[i]; ac1[i] = s1[i]; }
        }
    }
    PG8_WAIT_V(0);
    if (wr == 0) PG8_BAR;
    PG8_BAR;
#undef PG8_SA
#undef PG8_SB
#undef PG8_STAGE
#undef PG8_STAGEA
#undef PG8_LDA
#undef PG8_LDB
#undef PG8_MMA
#undef PG8_WAIT_V
#undef PG8_WAIT_L
#undef PG8_BAR
#undef PG8_SCHED
}
}
using pg8::Unit;

constexpr size_t al256(size_t x) { return (x + 255) & ~(size_t)255; }
constexpr size_t MB = 1024 * 1024;
constexpr size_t WS_CTL = 0;
constexpr size_t CTL_BAR = 0;
constexpr size_t CTL_MOECNT = 16384;
constexpr size_t CTL_BYTES = 32768;
constexpr int NIN = 7424;
constexpr size_t WS_WIN  = al256(WS_CTL + CTL_BYTES);
constexpr size_t WS_WBRA = WS_WIN  + (size_t)NIN * 1024 * 2;
constexpr size_t WS_WBRB = WS_WBRA + (size_t)1024 * 1024 * 2;
constexpr size_t WS_WBRC = WS_WBRB + (size_t)1024 * 512 * 2;
constexpr size_t WS_WO   = WS_WBRC + (size_t)1024 * 512 * 2;
constexpr size_t WS_WGLU = WS_WO   + (size_t)1024 * 1024 * 2;
constexpr size_t WS_WRT  = WS_WGLU + (size_t)512 * 512 * 2;
constexpr size_t WS_WGU  = WS_WRT  + (size_t)256 * 1024 * 2;
constexpr size_t WS_WDN  = WS_WGU  + (size_t)65 * 512 * 1024 * 2;
constexpr size_t WS_S5TF = WS_WDN  + (size_t)65 * 1024 * 256 * 2;
constexpr size_t WS_S5E  = WS_S5TF + (size_t)32 * 512 * 640 * 2;
constexpr size_t WS_S5A32 = WS_S5E + (size_t)32 * 256 * 512 * 2;
constexpr size_t WS_WEND = al256(WS_S5A32 + 32 * 64 * 8);
constexpr size_t WS_X   = WS_WEND;
constexpr size_t WS_XB  = WS_X  + (size_t)NTOK * 1024 * 4;
constexpr size_t WS_XM  = WS_XB + (size_t)NTOK * 1024 * 2;
constexpr size_t WS_XMB = WS_XM + (size_t)NTOK * 1024 * 4;
constexpr size_t WS_R   = WS_XMB + (size_t)NTOK * 1024 * 2;
constexpr size_t WS_QT    = WS_R;
constexpr size_t WS_IDXQ  = WS_QT    + (size_t)NTOK * 1024 * 2;
constexpr size_t WS_BQKV  = WS_IDXQ  + (size_t)NTOK * 512 * 2;
constexpr size_t WS_BZ    = WS_BQKV  + (size_t)NTOK * 1536 * 2;
constexpr size_t WS_CUP   = WS_BZ    + (size_t)NTOK * 512 * 2;
constexpr size_t WS_GATES = WS_CUP   + (size_t)32 * 1024 * 640 * 2;
constexpr size_t WS_MISC  = WS_GATES + (size_t)NTOK * 3072 * 2;
constexpr size_t WS_CKV   = WS_MISC  + (size_t)NTOK * 256 * 4;
constexpr size_t WS_IDXK  = WS_CKV   + (size_t)NTOK * 128 * 2;
constexpr size_t WS_SEL   = WS_IDXK  + (size_t)NTOK * 64 * 2;
constexpr size_t WS_CTX   = WS_SEL   + (size_t)NTOK * 256 * 4;
constexpr size_t WS_YB    = WS_CTX   + (size_t)NTOK * 1024 * 2;
constexpr size_t WS_XLOC  = WS_YB    + (size_t)NTOK * 512 * 2;
constexpr size_t WS_YCPRE = WS_XLOC  + (size_t)32 * 1024 * 256 * 4;
constexpr size_t WS_YC    = WS_YCPRE + (size_t)NTOK * 512 * 2;
constexpr size_t WS_U     = WS_YC    + (size_t)NTOK * 512 * 2;
constexpr size_t WS_DNA   = WS_U;
constexpr size_t WS_DNB   = WS_DNA + (size_t)2048 * 128 * 128 * 2;
constexpr size_t WS_DNQ   = WS_DNB + (size_t)2048 * 128 * 128 * 4;
constexpr size_t WS_DNO   = WS_DNQ + (size_t)2048 * 64 * 128 * 2;
constexpr size_t WS_DNS   = WS_DNO + (size_t)2048 * 64 * 128 * 4;
constexpr size_t WS_UEND  = WS_DNS + (size_t)2048 * 128 * 128 * 2;
constexpr size_t WS_SCORES = WS_UEND;
constexpr size_t WS_MERGED = WS_U;
constexpr size_t WS_MERGEDB = WS_MERGED + (size_t)NTOK * 1024 * 4;
static_assert(WS_MERGEDB + (size_t)NTOK * 1024 * 2 <= WS_UEND, "union");
constexpr size_t WS_SCORES2 = WS_U;
static_assert((size_t)8192 * 8192 * 4 <= WS_UEND - WS_U, "scores2");
constexpr size_t WS_MIXEND = WS_SCORES + (size_t)8192 * 8192 * 4;
constexpr int MOE_ROWS = NTOK * 8 + 64 * 256;
constexpr int MOE_TILES = MOE_ROWS / 256;
constexpr size_t WS_RLOG  = WS_R;
constexpr size_t WS_TOPI  = WS_RLOG + (size_t)NTOK * 256 * 4;
constexpr size_t WS_TOPG  = WS_TOPI + (size_t)NTOK * 8 * 4;
constexpr size_t WS_TOPR  = WS_TOPG + (size_t)NTOK * 8 * 4;
constexpr size_t WS_SROW  = WS_TOPR + (size_t)NTOK * 8 * 4;
constexpr size_t WS_TEXP  = WS_SROW + (size_t)MOE_ROWS * 4;
constexpr size_t WS_EBASE = WS_TEXP + al256((MOE_TILES + 8) * 4);
constexpr size_t WS_HS    = al256(WS_EBASE + 256);
constexpr size_t WS_YS    = WS_HS + (size_t)(NTOK + MOE_ROWS) * 256 * 2;
constexpr size_t WS_MOEEND = WS_YS + (size_t)(NTOK + MOE_ROWS) * 1024 * 2;
constexpr size_t WS_TOTAL = WS_MIXEND > WS_MOEEND ? WS_MIXEND : WS_MOEEND;
static_assert(WS_TOTAL < (size_t)2040 * MB, "workspace budget");

constexpr int LDS_BYTES = 147456;

struct Params {
    const float* in[33];
    float* out;
    unsigned char* ws;
};
enum { I_X = 0, I_RELB, I_WIN, I_KVN, I_KVUP, I_BCONV, I_BALOG, I_BDTB, I_BONORM, I_CLRE, I_CLIM, I_CLOGDT, I_CBRE, I_CBIM, I_CCRE, I_CCIM, I_CD,
       I_GLUW, I_GLUB, I_WBRA, I_WBRB, I_WBRC, I_WO, I_LN1G, I_LN1B, I_RTW, I_RTB, I_EGU, I_EDN, I_SGU, I_SDN, I_LN2G, I_LN2B };

struct Ctx {
    LAS unsigned char* lds; int tid, lane, wave, wg, nwg;
};

template <class Map>
__device__ __forceinline__ void cvt_tile(const Ctx& c, const float* __restrict__ src, int ld, bf16_t* __restrict__ dst, int K, int n0, int k0, const Map& map) {
    LAS float* t = (LAS float*)c.lds;
    const int n = c.tid & 63, kq = c.tid >> 6;
    const int sc = map(n0 + n);
#pragma unroll
    for (int i = 0; i < 8; ++i) { const int k = i * 8 + kq; t[k * 65 + n] = sc >= 0 ? src[(size_t)(k0 + k) * ld + sc] : 0.f; }
    __syncthreads();
    { const int nn = c.tid >> 3, kc = (c.tid & 7) * 8; u32x4 w;
      w.x = cvt_pk_bf16(t[(kc + 0) * 65 + nn], t[(kc + 1) * 65 + nn]); w.y = cvt_pk_bf16(t[(kc + 2) * 65 + nn], t[(kc + 3) * 65 + nn]);
      w.z = cvt_pk_bf16(t[(kc + 4) * 65 + nn], t[(kc + 5) * 65 + nn]); w.w = cvt_pk_bf16(t[(kc + 6) * 65 + nn], t[(kc + 7) * 65 + nn]);
      *(u32x4*)(dst + (size_t)(n0 + nn) * K + k0 + kc) = w; }
    __syncthreads();
}
template <class Map>
__device__ __forceinline__ void cvt_tile4(const Ctx& c, const float* __restrict__ src, int ld, bf16_t* __restrict__ dst, int K, int n0, int k0, const Map& map) {
    LAS float* t = (LAS float*)c.lds;
    const int n = c.tid & 63, kq = c.tid >> 6;
    const int sc = map(n0 + n);
    float v[32];
#pragma unroll
    for (int i = 0; i < 32; ++i) { const int k = i * 8 + kq; v[i] = sc >= 0 ? src[(size_t)(k0 + k) * ld + sc] : 0.f; }
#pragma unroll
    for (int i = 0; i < 32; ++i) { const int k = i * 8 + kq; t[(k >> 6) * (64 * 65) + (k & 63) * 65 + n] = v[i]; }
    __syncthreads();
    { const int nn = c.tid >> 3, kc = (c.tid & 7) * 8;
#pragma unroll
      for (int sb = 0; sb < 4; ++sb) { const LAS float* tt = t + sb * (64 * 65); u32x4 w;
        w.x = cvt_pk_bf16(tt[(kc + 0) * 65 + nn], tt[(kc + 1) * 65 + nn]); w.y = cvt_pk_bf16(tt[(kc + 2) * 65 + nn], tt[(kc + 3) * 65 + nn]);
        w.z = cvt_pk_bf16(tt[(kc + 4) * 65 + nn], tt[(kc + 5) * 65 + nn]); w.w = cvt_pk_bf16(tt[(kc + 6) * 65 + nn], tt[(kc + 7) * 65 + nn]);
        *(u32x4*)(dst + (size_t)(n0 + nn) * K + k0 + sb * 64 + kc) = w; } }
    __syncthreads();
}
struct MapIdent { __device__ int operator()(int n) const { return n; } };
struct MapLimit { int lim; __device__ int operator()(int n) const { return n < lim ? n : -1; } };
struct MapWin {
    __device__ int operator()(int n) const {
        if (n < 512) return 640 + n;
        if (n < 2048) return 1224 + (n - 512);
        if (n < 2560) return 2760 + (n - 2048);
        if (n < 3072) return 3280 + (n - 2560);
        if (n < 6144) return 3792 + (n - 3072);
        if (n < 6272) return 512 + (n - 6144);
        if (n < 6336) return 1152 + (n - 6272);
        if (n < 6344) return 1216 + (n - 6336);
        if (n < 6348) return 3272 + (n - 6344);
        if (n < 6352) return 3276 + (n - 6348);
        return -1;
    }
};
struct MapGU { __device__ int operator()(int n) const { const int j = n >> 8, p = n & 255; return p < 128 ? 128 * j + p : 256 + 128 * j + (p - 128); } };

__device__ __forceinline__ void sincos_rev(float phi, float& s, float& c) {
    float r = phi * 0.15915494309189535f; r -= rintf(r);
    s = __builtin_amdgcn_sinf(r); c = __builtin_amdgcn_cosf(r);
}

template <class Map>
__device__ __forceinline__ void cvt_direct(const Ctx& c, const float* __restrict__ src, int ld, bf16_t* __restrict__ dst, int K, int n0, int k0, const Map& map) {
    const int kb = (c.tid >> 6) * 8, n4 = (c.tid & 63) * 4; const int sc = map(n0 + n4);
    f32x4 v[8];
#pragma unroll
    for (int i = 0; i < 8; ++i) v[i] = *(const f32x4*)(src + (size_t)(k0 + kb + i) * ld + sc);
#pragma unroll
    for (int q = 0; q < 4; ++q) { u32x4 w; w.x = cvt_pk_bf16(v[0][q], v[1][q]); w.y = cvt_pk_bf16(v[2][q], v[3][q]); w.z = cvt_pk_bf16(v[4][q], v[5][q]); w.w = cvt_pk_bf16(v[6][q], v[7][q]);
        *(u32x4*)(dst + (size_t)(n0 + n4 + q) * K + k0 + kb) = w; }
}
__device__ __forceinline__ void p0_small_tile(const Ctx& c, const Params& P, int l, int j) {
    unsigned char* ws = P.ws;
    constexpr int J0 = 400, J1 = J0 + 32, J2 = J1 + 32, J3 = J2 + 64, J4 = J3 + 16, J5 = J4 + 16;
    if (j < J0) {}
        else if (j < J1) { const int q = j - J0, nt = q >> 1, kt = q & 1;
            cvt_tile4(c, P.in[I_WBRB] + (size_t)l * 512 * 1024, 1024, (bf16_t*)(ws + WS_WBRB), 512, nt * 64, kt * 256, MapIdent()); }
        else if (j < J2) { const int q = j - J1, nt = q >> 1, kt = q & 1;
            cvt_tile4(c, P.in[I_WBRC] + (size_t)l * 512 * 1024, 1024, (bf16_t*)(ws + WS_WBRC), 512, nt * 64, kt * 256, MapIdent()); }
        else if (j < J3) { const int q = j - J2, nt = q >> 2, kt = q & 3;
            cvt_tile4(c, P.in[I_WO] + (size_t)l * 1024 * 1024, 1024, (bf16_t*)(ws + WS_WO), 1024, nt * 64, kt * 256, MapIdent()); }
        else if (j < J4) { const int q = j - J3, nt = q >> 1, kt = q & 1;
            cvt_tile4(c, P.in[I_GLUW] + (size_t)l * 512 * 512, 512, (bf16_t*)(ws + WS_WGLU), 512, nt * 64, kt * 256, MapIdent()); }
        else if (j < J5) { const int q = j - J4, nt = q >> 2, kt = q & 3; MapLimit m; m.lim = 64;
            cvt_tile4(c, P.in[I_RTW] + (size_t)l * 1024 * 64, 64, (bf16_t*)(ws + WS_WRT), 1024, nt * 64, kt * 256, m); }
}
__device__ __forceinline__ void p0_wbra_job(const Ctx& c, const Params& P, int l, int h, int blk) {
    unsigned char* ws = P.ws;
    LAS float* tA = (LAS float*)c.lds; LAS float* tB = tA + 64 * 65;
    const float* kvup = P.in[I_KVUP] + (size_t)l * 128 * 1024;
                const float* wbr = P.in[I_WBRA] + (size_t)l * 512 * 1024;
                for (int i = c.tid; i < 64 * 64; i += 512) { const int e = i >> 6, cc = i & 63; tA[cc * 65 + e] = wbr[(size_t)(h * 64 + e) * 1024 + blk * 64 + cc]; }
                for (int i = c.tid; i < 128 * 64; i += 512) { const int r = i >> 6, e = i & 63; tB[r * 65 + e] = kvup[(size_t)r * 1024 + 512 + h * 64 + e]; }
                __syncthreads();
#pragma unroll
                for (int it = 0; it < 2; ++it) { const int o = c.tid + it * 512, cc = o >> 4, r8 = (o & 15) * 8; float a[8];
#pragma unroll
                    for (int q = 0; q < 8; ++q) a[q] = 0.f;
                    for (int e = 0; e < 64; ++e) { const float b = tA[cc * 65 + e];
#pragma unroll
                        for (int q = 0; q < 8; ++q) a[q] += tB[(r8 + q) * 65 + e] * b; }
                    u32x4 w; w.x = cvt_pk_bf16(a[0], a[1]); w.y = cvt_pk_bf16(a[2], a[3]); w.z = cvt_pk_bf16(a[4], a[5]); w.w = cvt_pk_bf16(a[6], a[7]);
                    *(u32x4*)((bf16_t*)(ws + WS_WBRA) + (size_t)(blk * 64 + cc) * 1024 + h * 128 + r8) = w; }
                __syncthreads();
}
__device__ __forceinline__ void p0_wincomb_job(const Ctx& c, const Params& P, int l, int h, int blk) {
    unsigned char* ws = P.ws;
    LAS float* tA = (LAS float*)c.lds; LAS float* tB = tA + 64 * 65;
    const float* kvup = P.in[I_KVUP] + (size_t)l * 128 * 1024;
                const float* win = P.in[I_WIN] + (size_t)l * 1024 * D_IN;
                for (int i = c.tid; i < 64 * 64; i += 512) { const int dm = i >> 6, e = i & 63; tA[dm * 65 + e] = win[(size_t)(blk * 64 + dm) * D_IN + h * 64 + e]; }
                for (int i = c.tid; i < 128 * 64; i += 512) { const int r = i >> 6, e = i & 63; tB[r * 65 + e] = kvup[(size_t)r * 1024 + h * 64 + e]; }
                __syncthreads();
#pragma unroll
                for (int it = 0; it < 2; ++it) { const int o = c.tid + it * 512, r = o >> 3, d8 = (o & 7) * 8; float a[8];
#pragma unroll
                    for (int q = 0; q < 8; ++q) a[q] = 0.f;
                    for (int e = 0; e < 64; ++e) { const float b = tB[r * 65 + e];
#pragma unroll
                        for (int q = 0; q < 8; ++q) a[q] += tA[(d8 + q) * 65 + e] * b; }
                    u32x4 w; w.x = cvt_pk_bf16(a[0], a[1]); w.y = cvt_pk_bf16(a[2], a[3]); w.z = cvt_pk_bf16(a[4], a[5]); w.w = cvt_pk_bf16(a[6], a[7]);
                    *(u32x4*)((bf16_t*)(ws + WS_WIN) + (size_t)(h * 128 + r) * 1024 + blk * 64 + d8) = w; }
                __syncthreads();
}
constexpr int P0X_SMALL = 128 + 160;
constexpr int P0X_JOBS = P0X_SMALL + 2080 + 1040;
constexpr int P0X_WIN = 400 + 128;
__device__ __forceinline__ void phase_p0_experts(const Ctx& c, const Params& P, int l) {
    unsigned char* ws = P.ws; unsigned* ctr = (unsigned*)(ws + WS_CTL + 20480) + 64 * l;
    LAS int* slot = (LAS int*)(c.lds + 70000);
    for (;;) {
        if (c.tid == 0) slot[0] = (int)atomicAdd(ctr, 1u);
        __syncthreads();
        const int qw = __builtin_amdgcn_readfirstlane(slot[0]);
        const int nwin = l + 1 < DEPTH ? P0X_WIN : 0;
        if (qw >= P0X_JOBS + nwin) break;
        __syncthreads();
        if (qw < nwin) {
            if (qw < 400) cvt_tile4(c, P.in[I_WIN] + (size_t)(l + 1) * 1024 * D_IN, D_IN, (bf16_t*)(ws + WS_WIN) + (size_t)1024 * 1024, 1024, (qw >> 2) * 64, (qw & 3) * 256, MapWin());
            else p0_wincomb_job(c, P, l + 1, (qw - 400) >> 4, (qw - 400) & 15);
            continue;
        }
        const int qa = qw - nwin;
        const int q0 = qa - P0X_SMALL;
        if (qa < 128) p0_wbra_job(c, P, l, qa >> 4, qa & 15);
        else if (qa < P0X_SMALL) p0_small_tile(c, P, l, 400 + qa - 128);
        else if (q0 < 2080) { const int e = q0 >> 5, r = q0 & 31, nt = r >> 4, kt = r & 15;
            const float* src = e < 64 ? P.in[I_EGU] + ((size_t)l * 64 + e) * 1024 * 512 : P.in[I_SGU] + (size_t)l * 1024 * 512;
            cvt_direct(c, src, 512, (bf16_t*)(ws + WS_WGU) + (size_t)e * 512 * 1024, 1024, nt * 256, kt * 64, MapGU()); }
        else { const int q = q0 - 2080, e = q >> 4, nt = (q >> 2) & 3, kt = q & 3;
            const float* src = e < 64 ? P.in[I_EDN] + ((size_t)l * 64 + e) * 256 * 1024 : P.in[I_SDN] + (size_t)l * 256 * 1024;
            cvt_direct(c, src, 1024, (bf16_t*)(ws + WS_WDN) + (size_t)e * 1024 * 256, 256, nt * 256, kt * 64, MapIdent()); }
    }
    __syncthreads();
}
__device__ __forceinline__ void phase_p0(const Ctx& c, const Params& P, int l, bool win) {
    unsigned char* ws = P.ws;
    constexpr int J0 = 400, J1 = J0 + 32, J2 = J1 + 32, J3 = J2 + 64, J4 = J3 + 16, J5 = J4 + 16;
    if (win) for (int j = c.wg; j < J0; j += c.nwg) {
        { const int nt = j >> 2, kt = j & 3;
            cvt_tile4(c, P.in[I_WIN] + (size_t)l * 1024 * D_IN, D_IN, (bf16_t*)(ws + WS_WIN) + (size_t)1024 * 1024, 1024, nt * 64, kt * 256, MapWin()); }
    }
    if (win) for (int j = c.wg; j < 128; j += c.nwg) p0_wincomb_job(c, P, l, j >> 4, j & 15);
    __syncthreads();
    for (int g = c.wg; g < 32; g += c.nwg) {
        LAS float* AP = (LAS float*)c.lds;
        LAS float* BB = AP + 33 * 128;
        LAS float* CC = BB + 64 * 32;
        LAS float* KT = CC + 16 * 128;
        const float dt = __expf(P.in[I_CLOGDT][l * 32 + g]);
        if (c.tid < 64) { const int p = c.tid;
            const float lr = P.in[I_CLRE][(l * 32 + g) * 64 + p], li = P.in[I_CLIM][(l * 32 + g) * 64 + p];
            const float mag = __expf(lr * dt); float sn, cs; sincos_rev(li * dt, sn, cs);
            const float are = mag * cs, aim = mag * sn, den = lr * lr + li * li;
            const float fre = ((are - 1.0f) * lr + aim * li) / den, fim = (aim * lr - (are - 1.0f) * li) / den;
            float pr = 1.f, pi = 0.f;
            for (int k = 0; k <= 32; ++k) { AP[(k * 64 + p) * 2] = pr; AP[(k * 64 + p) * 2 + 1] = pi; const float nr = pr * are - pi * aim, ni = pr * aim + pi * are; pr = nr; pi = ni; }
            ((float*)(ws + WS_S5A32))[(g * 64 + p) * 2] = AP[(32 * 64 + p) * 2]; ((float*)(ws + WS_S5A32))[(g * 64 + p) * 2 + 1] = AP[(32 * 64 + p) * 2 + 1];
            for (int j = 0; j < 16; ++j) { const float br = P.in[I_CBRE][((size_t)(l * 32 + g) * 64 + p) * 16 + j], bi = P.in[I_CBIM][((size_t)(l * 32 + g) * 64 + p) * 16 + j];
                BB[(p * 16 + j) * 2] = fre * br - fim * bi; BB[(p * 16 + j) * 2 + 1] = fre * bi + fim * br; }
        }
        for (int i = c.tid; i < 16 * 64; i += 512) { const int ii = i >> 6, p = i & 63;
            CC[i * 2] = P.in[I_CCRE][((size_t)(l * 32 + g) * 16 + ii) * 64 + p]; CC[i * 2 + 1] = P.in[I_CCIM][((size_t)(l * 32 + g) * 16 + ii) * 64 + p]; }
        __syncthreads();
        for (int o = c.tid; o < 32 * 256; o += 512) { const int tau = o >> 8, i = (o >> 4) & 15, j = o & 15; float s = 0.f;
            for (int p = 0; p < 64; ++p) { const float cr = CC[(i * 64 + p) * 2], ci = CC[(i * 64 + p) * 2 + 1], ar = AP[(tau * 64 + p) * 2], ai = AP[(tau * 64 + p) * 2 + 1];
                const float xr = cr * ar - ci * ai, xi = cr * ai + ci * ar; s += xr * BB[(p * 16 + j) * 2] - xi * BB[(p * 16 + j) * 2 + 1]; }
            if (tau == 0 && i == j) s += P.in[I_CD][(l * 32 + g) * 16 + i];
            KT[o] = s; }
        __syncthreads();
        bf16_t* TF = (bf16_t*)(ws + WS_S5TF) + (size_t)g * 512 * 640;
        for (int o = c.tid; o < 512 * 80; o += 512) { const int n = o / 80, k8 = (o % 80) * 8, tp = n >> 4, i = n & 15; float v[8];
            if (k8 < 512) { const int sp = k8 >> 4, j0 = k8 & 15;
#pragma unroll
                for (int q = 0; q < 8; ++q) v[q] = tp >= sp ? KT[(tp - sp) * 256 + i * 16 + j0 + q] : 0.f; }
            else { const int p0 = (k8 - 512) >> 1;
#pragma unroll
                for (int q = 0; q < 4; ++q) { const int p = p0 + q; const float cr = CC[(i * 64 + p) * 2], ci = CC[(i * 64 + p) * 2 + 1], ar = AP[((tp + 1) * 64 + p) * 2], ai = AP[((tp + 1) * 64 + p) * 2 + 1];
                    v[2 * q] = cr * ar - ci * ai; v[2 * q + 1] = -(cr * ai + ci * ar); } }
            u32x4 w; w.x = cvt_pk_bf16(v[0], v[1]); w.y = cvt_pk_bf16(v[2], v[3]); w.z = cvt_pk_bf16(v[4], v[5]); w.w = cvt_pk_bf16(v[6], v[7]);
            *(u32x4*)(TF + (size_t)n * 640 + k8) = w; }
        bf16_t* EE = (bf16_t*)(ws + WS_S5E) + (size_t)g * 256 * 512;
        for (int o = c.tid; o < 256 * 64; o += 512) { const int n = o >> 6, k8 = (o & 63) * 8; float v[8];
            if (n < 128) { const int p = n >> 1, cpx = n & 1, sp = k8 >> 4, j0 = k8 & 15; const float ar = AP[((31 - sp) * 64 + p) * 2], ai = AP[((31 - sp) * 64 + p) * 2 + 1];
#pragma unroll
                for (int q = 0; q < 8; ++q) { const float br = BB[(p * 16 + j0 + q) * 2], bi = BB[(p * 16 + j0 + q) * 2 + 1]; v[q] = cpx ? (ar * bi + ai * br) : (ar * br - ai * bi); } }
            else {
#pragma unroll
                for (int q = 0; q < 8; ++q) v[q] = 0.f; }
            u32x4 w; w.x = cvt_pk_bf16(v[0], v[1]); w.y = cvt_pk_bf16(v[2], v[3]); w.z = cvt_pk_bf16(v[4], v[5]); w.w = cvt_pk_bf16(v[6], v[7]);
            *(u32x4*)(EE + (size_t)n * 512 + k8) = w; }
        __syncthreads();
    }
}

struct SchedPlain {
    int nM, nN, nwg, G, c, K; const char* Bt;
    __device__ __forceinline__ void init(int M, int N, int K_, const void* Bt_, int G_, int c_) { nM = M / 256; nN = N / 256; nwg = nM * nN; G = G_; c = c_; K = K_; Bt = (const char*)Bt_; }
    __device__ __forceinline__ bool next(int i, Unit& u) const {
        const long L = (long)i * G + c; if (L >= nwg) return false;
        int wgid = (int)L; { const int q = nwg / 8, r = nwg % 8, xcd = wgid % 8, off = wgid / 8; wgid = (xcd < r ? xcd * (q + 1) : r * (q + 1) + (xcd - r) * q) + off; }
        const int nig = 8 * nN, gid = wgid / nig, fm = gid * 8, gsz = (nM - fm) < 8 ? (nM - fm) : 8;
        u.pm = fm + ((wgid % nig) % gsz); u.pn = (wgid % nig) / gsz; return true;
    }
    static constexpr bool GATHER = false;
    __device__ __forceinline__ int a_ld() const { return K; }
    __device__ __forceinline__ size_t a_tile_off(const Unit& u) const { return (size_t)u.pm * 256 * K * 2; }
    __device__ __forceinline__ unsigned a_row_off(const Unit& u, int r) const { return 0u; }
    __device__ __forceinline__ const char* b_ptr(const Unit& u) const { return Bt + (size_t)u.pn * 256 * K * 2; }
};
struct SchedGrouped {
    int nMg, nNg, ngr, nwg, G, c, K, lda; const char* Bt;
    __device__ __forceinline__ void init(int ngr_, int Mg, int Ng, int K_, const void* Bt_, int G_, int c_) { ngr = ngr_; nMg = Mg / 256; nNg = Ng / 256; nwg = ngr * nMg * nNg; G = G_; c = c_; K = K_; lda = K_; Bt = (const char*)Bt_; }
    __device__ __forceinline__ bool next(int i, Unit& u) const {
        const int L = i * G + c; if (L >= nwg) return false;
        const int per = nMg * nNg, g = L / per, r = L % per;
        u.pm = g * nMg + r / nNg; u.pn = g * nNg + r % nNg; return true;
    }
    static constexpr bool GATHER = false;
    __device__ __forceinline__ int a_ld() const { return lda; }
    __device__ __forceinline__ size_t a_tile_off(const Unit& u) const { return (size_t)u.pm * 256 * lda * 2; }
    __device__ __forceinline__ unsigned a_row_off(const Unit& u, int r) const { return 0u; }
    __device__ __forceinline__ const char* b_ptr(const Unit& u) const { return Bt + (size_t)u.pn * 256 * K * 2; }
};
#define EPI_LOOP_BEGIN \
    _Pragma("unroll") for (int ai = 0; ai < 2; ++ai) _Pragma("unroll") for (int m = 0; m < 4; ++m) { const int r = ai * 128 + wr * 64 + m * 16 + fr; \
    _Pragma("unroll") for (int bj = 0; bj < 2; ++bj) { const int c8 = bj * 128 + wc * 32 + fq * 8; const f32x4 v0 = acc[ai][bj][m][0], v1 = acc[ai][bj][m][1];
#define EPI_LOOP_END } asm volatile("" ::: "memory"); }
__device__ __forceinline__ u32x4 pack8(const f32x4 a, const f32x4 b) { u32x4 w; w.x = cvt_pk_bf16(a[0], a[1]); w.y = cvt_pk_bf16(a[2], a[3]); w.z = cvt_pk_bf16(b[0], b[1]); w.w = cvt_pk_bf16(b[2], b[3]); return w; }
__device__ __forceinline__ void unpack8(const u32x4 w, f32x4& a, f32x4& b) { a = (f32x4){bflo(w.x), bfhi(w.x), bflo(w.y), bfhi(w.y)}; b = (f32x4){bflo(w.z), bfhi(w.z), bflo(w.w), bfhi(w.w)}; }

struct EpiWin {
    static constexpr bool PERM = true;
    unsigned char* ws;
    __device__ __forceinline__ void operator()(const f32x4 (&acc)[2][2][4][2], const Unit& u, int wr, int wc, int fr, int fq) const {
        asm volatile("" : "+v"(fr), "+v"(fq));
        const int pn = u.pn; const int row0 = u.pm * 256;
        if (pn == 28) {
            float* M = (float*)(ws + WS_MISC);
            EPI_LOOP_BEGIN
                float* p = M + (size_t)(row0 + r) * 256 + c8; *(f32x4*)p = v0; *(f32x4*)(p + 4) = v1;
            EPI_LOOP_END
        } else if (pn == 14 || pn == 15) {
            bf16_t* C = (bf16_t*)(ws + WS_CUP);
            EPI_LOOP_BEGIN
                const int t = row0 + r, b = t >> 13, s = t & 8191, n = s >> 5, sp = s & 31, cc = (pn - 14) * 256 + c8, g = cc >> 4, j0 = cc & 15;
                *(u32x4*)(C + ((size_t)(g * 1024 + b * 256 + n) * 640) + sp * 16 + j0) = pack8(v0, v1);
            EPI_LOOP_END
        } else {
            bf16_t* base; int ld, ct;
            if (pn < 4) { base = (bf16_t*)(ws + WS_QT); ld = 1024; ct = pn; }
            else if (pn < 6) { base = (bf16_t*)(ws + WS_IDXQ); ld = 512; ct = pn - 4; }
            else if (pn < 12) { base = (bf16_t*)(ws + WS_BQKV); ld = 1536; ct = pn - 6; }
            else if (pn < 14) { base = (bf16_t*)(ws + WS_BZ); ld = 512; ct = pn - 12; }
            else { base = (bf16_t*)(ws + WS_GATES); ld = 3072; ct = pn - 16; }
            EPI_LOOP_BEGIN
                __builtin_nontemporal_store(pack8(v0, v1), (u32x4*)(base + (size_t)(row0 + r) * ld + ct * 256 + c8));
            EPI_LOOP_END
        }
    }
};
struct EpiBf16 {
    static constexpr bool PERM = true;
    bf16_t* O; int ld;
    __device__ __forceinline__ void operator()(const f32x4 (&acc)[2][2][4][2], const Unit& u, int wr, int wc, int fr, int fq) const {
        asm volatile("" : "+v"(fr), "+v"(fq));
        EPI_LOOP_BEGIN
            *(u32x4*)(O + (size_t)(u.pm * 256 + r) * ld + u.pn * 256 + c8) = pack8(v0, v1);
        EPI_LOOP_END
    }
};
struct EpiF32 {
    static constexpr bool PERM = true;
    float* O; int ld;
    __device__ __forceinline__ void operator()(const f32x4 (&acc)[2][2][4][2], const Unit& u, int wr, int wc, int fr, int fq) const {
        asm volatile("" : "+v"(fr), "+v"(fq));
        EPI_LOOP_BEGIN
            float* p = O + (size_t)(u.pm * 256 + r) * ld + u.pn * 256 + c8; *(f32x4*)p = v0; *(f32x4*)(p + 4) = v1;
        EPI_LOOP_END
    }
};
template <int MODE> struct EpiMerge {
    static constexpr bool PERM = true;
    float* Mf; bf16_t* Mb; const bf16_t* gates; int gcol0;
    __device__ __forceinline__ void operator()(const f32x4 (&acc)[2][2][4][2], const Unit& u, int wr, int wc, int fr, int fq) const {
        asm volatile("" : "+v"(fr), "+v"(fq));
        EPI_LOOP_BEGIN
            const size_t row = (size_t)(u.pm * 256 + r); const int col = u.pn * 256 + c8;
            const u32x4 gw = *(const u32x4*)(gates + row * 3072 + gcol0 + col); f32x4 g0, g1; unpack8(gw, g0, g1);
#pragma unroll
            for (int q = 0; q < 4; ++q) { g0[q] = sigmoidf_(g0[q]); g1[q] = sigmoidf_(g1[q]); }
            f32x4 a = v0 * g0, b = v1 * g1; bf16_t* p = Mb + row * 1024 + col;
            if (MODE != 0) { f32x4 m0, m1; unpack8(*(const u32x4*)p, m0, m1); a += m0; b += m1; }
            *(u32x4*)p = pack8(a, b);
        EPI_LOOP_END
    }
};
struct SchedMergeBC : SchedPlain {
    size_t offB, offC; const char* BtB; const char* BtC;
    __device__ __forceinline__ bool next(int i, Unit& u) const {
        Unit t; if (!SchedPlain::next(i >> 1, t)) return false;
        u.pm = t.pm; u.pn = (i & 1) * 4 + t.pn; return true;
    }
    __device__ __forceinline__ size_t a_tile_off(const Unit& u) const { return ((u.pn >> 2) ? offC : offB) + (size_t)u.pm * 256 * 512 * 2; }
    __device__ __forceinline__ const char* b_ptr(const Unit& u) const { return ((u.pn >> 2) ? BtC : BtB) + (size_t)(u.pn & 3) * 256 * 512 * 2; }
};
struct EpiMergeBC {
    static constexpr bool PERM = true;
    bf16_t* Mb; const bf16_t* gates;
    __device__ __forceinline__ void operator()(const f32x4 (&acc)[2][2][4][2], const Unit& u, int wr, int wc, int fr, int fq) const {
        asm volatile("" : "+v"(fr), "+v"(fq));
        const int gcol0 = 1024 + 1024 * (u.pn >> 2), pn = u.pn & 3;
        EPI_LOOP_BEGIN
            const size_t row = (size_t)(u.pm * 256 + r); const int col = pn * 256 + c8;
            const u32x4 gw = *(const u32x4*)(gates + row * 3072 + gcol0 + col); f32x4 g0, g1; unpack8(gw, g0, g1);
#pragma unroll
            for (int q = 0; q < 4; ++q) { g0[q] = sigmoidf_(g0[q]); g1[q] = sigmoidf_(g1[q]); }
            f32x4 a = v0 * g0, b = v1 * g1; bf16_t* p = Mb + row * 1024 + col;
            { f32x4 m0, m1; unpack8(*(const u32x4*)p, m0, m1); a += m0; b += m1; }
            *(u32x4*)p = pack8(a, b);
        EPI_LOOP_END
    }
};
struct EpiResid {
    static constexpr bool PERM = true;
    const bf16_t* XB; float* O;
    __device__ __forceinline__ void operator()(const f32x4 (&acc)[2][2][4][2], const Unit& u, int wr, int wc, int fr, int fq) const {
        asm volatile("" : "+v"(fr), "+v"(fq));
        EPI_LOOP_BEGIN
            const size_t o = (size_t)(u.pm * 256 + r) * 1024 + u.pn * 256 + c8;
            f32x4 x0, x1; unpack8(*(const u32x4*)(XB + o), x0, x1);
            *(f32x4*)(O + o) = x0 * DN_ALPHA + v0; *(f32x4*)(O + o + 4) = x1 * DN_ALPHA + v1;
        EPI_LOOP_END
    }
};
struct EpiGlu {
    static constexpr bool PERM = true;
    const bf16_t* Y; const float* bias; bf16_t* O;
    __device__ __forceinline__ void operator()(const f32x4 (&acc)[2][2][4][2], const Unit& u, int wr, int wc, int fr, int fq) const {
        asm volatile("" : "+v"(fr), "+v"(fq));
        EPI_LOOP_BEGIN
            const size_t o = (size_t)(u.pm * 256 + r) * 512 + u.pn * 256 + c8; const int col = u.pn * 256 + c8;
            f32x4 y0, y1; unpack8(*(const u32x4*)(Y + o), y0, y1);
            const f32x4 b0 = *(const f32x4*)(bias + col), b1 = *(const f32x4*)(bias + col + 4); f32x4 a, b;
#pragma unroll
            for (int q = 0; q < 4; ++q) { a[q] = y0[q] * sigmoidf_(v0[q] + b0[q]); b[q] = y1[q] * sigmoidf_(v1[q] + b1[q]); }
            *(u32x4*)(O + o) = pack8(a, b);
        EPI_LOOP_END
    }
};
__device__ __forceinline__ float gelu_f(float v) {
    const float av = fabsf(v), t = __builtin_amdgcn_rcpf(av * 0.2316418882f + 1.0f);
    float q = t * 0.5307027145f + (-0.7265760135f); q = q * t + 0.7107068705f; q = q * t + (-0.142248368f); q = q * t + 0.127414796f; q = q * t;
    const float e = __builtin_amdgcn_exp2f((v * v) * (-0.72134752044f));
    const float mm = v * (q * e); return v < 0.f ? mm : v - mm;
}
struct EpiS5 {
    static constexpr bool PERM = true;
    bf16_t* O;
    __device__ __forceinline__ void operator()(const f32x4 (&acc)[2][2][4][2], const Unit& u, int wr, int wc, int fr, int fq) const {
        asm volatile("" : "+v"(fr), "+v"(fq));
        const int g = u.pm >> 2, rb = (u.pm & 3) * 256, cb = (u.pn & 1) * 256;
        EPI_LOOP_BEGIN
            const int rr = rb + r, b = rr >> 8, n = rr & 255, cc = cb + c8, tp = cc >> 4, i0 = cc & 15; f32x4 a, bb;
#pragma unroll
            for (int q = 0; q < 4; ++q) { a[q] = gelu_f(v0[q]); bb[q] = gelu_f(v1[q]); }
            *(u32x4*)(O + (size_t)(b * 8192 + n * 32 + tp) * 512 + g * 16 + i0) = pack8(a, bb);
        EPI_LOOP_END
    }
};
struct EpiXloc {
    static constexpr bool PERM = true;
    float* O;
    __device__ __forceinline__ void operator()(const f32x4 (&acc)[2][2][4][2], const Unit& u, int wr, int wc, int fr, int fq) const {
        asm volatile("" : "+v"(fr), "+v"(fq));
        EPI_LOOP_BEGIN
            float* p = O + (size_t)(u.pm * 256 + r) * 256 + c8; *(f32x4*)p = v0; *(f32x4*)(p + 4) = v1;
        EPI_LOOP_END
    }
};
struct EpiGU {
    static constexpr bool PERM = true;
    bf16_t* HS;
    __device__ __forceinline__ void operator()(const f32x4 (&acc)[2][2][4][2], const Unit& u, int wr, int wc, int fr, int fq) const {
        asm volatile("" : "+v"(fr), "+v"(fq));
#pragma unroll
        for (int ai = 0; ai < 2; ++ai)
#pragma unroll
            for (int m = 0; m < 4; ++m) { const int r = ai * 128 + wr * 64 + m * 16 + fr; const int c8 = wc * 32 + fq * 8; f32x4 a, b;
                const f32x4 g0 = acc[ai][0][m][0], g1 = acc[ai][0][m][1], u0 = acc[ai][1][m][0], u1 = acc[ai][1][m][1];
#pragma unroll
                for (int q = 0; q < 4; ++q) { a[q] = siluf_(g0[q]) * u0[q]; b[q] = siluf_(g1[q]) * u1[q]; }
                __builtin_nontemporal_store(pack8(a, b), (u32x4*)(HS + (size_t)(u.pm * 256 + r) * 256 + (u.pn & 1) * 128 + c8)); }
    }
};
struct EpiDown {
    static constexpr bool PERM = true;
    bf16_t* YS;
    __device__ __forceinline__ void operator()(const f32x4 (&acc)[2][2][4][2], const Unit& u, int wr, int wc, int fr, int fq) const {
        asm volatile("" : "+v"(fr), "+v"(fq));
        EPI_LOOP_BEGIN
            __builtin_nontemporal_store(pack8(v0, v1), (u32x4*)(YS + (size_t)(u.pm * 256 + r) * 1024 + (u.pn & 3) * 256 + c8));
        EPI_LOOP_END
    }
};
struct SchedGU {
    const int* texp; const int* srow; int ntiles, G, c; const char* Bt;
    __device__ __forceinline__ bool next(int i, Unit& u) const {
        const int L = i * G + c, pm = ((L >> 4) << 3) | (L & 7); if (pm >= 128 + ntiles) return false;
        const int e = pm < 128 ? 64 : __builtin_amdgcn_readfirstlane(texp[pm - 128]);
        u.pm = pm; u.pn = e * 2 + ((L >> 3) & 1); return true;
    }
    static constexpr bool GATHER = true;
    __device__ __forceinline__ int a_ld() const { return 1024; }
    __device__ __forceinline__ size_t a_tile_off(const Unit& u) const { return 0; }
    __device__ __forceinline__ unsigned a_row_off(const Unit& u, int r) const {
        const int tok = u.pm < 128 ? u.pm * 256 + r : srow[(u.pm - 128) * 256 + r];
        return (unsigned)tok * 2048u;
    }
    __device__ __forceinline__ const char* b_ptr(const Unit& u) const { return Bt + (size_t)u.pn * 256 * 1024 * 2; }
};
struct SchedDown {
    const int* texp; int ntiles, G, c; const char* Bt;
    __device__ __forceinline__ bool next(int i, Unit& u) const {
        const int L = i * G + c, pm = ((L >> 5) << 3) | (L & 7); if (pm >= 128 + ntiles) return false;
        const int e = pm < 128 ? 64 : __builtin_amdgcn_readfirstlane(texp[pm - 128]);
        u.pm = pm; u.pn = e * 4 + ((L >> 3) & 3); return true;
    }
    static constexpr bool GATHER = false;
    __device__ __forceinline__ int a_ld() const { return 256; }
    __device__ __forceinline__ size_t a_tile_off(const Unit& u) const { return (size_t)u.pm * 256 * 512; }
    __device__ __forceinline__ unsigned a_row_off(const Unit& u, int r) const { return 0u; }
    __device__ __forceinline__ const char* b_ptr(const Unit& u) const { return Bt + (size_t)u.pn * 256 * 256 * 2; }
};

__device__ __forceinline__ void phase_load_x(const Ctx& c, const Params& P) {
    const float* x = P.in[I_X]; float* X = (float*)(P.ws + WS_X); bf16_t* XB = (bf16_t*)(P.ws + WS_XB);
    const size_t n8 = (size_t)NTOK * 1024 / 8;
    for (size_t i = (size_t)c.wg * 512 + c.tid; i < n8; i += (size_t)c.nwg * 512) {
        const f32x4 a = *(const f32x4*)(x + i * 8), b = *(const f32x4*)(x + i * 8 + 4);
        *(u32x4*)(XB + i * 8) = pack8(a, b);
    }
}
__device__ __forceinline__ void phase_ln(const Ctx& c, const float* in, const float* g, const float* bta, float* outF, bf16_t* outB) {
    const int gw = c.wg * 8 + c.wave, nw = c.nwg * 8;
    f32x4 gg[4], bb[4];
#pragma unroll
    for (int q = 0; q < 4; ++q) { gg[q] = *(const f32x4*)(g + q * 256 + c.lane * 4); bb[q] = *(const f32x4*)(bta + q * 256 + c.lane * 4); }
    for (int row = gw; row < NTOK; row += nw) {
        const float* p = in + (size_t)row * 1024; f32x4 v[4]; float s = 0.f;
#pragma unroll
        for (int q = 0; q < 4; ++q) { v[q] = *(const f32x4*)(p + q * 256 + c.lane * 4); s += (v[q][0] + v[q][1]) + (v[q][2] + v[q][3]); }
        const float mu = wave_sum(s) * (1.0f / 1024.0f); float qq = 0.f;
#pragma unroll
        for (int q = 0; q < 4; ++q) { const f32x4 d = v[q] - mu; qq += (d[0] * d[0] + d[1] * d[1]) + (d[2] * d[2] + d[3] * d[3]); }
        const float rs = rsqrtf(wave_sum(qq) * (1.0f / 1024.0f) + LN_EPS);
#pragma unroll
        for (int q = 0; q < 4; ++q) { const f32x4 o = (v[q] - mu) * rs * gg[q] + bb[q];
            if (outF) *(f32x4*)(outF + (size_t)row * 1024 + q * 256 + c.lane * 4) = o;
            u32x2 w; w.x = cvt_pk_bf16(o[0], o[1]); w.y = cvt_pk_bf16(o[2], o[3]); *(u32x2*)(outB + (size_t)row * 1024 + q * 256 + c.lane * 4) = w; }
    }
}
__device__ __forceinline__ void phase_kvnorm(const Ctx& c, const Params& P, int l) {
    const float* M = (const float*)(P.ws + WS_MISC); bf16_t* CKV = (bf16_t*)(P.ws + WS_CKV); bf16_t* IK = (bf16_t*)(P.ws + WS_IDXK);
    const float* g = P.in[I_KVN] + l * 128; const float g0 = g[c.lane * 2], g1 = g[c.lane * 2 + 1];
    const int gw = c.wg * 8 + c.wave, nw = c.nwg * 8;
    for (int t = gw; t < NTOK; t += nw) {
        const f32x2 v = *(const f32x2*)(M + (size_t)t * 256 + c.lane * 2);
        const float ms = wave_sum(v[0] * v[0] + v[1] * v[1]) * (1.0f / 128.0f); const float rs = rsqrtf(ms + RMS_EPS);
        *(unsigned*)(CKV + (size_t)t * 128 + c.lane * 2) = cvt_pk_bf16(v[0] * rs * g0, v[1] * rs * g1);
        const float k = M[(size_t)t * 256 + 128 + c.lane]; IK[(size_t)t * 64 + c.lane] = f2bf(k);
    }
}
__device__ __forceinline__ void phase_s5_carry(const Ctx& c, const Params& P, int wg0, int nwgs) {
    if (c.wg < wg0 || c.wg >= wg0 + nwgs) return;
    LAS float* SE = (LAS float*)c.lds;
    const float* XL = (const float*)(P.ws + WS_XLOC); bf16_t* CUP = (bf16_t*)(P.ws + WS_CUP); const float* A32 = (const float*)(P.ws + WS_S5A32);
    for (int task = c.wg - wg0; task < 128; task += nwgs) {
        const int b = task >> 5, g = task & 31, p = c.tid & 63, seg = c.tid >> 6;
        const float ar = A32[(g * 64 + p) * 2], ai = A32[(g * 64 + p) * 2 + 1];
        const size_t rowb = (size_t)g * 1024 + b * 256 + seg * 32;
        float Lr[32], Li[32]; float sr = 0.f, si = 0.f;
#pragma unroll
        for (int i = 0; i < 32; ++i) { Lr[i] = sr; Li[i] = si; const f32x2 x = *(const f32x2*)(XL + (rowb + i) * 256 + p * 2);
            const float nr = ar * sr - ai * si + x[0], ni = ar * si + ai * sr + x[1]; sr = nr; si = ni; }
        SE[(seg * 64 + p) * 2] = sr; SE[(seg * 64 + p) * 2 + 1] = si;
        float br = ar, bi = ai;
#pragma unroll
        for (int q = 0; q < 5; ++q) { const float nr = br * br - bi * bi, ni = 2.f * br * bi; br = nr; bi = ni; }
        __syncthreads();
        float xr = 0.f, xi = 0.f;
        for (int s = 0; s < seg; ++s) { const float er = SE[(s * 64 + p) * 2], ei = SE[(s * 64 + p) * 2 + 1]; const float nr = br * xr - bi * xi + er, ni = br * xi + bi * xr + ei; xr = nr; xi = ni; }
        float pr = 1.f, pi = 0.f;
#pragma unroll
        for (int i = 0; i < 32; ++i) { const float vr = pr * xr - pi * xi + Lr[i], vi = pr * xi + pi * xr + Li[i];
            *(unsigned*)(CUP + (rowb + i) * 640 + 512 + p * 2) = cvt_pk_bf16(vr, vi);
            const float nr = pr * ar - pi * ai, ni = pr * ai + pi * ar; pr = nr; pi = ni; }
        __syncthreads();
    }
}

__device__ __forceinline__ bf16x8 ldfragL(const LAS bf16_t* base, int stride, int row, int k0) { return *(const LAS bf16x8*)(base + row * stride + k0); }
__device__ __forceinline__ bf16x8 ldfragG(const bf16_t* base, int stride, int row, int k0) { return *(const bf16x8*)(base + (size_t)row * stride + k0); }
__device__ __forceinline__ f32x4 mfma16(bf16x8 a, bf16x8 b, f32x4 c) { return __builtin_amdgcn_mfma_f32_16x16x32_bf16(a, b, c, 0, 0, 0); }

#ifndef DBG_TID
#define DBG_TID 0
#endif
constexpr int DN_QS = 136, DN_TS = 72, DN_MS = 68;
constexpr int DL_QN = 0;
constexpr int DL_KN = DL_QN + 64 * DN_QS * 2;
constexpr int DL_KTBG = DL_KN + 128 * DN_TS * 2;
constexpr int DL_KTDEC = DL_KTBG + 128 * DN_TS * 2;
constexpr int DL_VTB = DL_KTDEC + 128 * DN_TS * 2;
constexpr int DL_MF = DL_VTB + 128 * DN_TS * 2;
constexpr int DL_QK = DL_MF + 128 * DN_TS * 2;
constexpr int DL_TB = DL_QK + 64 * DN_TS * 2;
constexpr int DL_SC = DL_TB + 64 * DN_TS * 2;
constexpr int DL_END = DL_SC + 5 * 64 * 4;
static_assert(64 * DN_MS * 4 <= 128 * DN_TS * 2 && 64 * DN_QS * 2 <= 128 * DN_TS * 2 && DL_END <= LDS_BYTES, "deltanet LDS map");

__device__ __forceinline__ void phase_dn_prep(const Ctx& c, const Params& P, int l) {
    LAS bf16_t* QN = (LAS bf16_t*)(c.lds + DL_QN); LAS bf16_t* KN = (LAS bf16_t*)(c.lds + DL_KN); LAS bf16_t* WT = KN;
    LAS bf16_t* KTBG = (LAS bf16_t*)(c.lds + DL_KTBG); LAS bf16_t* KTDEC = (LAS bf16_t*)(c.lds + DL_KTDEC); LAS bf16_t* VTB = (LAS bf16_t*)(c.lds + DL_VTB);
    LAS float* MF = (LAS float*)(c.lds + DL_MF); LAS bf16_t* UT = (LAS bf16_t*)(c.lds + DL_MF);
    LAS bf16_t* QK = (LAS bf16_t*)(c.lds + DL_QK); LAS bf16_t* TB = (LAS bf16_t*)(c.lds + DL_TB);
    LAS float* GC = (LAS float*)(c.lds + DL_SC); LAS float* BETA = GC + 64; LAS float* EGC = GC + 128; LAS float* EDEC = GC + 192; LAS float* GLAST = GC + 256;
    const bf16_t* BQKV = (const bf16_t*)(P.ws + WS_BQKV); const float* MISC = (const float*)(P.ws + WS_MISC);
    const float* conv = P.in[I_BCONV] + (size_t)l * 4 * 1536;
    const int lane = c.lane, w = c.wave, fr = lane & 15, fq = lane >> 4;
    for (int unit = c.wg; unit < 2048; unit += c.nwg) {
        const int b = unit >> 9, h = (unit >> 7) & 3, n = unit & 127;
        const size_t tok0 = (size_t)b * 8192 + n * 64;
        if (w == 0) {
            const float a = MISC[(tok0 + lane) * 256 + 200 + h], bb = MISC[(tok0 + lane) * 256 + 204 + h];
            const float xx = a + P.in[I_BDTB][l * 4 + h];
            const float sp = fmaxf(xx, 0.f) + log1pf(__expf(-fabsf(xx)));
            const float g = -__expf(P.in[I_BALOG][l * 4 + h]) * sp;
            float cs = g;
#pragma unroll
            for (int o = 1; o < 64; o <<= 1) { const float t = shf(cs, lane - o); if (lane >= o) cs += t; }
            const float last = shf(cs, 63);
            GC[lane] = cs; BETA[lane] = sigmoidf_(bb); EGC[lane] = __expf(cs); EDEC[lane] = __expf(last - cs); if (lane == 0) GLAST[0] = __expf(last);
        }
        __syncthreads();
        {
            float cw[3][4][2], hx[3][3][2];
#pragma unroll
            for (int s = 0; s < 3; ++s) { const int col = s * 512 + h * 128 + 2 * lane;
#pragma unroll
                for (int j = 0; j < 4; ++j) { cw[s][j][0] = conv[j * 1536 + col]; cw[s][j][1] = conv[j * 1536 + col + 1]; }
#pragma unroll
                for (int d = 0; d < 3; ++d) { const int pos = n * 64 + 8 * w - 3 + d; unsigned v = 0u;
                    if (pos >= 0) v = *(const unsigned*)(BQKV + ((size_t)b * 8192 + pos) * 1536 + col);
                    hx[s][d][0] = bflo(v); hx[s][d][1] = bfhi(v); } }
#pragma unroll
            for (int i = 0; i < 8; ++i) { const int t = 8 * w + i; float y[3][2];
#pragma unroll
                for (int s = 0; s < 3; ++s) { const int col = s * 512 + h * 128 + 2 * lane; const unsigned v = *(const unsigned*)(BQKV + (tok0 + t) * 1536 + col); const float c0 = bflo(v), c1 = bfhi(v);
                    const float z0 = cw[s][0][0] * hx[s][0][0] + cw[s][1][0] * hx[s][1][0] + cw[s][2][0] * hx[s][2][0] + cw[s][3][0] * c0;
                    const float z1 = cw[s][0][1] * hx[s][0][1] + cw[s][1][1] * hx[s][1][1] + cw[s][2][1] * hx[s][2][1] + cw[s][3][1] * c1;
                    y[s][0] = siluf_(z0); y[s][1] = siluf_(z1);
                    hx[s][0][0] = hx[s][1][0]; hx[s][0][1] = hx[s][1][1]; hx[s][1][0] = hx[s][2][0]; hx[s][1][1] = hx[s][2][1]; hx[s][2][0] = c0; hx[s][2][1] = c1; }
                const float rq = rsqrtf(wave_sum(y[0][0] * y[0][0] + y[0][1] * y[0][1]) + RMS_EPS) * 0.08838834764831845f;
                const float rk = rsqrtf(wave_sum(y[1][0] * y[1][0] + y[1][1] * y[1][1]) + RMS_EPS);
                const float q0 = y[0][0] * rq, q1 = y[0][1] * rq, k0 = y[1][0] * rk, k1 = y[1][1] * rk;
                const float bt = BETA[t], eg = EGC[t], ed = EDEC[t];
                *(LAS unsigned*)(QN + t * DN_QS + 2 * lane) = cvt_pk_bf16(q0, q1);
                *(LAS unsigned*)(KN + t * DN_QS + 2 * lane) = cvt_pk_bf16(k0, k1);
                KTBG[(2 * lane) * DN_TS + t] = f2bf(k0 * bt * eg); KTBG[(2 * lane + 1) * DN_TS + t] = f2bf(k1 * bt * eg);
                KTDEC[(2 * lane) * DN_TS + t] = f2bf(k0 * ed); KTDEC[(2 * lane + 1) * DN_TS + t] = f2bf(k1 * ed);
                VTB[(2 * lane) * DN_TS + t] = f2bf(y[2][0] * bt); VTB[(2 * lane + 1) * DN_TS + t] = f2bf(y[2][1] * bt);
            }
        }
        __syncthreads();
        {
            const int rt = w & 3; const bool isqk = w >= 4; const LAS bf16_t* Asrc = isqk ? QN : KN;
            bf16x8 af[4];
#pragma unroll
            for (int ks = 0; ks < 4; ++ks) af[ks] = ldfragL(Asrc, DN_QS, rt * 16 + fr, ks * 32 + fq * 8);
            for (int ct = 0; ct < 4; ++ct) {
                f32x4 acc = (f32x4){0.f, 0.f, 0.f, 0.f};
                if (ct <= rt) {
#pragma unroll
                    for (int ks = 0; ks < 4; ++ks) acc = mfma16(af[ks], ldfragL(KN, DN_QS, ct * 16 + fr, ks * 32 + fq * 8), acc);
                }
                const int j = ct * 16 + fr; const float gj = GC[j];
#pragma unroll
                for (int r = 0; r < 4; ++r) { const int i = rt * 16 + 4 * fq + r; const float dec = __expf(fminf(GC[i] - gj, 0.f));
                    if (isqk) QK[i * DN_TS + j] = f2bf(i >= j ? acc[r] * dec : 0.f);
                    else MF[i * DN_MS + j] = (i > j) ? BETA[i] * acc[r] * dec : 0.f; }
            }
        }
        __syncthreads();
        {
            LAS float* TF = (LAS float*)KN;
            LAS float* SW = (LAS float*)(c.lds + DL_END + 64) + w * 272;
            if (w < 4) {
                const int I = w; float t[16];
#pragma unroll
                for (int i = 0; i < 16; ++i) { float sacc = (i == fr) ? 1.f : 0.f;
#pragma unroll
                    for (int j = 0; j < i; ++j) sacc -= MF[(16 * I + i) * DN_MS + 16 * I + j] * t[j];
                    t[i] = sacc; }
                if (fq == 0) {
#pragma unroll
                    for (int i = 0; i < 16; ++i) { TF[(16 * I + i) * DN_MS + 16 * I + fr] = t[i]; TB[(16 * I + i) * DN_TS + 16 * I + fr] = f2bf(t[i]); } }
            } else {
                for (int e = (w - 4) * 64 + lane; e < 4096; e += 256) { const int i = e >> 6, j = e & 63; if ((j >> 4) > (i >> 4)) TB[i * DN_TS + j] = 0; }
            }
            __syncthreads();
#pragma unroll
            for (int d = 1; d < 4; ++d) {
                if (w < 4 - d) {
                    const int J = w, I = w + d; f32x4 acc = (f32x4){0.f, 0.f, 0.f, 0.f};
                    for (int K = J; K < I; ++K)
#pragma unroll
                        for (int ks = 0; ks < 4; ++ks) acc = __builtin_amdgcn_mfma_f32_16x16x4f32(MF[(16 * I + fr) * DN_MS + 16 * K + 4 * ks + fq], TF[(16 * K + 4 * ks + fq) * DN_MS + 16 * J + fr], acc, 0, 0, 0);
#pragma unroll
                    for (int r = 0; r < 4; ++r) SW[(4 * fq + r) * 17 + fr] = acc[r];
                    asm volatile("s_waitcnt lgkmcnt(0)" ::: "memory");
                    f32x4 acc2 = (f32x4){0.f, 0.f, 0.f, 0.f};
#pragma unroll
                    for (int ks = 0; ks < 4; ++ks) acc2 = __builtin_amdgcn_mfma_f32_16x16x4f32(TF[(16 * I + fr) * DN_MS + 16 * I + 4 * ks + fq], SW[(4 * ks + fq) * 17 + fr], acc2, 0, 0, 0);
#pragma unroll
                    for (int r = 0; r < 4; ++r) { TF[(16 * I + 4 * fq + r) * DN_MS + 16 * J + fr] = -acc2[r]; TB[(16 * I + 4 * fq + r) * DN_TS + 16 * J + fr] = f2bf(-acc2[r]); }
                }
                __syncthreads();
            }
        }
#if DBG_TID
        {
            LAS int* FL = (LAS int*)(c.lds + DL_END);
            if (c.tid == 0) FL[0] = 0;
            __syncthreads();
            int f = 0;
            auto bad16 = [](bf16_t v) { return (v & 0x7f80) == 0x7f80; };
            auto bad32 = [](float v) { return (__float_as_uint(v) & 0x7f800000u) == 0x7f800000u; };
            for (int i = c.tid; i < 64; i += 512) { if (bad32(GC[i]) || bad32(EGC[i]) || bad32(EDEC[i]) || bad32(BETA[i])) f |= 1; }
            for (int i = c.tid; i < 64 * 128; i += 512) { const int r = i >> 7, cc = i & 127; if (bad16(QN[r * DN_QS + cc])) f |= 2; }
            for (int i = c.tid; i < 128 * 64; i += 512) { const int r = i >> 6, cc = i & 63; if (bad16(KTBG[r * DN_TS + cc])) f |= 4; if (bad16(KTDEC[r * DN_TS + cc])) f |= 8; if (bad16(VTB[r * DN_TS + cc])) f |= 16; }
            for (int i = c.tid; i < 64 * 64; i += 512) { const int r = i >> 6, cc = i & 63; if (bad32(MF[r * DN_MS + cc])) f |= 32; if (bad16(QK[r * DN_TS + cc])) f |= 64; if (bad16(TB[r * DN_TS + cc])) f |= 128; }
            if (f) __hip_atomic_fetch_or(&FL[0], f, __ATOMIC_RELAXED, __HIP_MEMORY_SCOPE_WORKGROUP);
            __syncthreads();
        }
#endif
        {
#pragma unroll
            for (int q = 0; q < 8; ++q) { const int tile = w * 8 + q, which = tile >> 5, it = (tile >> 3) & 3, dt = tile & 7;
                const LAS bf16_t* Bsrc = which ? VTB : KTBG; f32x4 acc = (f32x4){0.f, 0.f, 0.f, 0.f};
#pragma unroll
                for (int ks = 0; ks < 2; ++ks) acc = mfma16(ldfragL(TB, DN_TS, it * 16 + fr, ks * 32 + fq * 8), ldfragL(Bsrc, DN_TS, dt * 16 + fr, ks * 32 + fq * 8), acc);
                LAS bf16_t* dst = (which ? UT : WT) + (dt * 16 + fr) * DN_TS + it * 16 + 4 * fq;
                u32x2 pk; pk.x = cvt_pk_bf16(acc[0], acc[1]); pk.y = cvt_pk_bf16(acc[2], acc[3]); *(LAS u32x2*)dst = pk; }
        }
        __syncthreads();
        {
            bf16_t* DNA = (bf16_t*)(P.ws + WS_DNA) + (size_t)unit * 128 * 128; float* DNB = (float*)(P.ws + WS_DNB) + (size_t)unit * 128 * 128;
            bf16_t* DNQ = (bf16_t*)(P.ws + WS_DNQ) + (size_t)unit * 64 * 128; float* DNO = (float*)(P.ws + WS_DNO) + (size_t)unit * 64 * 128;
            const float glast = GLAST[0];
            for (int q = 0; q < 24; ++q) { const int tile = w * 24 + q; f32x4 acc = (f32x4){0.f, 0.f, 0.f, 0.f};
                if (tile < 64) {
                    const int mt = tile >> 3, nt = tile & 7;
#pragma unroll
                    for (int ks = 0; ks < 2; ++ks) acc = mfma16(ldfragL(WT, DN_TS, mt * 16 + fr, ks * 32 + fq * 8), ldfragL(KTDEC, DN_TS, nt * 16 + fr, ks * 32 + fq * 8), acc);
                    const int d1 = nt * 16 + fr, d2 = mt * 16 + 4 * fq; float v[4];
#pragma unroll
                    for (int r = 0; r < 4; ++r) v[r] = ((d1 == d2 + r) ? glast : 0.f) - acc[r];
#if DBG_TID
                    { const float fl = (float)((LAS int*)(c.lds + DL_END))[0]; v[0] = fl; v[1] = fl; v[2] = fl; v[3] = fl; }
#endif
                    u32x2 pk; pk.x = cvt_pk_bf16(v[0], v[1]); pk.y = cvt_pk_bf16(v[2], v[3]); *(u32x2*)(DNA + (size_t)d1 * 128 + d2) = pk;
                } else if (tile < 128) {
                    const int tt = tile - 64, mt = tt >> 3, nt = tt & 7;
#pragma unroll
                    for (int ks = 0; ks < 2; ++ks) acc = mfma16(ldfragL(KTDEC, DN_TS, mt * 16 + fr, ks * 32 + fq * 8), ldfragL(UT, DN_TS, nt * 16 + fr, ks * 32 + fq * 8), acc);
                    *(f32x4*)(DNB + (size_t)(tt * 64 + lane) * 4) = acc;
                } else if (tile < 160) {
                    const int tt = tile - 128, mt = tt >> 2, nt = tt & 3;
#pragma unroll
                    for (int ks = 0; ks < 2; ++ks) acc = mfma16(ldfragL(WT, DN_TS, mt * 16 + fr, ks * 32 + fq * 8), ldfragL(QK, DN_TS, nt * 16 + fr, ks * 32 + fq * 8), acc);
                    const int i = nt * 16 + fr, d = mt * 16 + 4 * fq; const float eg = EGC[i];
                    const u32x2 qw = *(const LAS u32x2*)(QN + i * DN_QS + d);
                    u32x2 pk; pk.x = cvt_pk_bf16(bflo(qw.x) * eg - acc[0], bfhi(qw.x) * eg - acc[1]); pk.y = cvt_pk_bf16(bflo(qw.y) * eg - acc[2], bfhi(qw.y) * eg - acc[3]);
                    *(u32x2*)(DNQ + (size_t)i * 128 + d) = pk;
                } else {
                    const int tt = tile - 160, mt = tt >> 2, nt = tt & 3;
#pragma unroll
                    for (int ks = 0; ks < 2; ++ks) acc = mfma16(ldfragL(UT, DN_TS, mt * 16 + fr, ks * 32 + fq * 8), ldfragL(QK, DN_TS, nt * 16 + fr, ks * 32 + fq * 8), acc);
                    *(f32x4*)(DNO + (size_t)(tt * 64 + lane) * 4) = acc;
                }
            }
        }
        __syncthreads();
    }
}

__device__ __forceinline__ void phase_dn_scan(const Ctx& c, const Params& P, int nwgs) {
    if (c.wg >= nwgs) return;
    LAS bf16_t* ST = (LAS bf16_t*)c.lds;
    const int lane = c.lane, w = c.wave, fr = lane & 15, fq = lane >> 4;
    for (int task = c.wg; task < 64; task += nwgs) {
        const int bh = task >> 2, sl = task & 3;
        for (int i = c.tid; i < 2 * 32 * DN_QS / 2; i += 512) ((LAS unsigned*)ST)[i] = 0u;
        __syncthreads();
        const bf16_t* DNA = (const bf16_t*)(P.ws + WS_DNA) + (size_t)bh * 128 * 128 * 128; const float* DNB = (const float*)(P.ws + WS_DNB) + (size_t)bh * 128 * 128 * 128;
        bf16_t* DNS = (bf16_t*)(P.ws + WS_DNS) + (size_t)bh * 128 * 128 * 128;
        { const int dvl = fr + 16 * (w & 1), d1 = 32 * (w >> 1) + fq * 8;
          *(u32x4*)(DNS + (size_t)(sl * 32 + dvl) * 128 + d1) = (u32x4){0u, 0u, 0u, 0u}; }
        constexpr int PF = 4;
        bf16x8 af[PF][4]; f32x4 bi[PF][2];
#pragma unroll
        for (int p = 0; p < PF; ++p) {
#pragma unroll
            for (int ks = 0; ks < 4; ++ks) af[p][ks] = ldfragG(DNA + (size_t)p * 128 * 128, 128, w * 16 + fr, ks * 32 + fq * 8);
#pragma unroll
            for (int nt = 0; nt < 2; ++nt) bi[p][nt] = *(const f32x4*)(DNB + (size_t)p * 128 * 128 + (size_t)((w * 8 + sl * 2 + nt) * 64 + lane) * 4);
        }
#pragma unroll
        for (int n = 0; n < 127; ++n) {
            const int p = n % PF;
            const LAS bf16_t* cur = ST + (n & 1) * 32 * DN_QS; LAS bf16_t* nxt = ST + ((n + 1) & 1) * 32 * DN_QS;
            f32x4 acc[2] = {bi[p][0], bi[p][1]};
            bf16x8 a2[4];
#pragma unroll
            for (int ks = 0; ks < 4; ++ks) a2[ks] = af[p][ks];
            if (n + PF < 127) {
                const bf16_t* An = DNA + (size_t)(n + PF) * 128 * 128; const float* Bn = DNB + (size_t)(n + PF) * 128 * 128;
#pragma unroll
                for (int ks = 0; ks < 4; ++ks) af[p][ks] = ldfragG(An, 128, w * 16 + fr, ks * 32 + fq * 8);
#pragma unroll
                for (int nt = 0; nt < 2; ++nt) bi[p][nt] = *(const f32x4*)(Bn + (size_t)((w * 8 + sl * 2 + nt) * 64 + lane) * 4);
            }
            __builtin_amdgcn_sched_barrier(0);
#pragma unroll
            for (int nt = 0; nt < 2; ++nt)
#pragma unroll
                for (int ks = 0; ks < 4; ++ks) acc[nt] = mfma16(a2[ks], ldfragL(cur, DN_QS, nt * 16 + fr, ks * 32 + fq * 8), acc[nt]);
            bf16_t* Sg = DNS + (size_t)(n + 1) * 128 * 128;
#pragma unroll
            for (int nt = 0; nt < 2; ++nt) { u32x2 pk; pk.x = cvt_pk_bf16(acc[nt][0], acc[nt][1]); pk.y = cvt_pk_bf16(acc[nt][2], acc[nt][3]);
                *(LAS u32x2*)(nxt + (nt * 16 + fr) * DN_QS + w * 16 + 4 * fq) = pk;
                *(u32x2*)(Sg + (size_t)(sl * 32 + nt * 16 + fr) * 128 + w * 16 + 4 * fq) = pk; }
            asm volatile("s_waitcnt lgkmcnt(0)" ::: "memory"); __builtin_amdgcn_s_barrier(); asm volatile("" ::: "memory");
        }
        __syncthreads();
    }
}

__device__ __forceinline__ void phase_dn_out(const Ctx& c, const Params& P, int l) {
    const int lane = c.lane, fr = lane & 15, fq = lane >> 4;
    const bf16_t* BZ = (const bf16_t*)(P.ws + WS_BZ); bf16_t* YB = (bf16_t*)(P.ws + WS_YB); const float* gn = P.in[I_BONORM] + l * 128;
    for (int task = c.wg * 8 + c.wave; task < 2048 * 4; task += c.nwg * 8) {
        const int unit = task >> 2, it = task & 3, b = unit >> 9, h = (unit >> 7) & 3, n = unit & 127;
        const bf16_t* S = (const bf16_t*)(P.ws + WS_DNS) + (size_t)unit * 128 * 128; const bf16_t* Q = (const bf16_t*)(P.ws + WS_DNQ) + (size_t)unit * 64 * 128;
        const float* O = (const float*)(P.ws + WS_DNO) + (size_t)unit * 64 * 128;
        bf16x8 bq[4];
#pragma unroll
        for (int ks = 0; ks < 4; ++ks) bq[ks] = ldfragG(Q, 128, it * 16 + fr, ks * 32 + fq * 8);
        f32x4 acc[8]; float ss = 0.f;
#pragma unroll
        for (int mt = 0; mt < 8; ++mt) { acc[mt] = *(const f32x4*)(O + (size_t)((mt * 4 + it) * 64 + lane) * 4);
#pragma unroll
            for (int ks = 0; ks < 4; ++ks) acc[mt] = mfma16(ldfragG(S, 128, mt * 16 + fr, ks * 32 + fq * 8), bq[ks], acc[mt]);
            ss += (acc[mt][0] * acc[mt][0] + acc[mt][1] * acc[mt][1]) + (acc[mt][2] * acc[mt][2] + acc[mt][3] * acc[mt][3]); }
        ss += shf(ss, lane ^ 16); ss += shf(ss, lane ^ 32);
        const float rs = rsqrtf(ss * (1.0f / 128.0f) + RMS_EPS);
        const size_t tok = (size_t)b * 8192 + n * 64 + it * 16 + fr;
#pragma unroll
        for (int mt = 0; mt < 8; ++mt) { const int dv = mt * 16 + 4 * fq; const u32x2 zw = *(const u32x2*)(BZ + tok * 512 + h * 128 + dv); const f32x4 g4 = *(const f32x4*)(gn + dv);
            u32x2 pk; pk.x = cvt_pk_bf16(acc[mt][0] * rs * g4[0] * siluf_(bflo(zw.x)), acc[mt][1] * rs * g4[1] * siluf_(bfhi(zw.x)));
            pk.y = cvt_pk_bf16(acc[mt][2] * rs * g4[2] * siluf_(bflo(zw.y)), acc[mt][3] * rs * g4[3] * siluf_(bfhi(zw.y)));
            *(u32x2*)(YB + tok * 512 + h * 128 + dv) = pk; }
    }
}

__device__ __forceinline__ f32x16 mfma32(bf16x8 a, bf16x8 b, f32x16 c) { return __builtin_amdgcn_mfma_f32_32x32x16_bf16(a, b, c, 0, 0, 0); }

constexpr int IX_KS = 72;
__device__ __forceinline__ void phase_idx_scores(const Ctx& c, const Params& P, int b, size_t sc_off = WS_SCORES) {
    LAS bf16_t* KL = (LAS bf16_t*)c.lds;
    const bf16_t* IQ = (const bf16_t*)(P.ws + WS_IDXQ) + (size_t)b * 8192 * 512; const bf16_t* IK = (const bf16_t*)(P.ws + WS_IDXK) + (size_t)b * 8192 * 64;
    const float* MISC = (const float*)(P.ws + WS_MISC) + (size_t)b * 8192 * 256; float* SC = (float*)(P.ws + sc_off);
    const int lane = c.lane, w = c.wave, l31 = lane & 31, lh = lane >> 5;
    constexpr int NBLK = 64 * 65 / 2;
    const int blk0 = (int)((long)c.wg * NBLK / c.nwg), blk1 = (int)((long)(c.wg + 1) * NBLK / c.nwg);
    int qt = 0; while ((qt + 1) * (qt + 2) / 2 <= blk0) ++qt;
    int kb = blk0 - qt * (qt + 1) / 2;
    for (int blk = blk0; blk < blk1; ++blk) {
        LAS bf16_t* kl = KL + (blk & 1) * 128 * IX_KS;
        { const int key = c.tid >> 2, pc = c.tid & 3; const bf16_t* src = IK + (size_t)(kb * 128 + key) * 64 + pc * 16;
          const u32x4 a = *(const u32x4*)src, bq = *(const u32x4*)(src + 8);
          *(LAS u32x4*)(kl + key * IX_KS + pc * 16) = a; *(LAS u32x4*)(kl + key * IX_KS + pc * 16 + 8) = bq; }
        __syncthreads();
        for (int hp = 0; hp < 2; ++hp) {
            const int qlo = qt * 128 + w * 16 + hp * 8;
            bf16x8 af[2][4]; float wq[2][2][8];
#pragma unroll
            for (int at = 0; at < 2; ++at) { const int qq = ((l31 >> 2) & 1) + 2 * (l31 >> 4), hd = (l31 & 3) + 4 * ((l31 >> 3) & 1);
#pragma unroll
                for (int ks = 0; ks < 4; ++ks) af[at][ks] = *(const bf16x8*)(IQ + (size_t)(qlo + 4 * at + qq) * 512 + hd * 64 + ks * 16 + lh * 8);
#pragma unroll
                for (int sub = 0; sub < 2; ++sub) { const float* wp = MISC + (size_t)(qlo + 4 * at + lh + 2 * sub) * 256 + 192; const f32x4 w0 = *(const f32x4*)wp, w1 = *(const f32x4*)(wp + 4);
                    wq[at][sub][0] = w0[0]; wq[at][sub][1] = w0[1]; wq[at][sub][2] = w0[2]; wq[at][sub][3] = w0[3]; wq[at][sub][4] = w1[0]; wq[at][sub][5] = w1[1]; wq[at][sub][6] = w1[2]; wq[at][sub][7] = w1[3]; } }
            for (int kt = 0; kt < 4; ++kt) {
                const int key0 = kb * 128 + kt * 32;
                if (key0 > qlo + 7) break;
                bf16x8 bf[4];
#pragma unroll
                for (int ks = 0; ks < 4; ++ks) bf[ks] = *(const LAS bf16x8*)(kl + (kt * 32 + l31) * IX_KS + ks * 16 + lh * 8);
#pragma unroll
                for (int at = 0; at < 2; ++at) {
                    f32x16 acc;
#pragma unroll
                    for (int q = 0; q < 16; ++q) acc[q] = 0.f;
#pragma unroll
                    for (int ks = 0; ks < 4; ++ks) acc = mfma32(af[at][ks], bf[ks], acc);
                    float s0 = 0.f, s1 = 0.f;
#pragma unroll
                    for (int hd = 0; hd < 8; ++hd) { s0 += wq[at][0][hd] * fmaxf(acc[hd], 0.f); s1 += wq[at][1][hd] * fmaxf(acc[8 + hd], 0.f); }
                    const int q0 = qlo + 4 * at + lh;
                    SC[(size_t)q0 * 8192 + key0 + l31] = s0; SC[(size_t)(q0 + 2) * 8192 + key0 + l31] = s1;
                }
            }
        }
        ++kb; if (kb > qt) { kb = 0; ++qt; }
    }
    __syncthreads();
}

__device__ __forceinline__ unsigned ord_key(float v) { const unsigned bits = __float_as_uint(v + 0.0f); return bits ^ ((bits >> 31) ? 0xFFFFFFFFu : 0x80000000u); }
__device__ __forceinline__ int mbcnt64(unsigned long long m) { return (int)__builtin_amdgcn_mbcnt_hi((unsigned)(m >> 32), __builtin_amdgcn_mbcnt_lo((unsigned)m, 0u)); }
constexpr int SEL_CAP = 1024;
__device__ __forceinline__ void phase_select(const Ctx& c, const Params& P, int b, size_t sc_off = WS_SCORES) {
    const float* SC = (const float*)(P.ws + sc_off); int* SEL = (int*)(P.ws + WS_SEL) + (size_t)b * 8192 * 256;
    const int lane = c.lane;
    LAS unsigned* CU = (LAS unsigned*)(c.lds + c.wave * (SEL_CAP * 8)); LAS int* CI = (LAS int*)(CU + SEL_CAP);
    for (int t = c.wg * 8 + c.wave; t < 8192; t += c.nwg * 8) {
        int* out = SEL + (size_t)t * 256;
        if (t < 256) { for (int i = lane; i < 256; i += 64) out[i] = i <= t ? i : 0; continue; }
        const float* row = SC + (size_t)t * 8192; const int n = t + 1, ngrp = (n + 63) >> 6;
        unsigned tau0 = 1u; int ks = 0, msamp = 0; unsigned su[8];
        if (n > SEL_CAP) {
            msamp = 512;
#pragma unroll
            for (int q = 0; q < 8; ++q) { const int sidx = (int)(((long)(lane + 64 * q) * n) >> 9); su[q] = ord_key(row[sidx]); }
            ks = (int)((448l * 512 + n - 1) / n); if (ks < 1) ks = 1;
        }
        int C = 0; bool ok = false;
        for (int attempt = 0; attempt < 5 && !ok; ++attempt) {
            if (n > SEL_CAP) {
                unsigned prefix = 0u;
                for (int bit = 31; bit >= 0; --bit) { const unsigned cand = prefix | (1u << bit); int cnt = 0;
#pragma unroll
                    for (int q = 0; q < 8; ++q) cnt += __popcll(__ballot(su[q] >= cand));
                    if (cnt >= ks) prefix = cand; }
                tau0 = prefix;
            }
            C = 0; bool over = false;
            const int nv4 = (n + 255) >> 8;
            for (int g0 = 0; g0 < nv4; g0 += 16) {
                f32x4 v4[16];
#pragma unroll
                for (int k = 0; k < 16; ++k) { v4[k] = (f32x4){0.f, 0.f, 0.f, 0.f}; if (g0 + k < nv4) v4[k] = *(const f32x4*)(row + (g0 + k) * 256 + lane * 4); }
#pragma unroll
                for (int k = 0; k < 16; ++k) {
                    if (g0 + k < nv4) {
                        const int idx0 = (g0 + k) * 256 + lane * 4; unsigned uq[4]; bool f[4]; int pre = 0, tot = 0;
#pragma unroll
                        for (int q = 0; q < 4; ++q) { uq[q] = (idx0 + q <= t) ? ord_key(v4[k][q]) : 0u; f[q] = uq[q] >= tau0; const unsigned long long m = __ballot(f[q]); pre += mbcnt64(m); tot += __popcll(m); }
                        int pos = C + pre;
#pragma unroll
                        for (int q = 0; q < 4; ++q) { if (f[q]) { if (pos < SEL_CAP) { CU[pos] = uq[q]; CI[pos] = idx0 + q; } ++pos; } }
                        C += tot;
                    }
                }
            }
            over = C > SEL_CAP;
            if (over) { ks = ks > 1 ? ks >> 1 : 1; if (n <= SEL_CAP) break; }
            else if (C < 256) { ks = ks * 2 + 8; if (ks > msamp) ks = msamp; if (n <= SEL_CAP) break; }
            else ok = true;
        }
        asm volatile("s_waitcnt lgkmcnt(0)" ::: "memory");
        if (ok) {
            unsigned cu[16];
#pragma unroll
            for (int q = 0; q < 16; ++q) { const int ci = lane + 64 * q; cu[q] = ci < C ? CU[ci] : 0u; }
            unsigned prefix = 0u;
            for (int bit = 31; bit >= 0; --bit) { const unsigned cand = prefix | (1u << bit); int cnt = 0;
#pragma unroll
                for (int q = 0; q < 16; ++q) cnt += __popcll(__ballot(cu[q] >= cand));
                if (cnt >= 256) prefix = cand;
                if (cnt == 256) break; }
            int cgt = 0;
#pragma unroll
            for (int q = 0; q < 16; ++q) cgt += __popcll(__ballot(cu[q] > prefix));
            const int need_eq = 256 - cgt; int obase = 0, eqseen = 0;
#pragma unroll
            for (int q = 0; q < 16; ++q) { const bool gt = cu[q] > prefix, eq = cu[q] == prefix; const unsigned long long meq = __ballot(eq);
                const bool take = gt || (eq && (eqseen + mbcnt64(meq)) < need_eq); const unsigned long long mt = __ballot(take);
                if (take) out[obase + mbcnt64(mt)] = CI[lane + 64 * q];
                obase += __popcll(mt); eqseen += __popcll(meq); }
        } else {
            unsigned prefix = 0u;
            for (int bit = 31; bit >= 0; --bit) { const unsigned cand = prefix | (1u << bit); int cnt = 0;
                for (int g = 0; g < ngrp; ++g) { const int idx = g * 64 + lane; const unsigned u = idx <= t ? ord_key(row[idx]) : 0u; cnt += __popcll(__ballot(u >= cand)); }
                if (cnt >= 256) prefix = cand;
                if (cnt == 256) break; }
            int cgt = 0;
            for (int g = 0; g < ngrp; ++g) { const int idx = g * 64 + lane; const unsigned u = idx <= t ? ord_key(row[idx]) : 0u; cgt += __popcll(__ballot(u > prefix)); }
            const int need_eq = 256 - cgt; int obase = 0, eqseen = 0;
            for (int g = 0; g < ngrp; ++g) { const int idx = g * 64 + lane; const unsigned u = idx <= t ? ord_key(row[idx]) : 0u;
                const bool gt = u > prefix, eq = u == prefix; const unsigned long long meq = __ballot(eq);
                const bool take = gt || (eq && (eqseen + mbcnt64(meq)) < need_eq); const unsigned long long mt = __ballot(take);
                if (take) out[obase + mbcnt64(mt)] = idx;
                obase += __popcll(mt); eqseen += __popcll(meq); }
        }
    }
    __syncthreads();
}

__device__ __forceinline__ unsigned off_b(unsigned row, unsigned ch) { return 256u * row + 16u * (ch ^ (((row & 3u) << 2) | ((row >> 2) & 3u))); }
__device__ __forceinline__ unsigned rho_of(unsigned kap) { return (kap & 32u) | (((kap >> 2) & 3u) << 3) | (((kap >> 4) & 1u) << 2) | (kap & 3u); }
__device__ __forceinline__ void tr_read4(unsigned a0, unsigned a1, unsigned a2, unsigned a3, bf16x8& x, bf16x8& y) {
    u32x2 r0, r1, r2, r3;
    asm volatile("ds_read_b64_tr_b16 %0, %4\n\tds_read_b64_tr_b16 %1, %5\n\tds_read_b64_tr_b16 %2, %6\n\tds_read_b64_tr_b16 %3, %7\n\ts_waitcnt lgkmcnt(0)"
                 : "=&v"(r0), "=&v"(r1), "=&v"(r2), "=&v"(r3) : "v"(a0), "v"(a1), "v"(a2), "v"(a3) : "memory");
    u32x4 xx; xx.x = r0.x; xx.y = r0.y; xx.z = r1.x; xx.w = r1.y; u32x4 yy; yy.x = r2.x; yy.y = r2.y; yy.z = r3.x; yy.w = r3.y;
    x = __builtin_bit_cast(bf16x8, xx); y = __builtin_bit_cast(bf16x8, yy);
}
constexpr int AT_TILE = 16384, AT_WAVE = AT_TILE + 256, AT_BIAS = 8 * AT_WAVE;
__device__ __forceinline__ void phase_attn(const Ctx& c, const Params& P) {
    const int lane = c.lane, w = c.wave, fr = lane & 15, fq = lane >> 4;
    LAS unsigned char* tile = c.lds + w * AT_WAVE; LAS int* kidx = (LAS int*)(tile + AT_TILE); LAS float* BT = (LAS float*)(c.lds + AT_BIAS);
    const unsigned tile_a = (unsigned)(size_t)tile;
    for (int i = c.tid; i < 129 * 8; i += 512) { const int d = i >> 3, h = i & 7; int bk;
        if (d < 16) bk = d; else { const int lg = 16 + (int)(logf((float)d / 16.0f) / 2.0794415416798357f * 16.0f); bk = lg < 31 ? lg : 31; }
        BT[i] = P.in[I_RELB][bk * 8 + h]; }
    __syncthreads();
    const bf16_t* QT = (const bf16_t*)(P.ws + WS_QT); const bf16_t* CKV = (const bf16_t*)(P.ws + WS_CKV); const int* SEL = (const int*)(P.ws + WS_SEL); bf16_t* CTX = (bf16_t*)(P.ws + WS_CTX);
    for (int t = c.wg * 8 + w; t < NTOK; t += c.nwg * 8) {
        const int b = t >> 13, s = t & 8191, nsel = s + 1 < 256 ? s + 1 : 256;
        bf16x8 qf[4];
#pragma unroll
        for (int ks = 0; ks < 4; ++ks) { u32x4 z = (u32x4){0u, 0u, 0u, 0u}; if (fr < 8) z = *(const u32x4*)(QT + (size_t)t * 1024 + fr * 128 + ks * 32 + fq * 8); qf[ks] = __builtin_bit_cast(bf16x8, z); }
        f32x4 ctx[8];
#pragma unroll
        for (int cc = 0; cc < 8; ++cc) ctx[cc] = (f32x4){0.f, 0.f, 0.f, 0.f};
        float mrun = -1e30f, lrun = 0.f;
        int nidx = lane < nsel ? SEL[(size_t)t * 256 + lane] : 0;
        u32x4 pre[8]; bool havepre = false;
        for (int ch = 0; ch * 64 < nsel; ++ch) {
            const bool more = (ch + 1) * 64 < nsel; int nnext = 0;
            if (more) { const int slot = (ch + 1) * 64 + lane; nnext = slot < nsel ? SEL[(size_t)t * 256 + slot] : 0; }
            kidx[lane] = nidx;
            asm volatile("s_waitcnt lgkmcnt(0)" ::: "memory");
#pragma unroll
            for (int it = 0; it < 16; ++it) { const int kap = it * 4 + fq; u32x4 v;
                if (it < 8 && havepre) v = pre[it & 7];
                else { const int ki = kidx[kap]; v = *(const u32x4*)(CKV + ((size_t)b * 8192 + ki) * 128 + fr * 8); }
                *(LAS u32x4*)(tile + off_b(rho_of(kap), fr)) = v; }
            asm volatile("s_waitcnt vmcnt(0) lgkmcnt(0)" ::: "memory");
            f32x4 sc[4];
#pragma unroll
            for (int rb = 0; rb < 4; ++rb) { sc[rb] = (f32x4){0.f, 0.f, 0.f, 0.f};
#pragma unroll
                for (int ks = 0; ks < 4; ++ks) { const bf16x8 a = *(const LAS bf16x8*)(tile + off_b(rho_of(16 * rb + fr), 4 * ks + fq)); sc[rb] = mfma16(a, qf[ks], sc[rb]); } }
            if (more) {
#pragma unroll
                for (int it = 0; it < 8; ++it) { const int ki = shi(nnext, it * 4 + fq); pre[it] = *(const u32x4*)(CKV + ((size_t)b * 8192 + ki) * 128 + fr * 8); } }
            havepre = more; nidx = nnext;
            float mx = -1e30f;
#pragma unroll
            for (int rb = 0; rb < 4; ++rb)
#pragma unroll
                for (int r = 0; r < 4; ++r) { const int kap = 16 * rb + 4 * fq + r; const int slot = ch * 64 + kap; int dist = s - kidx[kap]; dist = dist < 0 ? 0 : (dist > 128 ? 128 : dist);
                    float lg = sc[rb][r] * 0.125f + BT[dist * 8 + (fr & 7)]; lg = slot < nsel ? lg : -1e30f; sc[rb][r] = lg; mx = fmaxf(mx, lg); }
            mx = fmaxf(mx, shf(mx, lane ^ 16)); mx = fmaxf(mx, shf(mx, lane ^ 32));
            const float mnew = fmaxf(mrun, mx), alpha = __expf(mrun - mnew); mrun = mnew;
            float ps = 0.f; bf16x8 pf[2];
            { float pv[16];
#pragma unroll
              for (int rb = 0; rb < 4; ++rb)
#pragma unroll
                  for (int r = 0; r < 4; ++r) { const float p = sc[rb][r] > -1e29f ? __expf(sc[rb][r] - mnew) : 0.f; pv[rb * 4 + r] = p; ps += p; }
#pragma unroll
              for (int kk = 0; kk < 2; ++kk) { u32x4 pk; pk.x = cvt_pk_bf16(pv[kk * 8 + 0], pv[kk * 8 + 1]); pk.y = cvt_pk_bf16(pv[kk * 8 + 2], pv[kk * 8 + 3]); pk.z = cvt_pk_bf16(pv[kk * 8 + 4], pv[kk * 8 + 5]); pk.w = cvt_pk_bf16(pv[kk * 8 + 6], pv[kk * 8 + 7]);
                  pf[kk] = __builtin_bit_cast(bf16x8, pk); } }
            lrun = lrun * alpha + ps;
            float ar[4];
#pragma unroll
            for (int r = 0; r < 4; ++r) ar[r] = shf(alpha, (4 * fq + r) & 15);
#pragma unroll
            for (int cc = 0; cc < 8; ++cc) { ctx[cc][0] *= ar[0]; ctx[cc][1] *= ar[1]; ctx[cc][2] *= ar[2]; ctx[cc][3] *= ar[3]; }
#pragma unroll
            for (int kk = 0; kk < 2; ++kk)
#pragma unroll
                for (int c2 = 0; c2 < 4; ++c2) { bf16x8 b0, b1;
                    const unsigned q = fr >> 2, p = fr & 3;
                    const unsigned r0 = 32 * kk + 8 * fq + q, r1 = r0 + 4;
                    const unsigned a00 = tile_a + off_b(r0, 2 * (2 * c2) + (p >> 1)) + 8 * (p & 1), a01 = tile_a + off_b(r1, 2 * (2 * c2) + (p >> 1)) + 8 * (p & 1);
                    const unsigned a10 = tile_a + off_b(r0, 2 * (2 * c2 + 1) + (p >> 1)) + 8 * (p & 1), a11 = tile_a + off_b(r1, 2 * (2 * c2 + 1) + (p >> 1)) + 8 * (p & 1);
                    tr_read4(a00, a01, a10, a11, b0, b1);
                    ctx[2 * c2] = mfma16(pf[kk], b0, ctx[2 * c2]); ctx[2 * c2 + 1] = mfma16(pf[kk], b1, ctx[2 * c2 + 1]); }
        }
        lrun += shf(lrun, lane ^ 16); lrun += shf(lrun, lane ^ 32);
        const float linv = 1.0f / lrun; float li[4];
#pragma unroll
        for (int r = 0; r < 4; ++r) li[r] = shf(linv, (4 * fq + r) & 15);
        if (fq < 2) {
#pragma unroll
            for (int cc = 0; cc < 8; ++cc)
#pragma unroll
                for (int r = 0; r < 4; ++r) CTX[(size_t)t * 1024 + (4 * fq + r) * 128 + cc * 16 + fr] = f2bf(ctx[cc][r] * li[r]);
        }
    }
    __syncthreads();
}

__device__ __forceinline__ void phase_route(const Ctx& c, const Params& P, int l) {
    LAS int* LC = (LAS int*)c.lds;
    LAS int* LB = LC + 64;
    LAS int* LR = LC + 128;
    LAS int* LE = LC + 128 + 1024;
    const float* RL = (const float*)(P.ws + WS_RLOG); int* TOPI = (int*)(P.ws + WS_TOPI); float* TOPG = (float*)(P.ws + WS_TOPG); int* TOPR = (int*)(P.ws + WS_TOPR);
    unsigned* gcnt = (unsigned*)(P.ws + WS_CTL + CTL_MOECNT) + l * 64;
    const int lane = c.lane; const float rb = P.in[I_RTB][l * 64 + lane];
    for (int blk = c.wg; blk < NTOK / 128; blk += c.nwg) {
        if (c.tid < 64) LC[c.tid] = 0;
        __syncthreads();
        for (int i = 0; i < 16; ++i) { const int lt = c.wave * 16 + i, tok = blk * 128 + lt;
            const float sc = sigmoidf_(RL[(size_t)tok * 256 + lane]); float key = sc + rb; float mys = 0.f; int mye = 0; float ssum = 0.f;
#pragma unroll
            for (int j = 0; j < 8; ++j) { const float mx = wave_max(key); const unsigned long long m = __ballot(key == mx); const int src = m ? __ffsll((long long)m) - 1 : j;
                const float s = shf(sc, src); ssum += s; if (lane == j) { mys = s; mye = src; } if (lane == src) key = -1e30f; }
            if (lane < 8) { const int lr = __hip_atomic_fetch_add(&LC[mye], 1, __ATOMIC_RELAXED, __HIP_MEMORY_SCOPE_WORKGROUP); LR[lt * 8 + lane] = lr; LE[lt * 8 + lane] = mye;
                TOPI[(size_t)tok * 8 + lane] = mye; TOPG[(size_t)tok * 8 + lane] = mys / ssum * 2.5f; }
        }
        __syncthreads();
        if (c.tid < 64) LB[c.tid] = (int)atomicAdd(&gcnt[c.tid], (unsigned)LC[c.tid]);
        __syncthreads();
        for (int i = c.tid; i < 1024; i += 512) TOPR[(size_t)blk * 1024 + i] = LB[LE[i]] + LR[i];
        __syncthreads();
    }
}
__device__ __forceinline__ void phase_moe_book(const Ctx& c, const Params& P, int l) {
    LAS int* EB = (LAS int*)c.lds;
    const unsigned* gcnt = (const unsigned*)(P.ws + WS_CTL + CTL_MOECNT) + l * 64;
    int* SROW = (int*)(P.ws + WS_SROW); int* TEXP = (int*)(P.ws + WS_TEXP); int* EBASE = (int*)(P.ws + WS_EBASE);
    const int* TOPI = (const int*)(P.ws + WS_TOPI); const int* TOPR = (const int*)(P.ws + WS_TOPR);
    if (c.tid == 0) { int acc = 0; for (int e = 0; e < 64; ++e) { const int cnt = (int)__hip_atomic_load(&gcnt[e], __ATOMIC_RELAXED, __HIP_MEMORY_SCOPE_AGENT); EB[e] = acc; EB[64 + e] = cnt; acc += (cnt + 255) & ~255; } EB[128] = acc; }
    __syncthreads();
    if (c.wg == 0) { if (c.tid < 64) EBASE[c.tid] = EB[c.tid]; if (c.tid == 64) TEXP[MOE_TILES] = EB[128] >> 8; }
    for (int e = c.wg; e < 64; e += c.nwg) { const int base = EB[e], cnt = EB[64 + e], pad = (cnt + 255) & ~255;
        for (int i = cnt + c.tid; i < pad; i += 512) SROW[base + i] = 0;
        for (int i = c.tid; i < (pad >> 8); i += 512) TEXP[(base >> 8) + i] = e; }
    for (int i = c.wg * 512 + c.tid; i < NTOK * 8; i += c.nwg * 512) SROW[EB[TOPI[i]] + TOPR[i]] = i >> 3;
    __syncthreads();
}
__device__ __forceinline__ void phase_combine(const Ctx& c, const Params& P, int l, float* outF, bf16_t* outB) {
    const bf16_t* XMB = (const bf16_t*)(P.ws + WS_XMB); const bf16_t* YS = (const bf16_t*)(P.ws + WS_YS);
    const int* TOPI = (const int*)(P.ws + WS_TOPI); const int* TOPR = (const int*)(P.ws + WS_TOPR); const float* TOPG = (const float*)(P.ws + WS_TOPG); const int* EBASE = (const int*)(P.ws + WS_EBASE);
    const float* g = P.in[I_LN2G] + l * 1024; const float* bt = P.in[I_LN2B] + l * 1024; const int lane = c.lane;
    for (int tok = c.wg * 8 + c.wave; tok < NTOK; tok += c.nwg * 8) {
        f32x4 v[4];
#pragma unroll
        for (int q = 0; q < 4; ++q) { const u32x2 xw = *(const u32x2*)(XMB + (size_t)tok * 1024 + q * 256 + lane * 4); const f32x4 x = (f32x4){bflo(xw.x), bfhi(xw.x), bflo(xw.y), bfhi(xw.y)}; const u32x2 sh = *(const u32x2*)(YS + (size_t)tok * 1024 + q * 256 + lane * 4);
            v[q] = x * DN_ALPHA + (f32x4){bflo(sh.x), bfhi(sh.x), bflo(sh.y), bfhi(sh.y)}; }
        for (int k = 0; k < 8; ++k) { const int e = TOPI[(size_t)tok * 8 + k]; const size_t row = (size_t)NTOK + EBASE[e] + TOPR[(size_t)tok * 8 + k]; const float gt = TOPG[(size_t)tok * 8 + k];
#pragma unroll
            for (int q = 0; q < 4; ++q) { const u32x2 y = *(const u32x2*)(YS + row * 1024 + q * 256 + lane * 4); v[q] += (f32x4){bflo(y.x), bfhi(y.x), bflo(y.y), bfhi(y.y)} * gt; } }
        float s = 0.f;
#pragma unroll
        for (int q = 0; q < 4; ++q) s += (v[q][0] + v[q][1]) + (v[q][2] + v[q][3]);
        const float mu = wave_sum(s) * (1.0f / 1024.0f); float qq = 0.f;
#pragma unroll
        for (int q = 0; q < 4; ++q) { const f32x4 d = v[q] - mu; qq += (d[0] * d[0] + d[1] * d[1]) + (d[2] * d[2] + d[3] * d[3]); }
        const float rs = rsqrtf(wave_sum(qq) * (1.0f / 1024.0f) + LN_EPS);
#pragma unroll
        for (int q = 0; q < 4; ++q) { const f32x4 o = (v[q] - mu) * rs * *(const f32x4*)(g + q * 256 + lane * 4) + *(const f32x4*)(bt + q * 256 + lane * 4);
            if (outF) *(f32x4*)(outF + (size_t)tok * 1024 + q * 256 + lane * 4) = o;
            if (outB) { u32x2 wv; wv.x = cvt_pk_bf16(o[0], o[1]); wv.y = cvt_pk_bf16(o[2], o[3]); *(u32x2*)(outB + (size_t)tok * 1024 + q * 256 + lane * 4) = wv; } }
    }
}

constexpr int LDS_PARAM_OFF = LDS_BYTES - 1024;
__device__ __forceinline__ Params ld_params(LAS unsigned char* lds) {
    unsigned a_s = (unsigned)(size_t)lds + LDS_PARAM_OFF; asm volatile("" : "+s"(a_s) :: "memory");
    unsigned a_ = a_s; asm volatile("" : "+v"(a_));
    Params P; const LAS unsigned* src = (const LAS unsigned*)(size_t)a_;
#pragma unroll
    for (int i = 0; i < 33; ++i) { const unsigned lo = __builtin_amdgcn_readfirstlane(src[2 * i]), hi = __builtin_amdgcn_readfirstlane(src[2 * i + 1]); P.in[i] = (const float*)(const __attribute__((address_space(1))) float*)(((unsigned long long)hi << 32) | lo); }
    { const unsigned lo = __builtin_amdgcn_readfirstlane(src[66]), hi = __builtin_amdgcn_readfirstlane(src[67]); P.out = (float*)(__attribute__((address_space(1))) float*)(((unsigned long long)hi << 32) | lo); }
    { const unsigned lo = __builtin_amdgcn_readfirstlane(src[68]), hi = __builtin_amdgcn_readfirstlane(src[69]); P.ws = (unsigned char*)(__attribute__((address_space(1))) unsigned char*)(((unsigned long long)hi << 32) | lo); }
    return P;
}
__device__ __forceinline__ Ctx fresh_ctx(LAS unsigned char* lds, int wave) {
    Ctx c; int t = wave * 64 + (int)__builtin_amdgcn_mbcnt_hi(~0u, __builtin_amdgcn_mbcnt_lo(~0u, 0u)); asm volatile("" : "+v"(t)); c.tid = t; c.lane = t & 63; c.wave = __builtin_amdgcn_readfirstlane(t >> 6); c.wg = blockIdx.x; c.nwg = gridDim.x; c.lds = lds; return c;
}
#ifndef MK_DUMP_OFF
#define MK_DUMP_OFF WS_DNA
#define MK_DUMP_BF16 1
#define MK_DUMP_LD 1024
#endif
__device__ __forceinline__ void dbg_dump(const Ctx& c, const Params& P) {
    const size_t n = (size_t)NTOK * 1024;
    for (size_t i = (size_t)c.wg * 512 + c.tid; i < n; i += (size_t)c.nwg * 512)
    { const size_t row = i >> 10, col = i & 1023, j = row * MK_DUMP_LD + col;
        P.out[i] = col >= MK_DUMP_LD ? 0.f : (MK_DUMP_BF16 ? bf2f(((const bf16_t*)(P.ws + MK_DUMP_OFF))[j]) : ((const float*)(P.ws + MK_DUMP_OFF))[j]); }
}
#ifndef DUP_SEL
#define DUP_SEL 1
#define DUP_PREP 1
#define DUP_ATTN 1
#define DUP_P0 1
#define DUP_SCAN 1
#define DUP_SCORES 1
#endif
#ifndef MK_STOP_AFTER
#define MK_STOP_AFTER 100000
#endif
__global__ void __launch_bounds__(512, 2) hybrid_fwd(Params Pk) {
    extern __shared__ __attribute__((aligned(16))) unsigned char shm[];
    Ctx c0; c0.lds = (LAS unsigned char*)shm; c0.tid = threadIdx.x; c0.lane = c0.tid & 63; c0.wave = __builtin_amdgcn_readfirstlane(c0.tid >> 6); c0.wg = blockIdx.x; c0.nwg = gridDim.x;
#define CX (fresh_ctx(c0.lds, c0.wave))
    LAS unsigned* barw = (LAS unsigned*)(c0.lds + LDS_BYTES - 16);
    if (c0.tid == 0) { barw[0] = 0u; barw[1] = 0u; barw[2] = 0u; barw[3] = 0u; }
    if (c0.tid < 35) { LAS unsigned long long* d = (LAS unsigned long long*)(c0.lds + LDS_PARAM_OFF); d[c0.tid] = c0.tid < 33 ? (unsigned long long)Pk.in[c0.tid] : (c0.tid == 33 ? (unsigned long long)Pk.out : (unsigned long long)Pk.ws); }
    __syncthreads();
    XcdBarrier bar = xcd_barrier_post((unsigned*)(Pk.ws + WS_CTL + CTL_BAR), (volatile LAS unsigned*)barw, c0.tid);
#define PP (ld_params((CX).lds))
#define WSP (PP.ws)
#define GBAR() xcd_barrier_ni(bar.bar, bar.x, (unsigned)(size_t)bar.st, (CX).tid)
    phase_load_x(CX, PP);
    phase_p0(CX, PP, 0, true);
    GBAR();
#define LAYER_BODY(l) {\
        { const Ctx cc = CX; SchedPlain S; S.init(NTOK, NIN, 1024, WSP + WS_WIN, cc.nwg, cc.wg); EpiWin E; E.ws = WSP; pg8::gemm_phase(cc.lds, cc.wave, (const char*)(WSP + WS_XB), 1024, S, E); } \
        GBAR(); if ((l) * 100 + 2 >= MK_STOP_AFTER) { dbg_dump(CX, PP); return; } \
        phase_kvnorm(CX, PP, l); \
        for (int d_ = 0; d_ < DUP_PREP; ++d_) phase_dn_prep(CX, PP, l); \
        { const Ctx cc = CX; SchedGrouped S; S.init(32, 1024, 256, 512, WSP + WS_S5E, cc.nwg, cc.wg); S.lda = 640; EpiXloc E; E.O = (float*)(WSP + WS_XLOC); pg8::gemm_phase(cc.lds, cc.wave, (const char*)(WSP + WS_CUP), 512, S, E); } \
        GBAR(); if ((l) * 100 + 3 >= MK_STOP_AFTER) { dbg_dump(CX, PP); return; } \
          \
        if (c0.nwg > 64) { \
            if (c0.wg < 64) phase_dn_scan(CX, PP, 64); \
            else { phase_s5_carry(CX, PP, 64, c0.nwg - 64); Ctx c2 = CX; c2.wg -= 64; c2.nwg -= 64; phase_idx_scores(c2, PP, 0); } \
        } else { phase_dn_scan(CX, PP, c0.nwg); phase_s5_carry(CX, PP, 0, c0.nwg); phase_idx_scores(CX, PP, 0); } \
        phase_p0_experts(CX, PP, l); \
        GBAR(); if ((l) * 100 + 4 >= MK_STOP_AFTER) { dbg_dump(CX, PP); return; } \
        phase_dn_out(CX, PP, l); \
        { const Ctx cc = CX; SchedGrouped S; S.init(32, 1024, 512, 640, WSP + WS_S5TF, cc.nwg, cc.wg); S.lda = 640; EpiS5 E; E.O = (bf16_t*)(WSP + WS_YCPRE); pg8::gemm_phase(cc.lds, cc.wave, (const char*)(WSP + WS_CUP), 640, S, E); } \
        phase_select(CX, PP, 0); \
        GBAR(); if ((l) * 100 + 5 >= MK_STOP_AFTER) { dbg_dump(CX, PP); return; } \
          \
        phase_idx_scores(CX, PP, 1, WS_SCORES2); \
        GBAR(); if ((l) * 100 + 6 >= MK_STOP_AFTER) { dbg_dump(CX, PP); return; } \
        phase_idx_scores(CX, PP, 2, WS_SCORES); phase_select(CX, PP, 1, WS_SCORES2); \
        GBAR(); if ((l) * 100 + 7 >= MK_STOP_AFTER) { dbg_dump(CX, PP); return; } \
        phase_idx_scores(CX, PP, 3, WS_SCORES2); phase_select(CX, PP, 2, WS_SCORES); \
        GBAR(); if ((l) * 100 + 7 >= MK_STOP_AFTER) { dbg_dump(CX, PP); return; } \
        phase_select(CX, PP, 3, WS_SCORES2); \
        GBAR(); if ((l) * 100 + 7 >= MK_STOP_AFTER) { dbg_dump(CX, PP); return; } \
        for (int d_ = 0; d_ < DUP_ATTN; ++d_) phase_attn(CX, PP); \
        { const Ctx cc = CX; SchedPlain S; S.init(NTOK, 512, 512, WSP + WS_WGLU, cc.nwg, cc.wg); EpiGlu E; E.Y = (const bf16_t*)(WSP + WS_YCPRE); E.bias = PP.in[I_GLUB] + l * 512; E.O = (bf16_t*)(WSP + WS_YC); \
          pg8::gemm_phase(cc.lds, cc.wave, (const char*)(WSP + WS_YCPRE), 512, S, E); } \
        GBAR(); if ((l) * 100 + 8 >= MK_STOP_AFTER) { dbg_dump(CX, PP); return; } \
        { const Ctx cc = CX; SchedPlain S; S.init(NTOK, 1024, 1024, WSP + WS_WBRA, cc.nwg, cc.wg); EpiMerge<0> E; E.Mf = (float*)(WSP + WS_MERGED); E.Mb = (bf16_t*)(WSP + WS_MERGEDB); E.gates = (const bf16_t*)(WSP + WS_GATES); E.gcol0 = 0; \
          pg8::gemm_phase(cc.lds, cc.wave, (const char*)(WSP + WS_CTX), 1024, S, E); } \
        { const Ctx cc = CX; SchedMergeBC S; S.init(NTOK, 1024, 512, WSP + WS_WBRB, cc.nwg, cc.wg); S.offB = WS_YB; S.offC = WS_YC; S.BtB = (const char*)(WSP + WS_WBRB); S.BtC = (const char*)(WSP + WS_WBRC); \
          EpiMergeBC E; E.Mb = (bf16_t*)(WSP + WS_MERGEDB); E.gates = (const bf16_t*)(WSP + WS_GATES); pg8::gemm_phase(cc.lds, cc.wave, (const char*)WSP, 512, S, E); } \
        GBAR(); if ((l) * 100 + 9 >= MK_STOP_AFTER) { dbg_dump(CX, PP); return; } \
        { const Ctx cc = CX; SchedPlain S; S.init(NTOK, 1024, 1024, WSP + WS_WO, cc.nwg, cc.wg); EpiResid E; E.XB = (const bf16_t*)(WSP + WS_XB); E.O = (float*)(WSP + WS_XM); pg8::gemm_phase(cc.lds, cc.wave, (const char*)(WSP + WS_MERGEDB), 1024, S, E); } \
        GBAR(); if ((l) * 100 + 10 >= MK_STOP_AFTER) { dbg_dump(CX, PP); return; } \
        phase_ln(CX, (const float*)(WSP + WS_XM), PP.in[I_LN1G] + l * 1024, PP.in[I_LN1B] + l * 1024, (float*)nullptr, (bf16_t*)(WSP + WS_XMB)); \
        GBAR(); if ((l) * 100 + 11 >= MK_STOP_AFTER) { dbg_dump(CX, PP); return; } \
        { const Ctx cc = CX; SchedPlain S; S.init(NTOK, 256, 1024, WSP + WS_WRT, cc.nwg, cc.wg); EpiF32 E; E.O = (float*)(WSP + WS_RLOG); E.ld = 256; pg8::gemm_phase(cc.lds, cc.wave, (const char*)(WSP + WS_XMB), 1024, S, E); } \
        GBAR(); if ((l) * 100 + 12 >= MK_STOP_AFTER) { dbg_dump(CX, PP); return; } \
        phase_route(CX, PP, l); \
        GBAR(); if ((l) * 100 + 13 >= MK_STOP_AFTER) { dbg_dump(CX, PP); return; } \
        phase_moe_book(CX, PP, l); if ((l) + 1 < DEPTH) phase_p0(CX, PP, (l) + 1, false); \
        GBAR(); if ((l) * 100 + 14 >= MK_STOP_AFTER) { dbg_dump(CX, PP); return; } \
        { const Ctx cc = CX; SchedGU S; S.texp = (const int*)(WSP + WS_TEXP); S.srow = (const int*)(WSP + WS_SROW); S.ntiles = __builtin_amdgcn_readfirstlane(S.texp[MOE_TILES]); S.G = cc.nwg; S.c = cc.wg; S.Bt = (const char*)(WSP + WS_WGU); \
          EpiGU E; E.HS = (bf16_t*)(WSP + WS_HS); pg8::gemm_phase(cc.lds, cc.wave, (const char*)(WSP + WS_XMB), 1024, S, E); } \
        GBAR(); if ((l) * 100 + 15 >= MK_STOP_AFTER) { dbg_dump(CX, PP); return; } \
        { const Ctx cc = CX; SchedDown S; S.texp = (const int*)(WSP + WS_TEXP); S.ntiles = __builtin_amdgcn_readfirstlane(S.texp[MOE_TILES]); S.G = cc.nwg; S.c = cc.wg; S.Bt = (const char*)(WSP + WS_WDN); \
          EpiDown E; E.YS = (bf16_t*)(WSP + WS_YS); pg8::gemm_phase(cc.lds, cc.wave, (const char*)(WSP + WS_HS), 256, S, E); } \
        GBAR(); if ((l) * 100 + 16 >= MK_STOP_AFTER) { dbg_dump(CX, PP); return; } \
        if (l == DEPTH - 1) phase_combine(CX, PP, l, PP.out, (bf16_t*)nullptr); \
        else phase_combine(CX, PP, l, (float*)nullptr, (bf16_t*)(WSP + WS_XB)); \
        GBAR(); if ((l) * 100 + 17 >= MK_STOP_AFTER) { dbg_dump(CX, PP); return; } \
    }
    LAYER_BODY(0) LAYER_BODY(1) LAYER_BODY(2) LAYER_BODY(3)
#undef GBAR
#undef CX
#undef PP
#undef WSP
}

extern "C" void kernel_launch(void* const* d_in, const int* in_sizes, int n_in, void* d_out, int out_size, void* d_ws, size_t ws_size, hipStream_t stream) {
    static int grid = 0;
    if (grid == 0) {
        if (n_in != 33 || ws_size < WS_TOTAL) { fprintf(stderr, "kernel_launch: expected 33 inputs and >= %zu bytes of workspace; got %d inputs, %zu bytes\n", (size_t)WS_TOTAL, n_in, ws_size); grid = -1; return; }
        int dev = 0, cus = 0, per_cu = 0;
        if (hipGetDevice(&dev) != hipSuccess || hipDeviceGetAttribute(&cus, hipDeviceAttributeMultiprocessorCount, dev) != hipSuccess) { grid = -1; return; }
        if (hipFuncSetAttribute((const void*)hybrid_fwd, hipFuncAttributeMaxDynamicSharedMemorySize, LDS_BYTES) != hipSuccess) { fprintf(stderr, "kernel_launch: hipFuncSetAttribute failed\n"); grid = -1; return; }
        if (hipOccupancyMaxActiveBlocksPerMultiprocessor(&per_cu, (const void*)hybrid_fwd, 512, LDS_BYTES) != hipSuccess || per_cu < 1) { fprintf(stderr, "kernel_launch: occupancy query says %d\n", per_cu); per_cu = 1; }
        (void)hipGetLastError();
        grid = cus;
    }
    if (grid < 0) return;
    if (hipMemsetAsync((char*)d_ws + WS_CTL, 0, CTL_BYTES, stream) != hipSuccess) return;
    Params p{};
    for (int i = 0; i < 33; ++i) p.in[i] = (const float*)d_in[i];
    p.out = (float*)d_out; p.ws = (unsigned char*)d_ws;
    hipLaunchKernelGGL(hybrid_fwd, dim3(grid), dim3(512), LDS_BYTES, stream, p);
}
```

```cpp
#include <hip/hip_runtime.h>
#include <stdint.h>
#include <stdio.h>

#define LAS __attribute__((address_space(3)))
typedef unsigned short bf16_t;
typedef short bf16x8 __attribute__((ext_vector_type(8)));
typedef float f32x4 __attribute__((ext_vector_type(4)));
typedef float f32x16 __attribute__((ext_vector_type(16)));
typedef float f32x2 __attribute__((ext_vector_type(2)));
typedef unsigned u32x4 __attribute__((ext_vector_type(4)));
typedef unsigned u32x2 __attribute__((ext_vector_type(2)));

constexpr int D_MODEL = 1024, BATCH = 4, SEQ = 8192, DEPTH = 4, NTOK = BATCH * SEQ;
constexpr int D_IN = 6864;
constexpr float DN_ALPHA = 1.681792830507429f;
constexpr float LN_EPS = 1e-5f, RMS_EPS = 1e-6f;
constexpr int NWG_THREADS = 512;

typedef __bf16 bf16x2_t __attribute__((ext_vector_type(2)));
__device__ __forceinline__ unsigned cvt_pk_bf16(float lo, float hi) { const f32x2 v = {lo, hi}; const bf16x2_t r = __builtin_convertvector(v, bf16x2_t); return __builtin_bit_cast(unsigned, r); }
__device__ __forceinline__ bf16_t f2bf(float f) { unsigned u = __float_as_uint(f); u += 0x7FFFu + ((u >> 16) & 1u); return (bf16_t)(u >> 16); }
__device__ __forceinline__ float bf2f(bf16_t b) { return __uint_as_float(((unsigned)b) << 16); }
__device__ __forceinline__ float bflo(unsigned w) { return __uint_as_float(w << 16); }
__device__ __forceinline__ float bfhi(unsigned w) { return __uint_as_float(w & 0xffff0000u); }
__device__ __forceinline__ float sigmoidf_(float x) { return 1.0f / (1.0f + __expf(-x)); }
__device__ __forceinline__ float siluf_(float x) { return x / (1.0f + __expf(-x)); }
__device__ __forceinline__ int lane_opq() { int l = (int)__builtin_amdgcn_mbcnt_hi(~0u, __builtin_amdgcn_mbcnt_lo(~0u, 0u)); asm volatile("" : "+v"(l)); return l; }
__device__ __forceinline__ float shf(float v, int src) { return __int_as_float(__builtin_amdgcn_ds_bpermute(src << 2, __float_as_int(v))); }
__device__ __forceinline__ int shi(int v, int src) { return __builtin_amdgcn_ds_bpermute(src << 2, v); }
__device__ __forceinline__ float wave_sum(float v) {
    const int l = lane_opq();
#pragma unroll
    for (int o = 32; o >= 1; o >>= 1) v += shf(v, l ^ o);
    return v;
}
__device__ __forceinline__ float wave_max(float v) {
    const int l = lane_opq();
#pragma unroll
    for (int o = 32; o >= 1; o >>= 1) v = fmaxf(v, shf(v, l ^ o));
    return v;
}

#define XB_TMO      128
#define XB_XCNT(j)  (256  + 64 * (j))
#define XB_XSUB(j)  (1280 + 64 * (j))
#define XB_XGEN(j)  (2304 + 64 * (j))
#define XB_TOP      3328
#define XB_TOPGEN   3392
#define XCD_BAR_WORDS 3456
#define XB_SPIN_CAP (1u << 18)

__device__ __forceinline__ unsigned xb_ld(unsigned* p)              { return __hip_atomic_load(p, __ATOMIC_RELAXED, __HIP_MEMORY_SCOPE_AGENT); }
__device__ __forceinline__ unsigned xb_add(unsigned* p, unsigned v) { return __hip_atomic_fetch_add(p, v, __ATOMIC_RELAXED, __HIP_MEMORY_SCOPE_AGENT); }
__device__ __forceinline__ unsigned xb_xcc_id() { return (unsigned)__builtin_amdgcn_s_getreg((3 << 11) | 20) & 0xFu; }
#define XB_SPIN(cond, bar) do { unsigned _sp = 0; while (cond) { __builtin_amdgcn_s_sleep(1); \
    if ((++_sp & 255u) == 0u) { if (xb_ld(&(bar)[XB_TMO])) break; if (_sp > XB_SPIN_CAP) { atomicAdd(&(bar)[XB_TMO], 1u); break; } } } } while (0)

struct XcdBarrier { unsigned* bar; unsigned x; volatile LAS unsigned* st; };

__device__ __forceinline__ XcdBarrier xcd_barrier_post(unsigned* bar, volatile LAS unsigned* st, int tid) {
    XcdBarrier b; b.bar = bar; b.x = xb_xcc_id(); b.st = st;
    if (tid == 0) (void)xb_add(&bar[XB_XCNT(b.x)], 1u);
    return b;
}
__device__ __forceinline__ void xcd_barrier_complete(unsigned* bar, unsigned x, unsigned& nloc, unsigned& nx) {
    const unsigned G = gridDim.x * gridDim.y * gridDim.z;
    unsigned sum, cnt, mine, sp = 0u;
    for (;;) {
        sum = 0u; cnt = 0u; mine = 0u;
#pragma unroll
        for (unsigned j = 0; j < 16; ++j) { const unsigned c = xb_ld(&bar[XB_XCNT(j)]); sum += c; cnt += (c > 0u) ? 1u : 0u; mine = (j == x) ? c : mine; }
        if (sum == G) break;
        __builtin_amdgcn_s_sleep(1);
        if ((++sp & 255u) == 0u) { if (xb_ld(&bar[XB_TMO])) break; if (sp > XB_SPIN_CAP) { atomicAdd(&bar[XB_TMO], 1u); break; } }
    }
    nloc = mine > 0u ? mine : 1u; nx = cnt > 0u ? cnt : 1u;
}
__device__ __noinline__ void xcd_barrier_ni(unsigned* bar_, unsigned x_, unsigned st_, int tid) {
    XcdBarrier b; b.bar = bar_; b.x = x_; b.st = (volatile LAS unsigned*)(size_t)st_;
    asm volatile("s_waitcnt vmcnt(0)" ::: "memory");
    __syncthreads();
    if (tid == 0) {
        unsigned* bar = b.bar;
        __builtin_amdgcn_s_waitcnt(0);
        unsigned nloc = b.st[0], nx = b.st[1];
        if (nloc == 0u) { xcd_barrier_complete(bar, b.x, nloc, nx); b.st[0] = nloc; b.st[1] = nx; }
        const unsigned old = xb_add(&bar[XB_XSUB(b.x)], 1u);
        const unsigned gen = old / nloc;
        if (old + 1u == (gen + 1u) * nloc) {
            __builtin_amdgcn_fence(__ATOMIC_RELEASE, "agent");
            asm volatile("s_waitcnt vmcnt(0)" ::: "memory");
            const unsigned og = xb_add(&bar[XB_TOP], 1u);
            const unsigned tg = og / nx;
            if (og + 1u == (tg + 1u) * nx) xb_add(&bar[XB_TOPGEN], 1u);
            else XB_SPIN(xb_ld(&bar[XB_TOPGEN]) == tg, bar);
            __builtin_amdgcn_fence(__ATOMIC_ACQUIRE, "agent");
            xb_add(&bar[XB_XGEN(b.x)], 1u);
            asm volatile("s_waitcnt vmcnt(0)" ::: "memory");
        } else {
            XB_SPIN(xb_ld(&bar[XB_XGEN(b.x)]) == gen, bar);
            __builtin_amdgcn_fence(__ATOMIC_ACQUIRE, "agent");
            asm volatile("s_waitcnt vmcnt(0)" ::: "memory");
        }
    }
    __syncthreads();
}

namespace pg8 {
#ifndef PG8_A_AUX
#define PG8_A_AUX 0
#endif
constexpr int BM = 256, BK = 64, HALF = 128, HTB = HALF * BK * 2, STAGE_BYTES = 8 * HTB;
__device__ __forceinline__ int lds_byte(int r, int c) { const int st = (r >> 4) * 2 + (c >> 5), rr = r & 15, cc = c & 31, ob = rr * 64 + cc * 2; return st * 1024 + (ob ^ (((ob >> 9) & 1) << 5)); }
__device__ __forceinline__ void stage_rc(int b, int& R, int& C) { const int st = b / 1024, sb = b % 1024, swz = sb ^ (((sb >> 9) & 1) << 5); R = (st >> 1) * 16 + swz / 64; C = (st & 1) * 32 + (swz % 64) / 2; }
__device__ __forceinline__ int perm32(int rho) { const int n = rho >> 4, i = rho & 15; return 8 * (i >> 2) + 4 * n + (i & 3); }
struct Unit { int pm, pn; };

template <class Epi, class Sched>
__device__ __forceinline__ void gemm_phase(LAS unsigned char* lds, const int wave_, const char* Abase, const int K, const Sched& S, const Epi& E) {
    int tid_ = wave_ * 64 + (int)__builtin_amdgcn_mbcnt_hi(~0u, __builtin_amdgcn_mbcnt_lo(~0u, 0u)); asm volatile("" : "+v"(tid_));
    const int tid = tid_, wid = __builtin_amdgcn_readfirstlane(tid >> 6), lane = tid & 63, wr = wid >> 2, wc = wid & 3, fr = lane & 15, fq = lane >> 4;
    const int nt = K / BK;
    int RA[2], CA[2]; unsigned voffB[2];
#pragma unroll
    for (int i = 0; i < 2; ++i) { int R, C; stage_rc(tid * 16 + i * 8192, R, C); const int Rb = Epi::PERM ? ((R & ~31) + perm32(R & 31)) : R;
        RA[i] = R; CA[i] = C * 2; voffB[i] = (unsigned)(Rb * K + C) * 2u; }
    const size_t kstep = (size_t)(BK * 2);
    const size_t hstep = (size_t)HALF * K * 2;
    const unsigned ldsw = (unsigned)wid * 1024u;
    const int aoff = lds_byte(wr * 64 + fr, fq * 8), boff = lds_byte(wc * 32 + fr, fq * 8);
#define PG8_SA(b, h) (((b) * 2 + (h)) * HTB)
#define PG8_SB(b, h) ((4 + (b) * 2 + (h)) * HTB)
#define PG8_STAGE(bufoff, gbase, voff) do { _Pragma("unroll") for (int _i = 0; _i < 2; ++_i) \
        __builtin_amdgcn_global_load_lds((const unsigned*)((const char*)(gbase) + (voff)[_i]), (LAS unsigned*)(lds + (bufoff) + ldsw + _i * 8192), 16, 0, 0); } while (0)
#define PG8_STAGEA(bufoff, base, offs, kb) do { _Pragma("unroll") for (int _i = 0; _i < 2; ++_i) \
        __builtin_amdgcn_global_load_lds((const unsigned*)((base) + (size_t)(offs)[_i] + (size_t)(kb)), (LAS unsigned*)(lds + (bufoff) + ldsw + _i * 8192), 16, 0, PG8_A_AUX); } while (0)
#define PG8_LDA(dst, b, h) do { _Pragma("unroll") for (int m = 0; m < 4; ++m) _Pragma("unroll") for (int k = 0; k < 2; ++k) dst[m][k] = *(const LAS bf16x8*)(lds + PG8_SA(b, h) + aoff + m * 2048 + k * 1024); } while (0)
#define PG8_LDB(dst, b, h) do { _Pragma("unroll") for (int n = 0; n < 2; ++n) _Pragma("unroll") for (int k = 0; k < 2; ++k) dst[n][k] = *(const LAS bf16x8*)(lds + PG8_SB(b, h) + boff + n * 2048 + k * 1024); } while (0)
#define PG8_MMA(ai, bj, At, Bt) do { __builtin_amdgcn_s_setprio(1); _Pragma("unroll") for (int m = 0; m < 4; ++m) _Pragma("unroll") for (int n = 0; n < 2; ++n) _Pragma("unroll") for (int k = 0; k < 2; ++k) \
        acc[ai][bj][m][n] = __builtin_amdgcn_mfma_f32_16x16x32_bf16(Bt[n][k], At[m][k], acc[ai][bj][m][n], 0, 0, 0); __builtin_amdgcn_s_setprio(0); } while (0)
#define PG8_WAIT_V(n) asm volatile("s_waitcnt vmcnt(" #n ")" ::: "memory")
#define PG8_WAIT_L(n) asm volatile("s_waitcnt lgkmcnt(" #n ")" ::: "memory")
#define PG8_BAR __builtin_amdgcn_s_barrier()
#define PG8_SCHED __builtin_amdgcn_sched_barrier(0)
    Unit cur, nxt; int ui = 0;
    if (!S.next(0, cur)) return;
    f32x4 acc[2][2][4][2];
#pragma unroll
    for (int a = 0; a < 2; ++a)
#pragma unroll
        for (int b = 0; b < 2; ++b)
#pragma unroll
            for (int m = 0; m < 4; ++m)
#pragma unroll
                for (int n = 0; n < 2; ++n) acc[a][b][m][n] = (f32x4){0.f, 0.f, 0.f, 0.f};
    bf16x8 At[4][2], B0[2][2], B1[2][2];
    constexpr bool GA = Sched::GATHER;
    unsigned ac0[2], ac1[2];
    const size_t hstepA = GA ? (size_t)0 : (size_t)HALF * S.a_ld() * 2;
    const char* cA = Abase; const char* nA = Abase;
    if constexpr (GA) {
#pragma unroll
        for (int i = 0; i < 2; ++i) { ac0[i] = S.a_row_off(cur, RA[i]) + CA[i]; ac1[i] = S.a_row_off(cur, HALF + RA[i]) + CA[i]; }
    } else {
#pragma unroll
        for (int i = 0; i < 2; ++i) { ac0[i] = (unsigned)(RA[i] * S.a_ld() * 2 + CA[i]); ac1[i] = ac0[i]; }
        cA = Abase + (size_t)S.a_tile_off(cur);
    }
    const char* cB = S.b_ptr(cur);
    PG8_STAGE(PG8_SB(0, 0), cB, voffB); PG8_STAGEA(PG8_SA(0, 0), cA, ac0, 0); PG8_STAGE(PG8_SB(0, 1), cB + hstep, voffB); PG8_STAGEA(PG8_SA(0, 1), cA + hstepA, ac1, 0);
    if (wr == 1) PG8_BAR;
    PG8_WAIT_V(4); PG8_BAR;
    PG8_STAGE(PG8_SB(1, 0), cB + kstep, voffB); PG8_STAGEA(PG8_SA(1, 0), cA, ac0, kstep); PG8_STAGE(PG8_SB(1, 1), cB + hstep + kstep, voffB);
    PG8_WAIT_V(6); PG8_BAR;
    for (;;) {
        const bool has_next = S.next(ui + 1, nxt);
        const char* nB = has_next ? S.b_ptr(nxt) : cB;
        if constexpr (!GA) { nA = has_next ? Abase + (size_t)S.a_tile_off(nxt) : cA; }
        unsigned s0[2], s1[2];
        for (int t = 0; t < nt; t += 2) {
            const bool last = (t == nt - 2);
            const size_t k1 = (size_t)(t + 1) * kstep;
            const size_t k2 = last ? (size_t)0 : (size_t)(t + 2) * kstep;
            const char* b2 = last ? nB : cB + (size_t)(t + 2) * kstep;
            const char* b3 = b2 + kstep;
            const char* a2 = (last && !GA) ? nA : cA;
#pragma unroll
            for (int i = 0; i < 2; ++i) { s0[i] = ac0[i]; s1[i] = ac1[i]; }
            if constexpr (GA) { if (last && has_next) {
#pragma unroll
                for (int i = 0; i < 2; ++i) { int R, C; stage_rc(tid * 16 + i * 8192, R, C); s0[i] = S.a_row_off(nxt, R) + C * 2; s1[i] = S.a_row_off(nxt, HALF + R) + C * 2; } } }
            PG8_LDB(B0, 0, 0); PG8_SCHED; PG8_LDA(At, 0, 0); PG8_STAGEA(PG8_SA(1, 1), cA + hstepA, ac1, k1);
            PG8_WAIT_L(8); PG8_BAR; PG8_WAIT_L(0); PG8_MMA(0, 0, At, B0); PG8_BAR; PG8_SCHED;
            PG8_LDB(B1, 0, 1); PG8_STAGE(PG8_SB(0, 0), b2, voffB);
            PG8_BAR; PG8_WAIT_L(0); PG8_MMA(0, 1, At, B1); PG8_BAR;
            PG8_LDA(At, 0, 1); PG8_STAGEA(PG8_SA(0, 0), a2, s0, k2);
            PG8_BAR; PG8_WAIT_L(0); PG8_MMA(1, 0, At, B0); PG8_BAR; PG8_SCHED;
            PG8_STAGE(PG8_SB(0, 1), b2 + hstep, voffB);
            PG8_WAIT_V(6); PG8_BAR; PG8_MMA(1, 1, At, B1); PG8_BAR;
            PG8_LDB(B0, 1, 0); PG8_SCHED; PG8_LDA(At, 1, 0); PG8_STAGEA(PG8_SA(0, 1), a2 + hstepA, s1, k2);
            PG8_WAIT_L(8); PG8_BAR; PG8_WAIT_L(0); PG8_MMA(0, 0, At, B0); PG8_BAR; PG8_SCHED;
            PG8_LDB(B1, 1, 1); PG8_STAGE(PG8_SB(1, 0), b3, voffB);
            PG8_BAR; PG8_WAIT_L(0); PG8_MMA(0, 1, At, B1); PG8_BAR;
            PG8_LDA(At, 1, 1); PG8_STAGEA(PG8_SA(1, 0), a2, s0, k2 + kstep);
            PG8_BAR; PG8_WAIT_L(0); PG8_MMA(1, 0, At, B0); PG8_BAR; PG8_SCHED;
            PG8_STAGE(PG8_SB(1, 1), b3 + hstep, voffB);
            PG8_WAIT_V(6); PG8_BAR; PG8_MMA(1, 1, At, B1); PG8_BAR;
        }
        { int l2 = (int)__builtin_amdgcn_mbcnt_hi(~0u, __builtin_amdgcn_mbcnt_lo(~0u, 0u)); asm volatile("" : "+v"(l2)); E(acc, cur, wr, wc, l2 & 15, l2 >> 4); }
        if (!has_next) break;
#pragma unroll
        for (int a = 0; a < 2; ++a)
#pragma unroll
            for (int b = 0; b < 2; ++b)
#pragma unroll
                for (int m = 0; m < 4; ++m)
#pragma unroll
                    for (int n = 0; n < 2; ++n) acc[a][b][m][n] = (f32x4){0.f, 0.f, 0.f, 0.f};
        cur = nxt; cB = nB; cA = nA; ++ui;
        if constexpr (GA) {
#pragma unroll
            for (int i = 0; i < 2; ++i) { ac0[i] = s0[i]; ac1[i] = s1[i]; }
        }
    }
    PG8_WAIT_V(0);
    if (wr == 0) PG8_BAR;
    PG8_BAR;
#undef PG8_SA
#undef PG8_SB
#undef PG8_STAGE
#undef PG8_STAGEA
#undef PG8_LDA
#undef PG8_LDB
#undef PG8_MMA
#undef PG8_WAIT_V
#undef PG8_WAIT_L
#undef PG8_BAR
#undef PG8_SCHED
}
}
using pg8::Unit;

constexpr size_t al256(size_t x) { return (x + 255) & ~(size_t)255; }
constexpr size_t MB = 1024 * 1024;
constexpr size_t WS_CTL = 0;
constexpr size_t CTL_BAR = 0;
constexpr size_t CTL_MOECNT = 16384;
constexpr size_t CTL_BYTES = 32768;
constexpr int NIN = 7424;
constexpr size_t WS_WIN  = al256(WS_CTL + CTL_BYTES);
constexpr size_t WS_WBRA = WS_WIN  + (size_t)NIN * 1024 * 2;
constexpr size_t WS_WBRB = WS_WBRA + (size_t)1024 * 1024 * 2;
constexpr size_t WS_WBRC = WS_WBRB + (size_t)1024 * 512 * 2;
constexpr size_t WS_WO   = WS_WBRC + (size_t)1024 * 512 * 2;
constexpr size_t WS_WGLU = WS_WO   + (size_t)1024 * 1024 * 2;
constexpr size_t WS_WRT  = WS_WGLU + (size_t)512 * 512 * 2;
constexpr size_t WS_WGU  = WS_WRT  + (size_t)256 * 1024 * 2;
constexpr size_t WS_WDN  = WS_WGU  + (size_t)65 * 512 * 1024 * 2;
constexpr size_t WS_S5TF = WS_WDN  + (size_t)65 * 1024 * 256 * 2;
constexpr size_t WS_S5E  = WS_S5TF + (size_t)32 * 512 * 640 * 2;
constexpr size_t WS_S5A32 = WS_S5E + (size_t)32 * 256 * 512 * 2;
constexpr size_t WS_WEND = al256(WS_S5A32 + 32 * 64 * 8);
constexpr size_t WS_X   = WS_WEND;
constexpr size_t WS_XB  = WS_X  + (size_t)NTOK * 1024 * 4;
constexpr size_t WS_XM  = WS_XB + (size_t)NTOK * 1024 * 2;
constexpr size_t WS_XMB = WS_XM + (size_t)NTOK * 1024 * 4;
constexpr size_t WS_R   = WS_XMB + (size_t)NTOK * 1024 * 2;
constexpr size_t WS_QT    = WS_R;
constexpr size_t WS_IDXQ  = WS_QT    + (size_t)NTOK * 1024 * 2;
constexpr size_t WS_BQKV  = WS_IDXQ  + (size_t)NTOK * 512 * 2;
constexpr size_t WS_BZ    = WS_BQKV  + (size_t)NTOK * 1536 * 2;
constexpr size_t WS_CUP   = WS_BZ    + (size_t)NTOK * 512 * 2;
constexpr size_t WS_GATES = WS_CUP   + (size_t)32 * 1024 * 640 * 2;
constexpr size_t WS_MISC  = WS_GATES + (size_t)NTOK * 3072 * 2;
constexpr size_t WS_CKV   = WS_MISC  + (size_t)NTOK * 256 * 4;
constexpr size_t WS_IDXK  = WS_CKV   + (size_t)NTOK * 128 * 2;
constexpr size_t WS_SEL   = WS_IDXK  + (size_t)NTOK * 64 * 2;
constexpr size_t WS_CTX   = WS_SEL   + (size_t)NTOK * 256 * 4;
constexpr size_t WS_YB    = WS_CTX   + (size_t)NTOK * 1024 * 2;
constexpr size_t WS_XLOC  = WS_YB    + (size_t)NTOK * 512 * 2;
constexpr size_t WS_YCPRE = WS_XLOC  + (size_t)32 * 1024 * 256 * 4;
constexpr size_t WS_YC    = WS_YCPRE + (size_t)NTOK * 512 * 2;
constexpr size_t WS_U     = WS_YC    + (size_t)NTOK * 512 * 2;
constexpr size_t WS_DNA   = WS_U;
constexpr size_t WS_DNB   = WS_DNA + (size_t)2048 * 128 * 128 * 2;
constexpr size_t WS_DNQ   = WS_DNB + (size_t)2048 * 128 * 128 * 4;
constexpr size_t WS_DNO   = WS_DNQ + (size_t)2048 * 64 * 128 * 2;
constexpr size_t WS_DNS   = WS_DNO + (size_t)2048 * 64 * 128 * 4;
constexpr size_t WS_UEND  = WS_DNS + (size_t)2048 * 128 * 128 * 2;
constexpr size_t WS_SCORES = WS_UEND;
constexpr size_t WS_MERGED = WS_U;
constexpr size_t WS_MERGEDB = WS_MERGED + (size_t)NTOK * 1024 * 4;
static_assert(WS_MERGEDB + (size_t)NTOK * 1024 * 2 <= WS_UEND, "union");
constexpr size_t WS_SCORES2 = WS_U;
static_assert((size_t)8192 * 8192 * 4 <= WS_UEND - WS_U, "scores2");
constexpr size_t WS_MIXEND = WS_SCORES + (size_t)8192 * 8192 * 4;
constexpr int MOE_ROWS = NTOK * 8 + 64 * 256;
constexpr int MOE_TILES = MOE_ROWS / 256;
constexpr size_t WS_RLOG  = WS_R;
constexpr size_t WS_TOPI  = WS_RLOG + (size_t)NTOK * 256 * 4;
constexpr size_t WS_TOPG  = WS_TOPI + (size_t)NTOK * 8 * 4;
constexpr size_t WS_TOPR  = WS_TOPG + (size_t)NTOK * 8 * 4;
constexpr size_t WS_SROW  = WS_TOPR + (size_t)NTOK * 8 * 4;
constexpr size_t WS_TEXP  = WS_SROW + (size_t)MOE_ROWS * 4;
constexpr size_t WS_EBASE = WS_TEXP + al256((MOE_TILES + 8) * 4);
constexpr size_t WS_HS    = al256(WS_EBASE + 256);
constexpr size_t WS_YS    = WS_HS + (size_t)(NTOK + MOE_ROWS) * 256 * 2;
constexpr size_t WS_MOEEND = WS_YS + (size_t)(NTOK + MOE_ROWS) * 1024 * 2;
constexpr size_t WS_TOTAL = WS_MIXEND > WS_MOEEND ? WS_MIXEND : WS_MOEEND;
static_assert(WS_TOTAL < (size_t)2040 * MB, "workspace budget");

constexpr int LDS_BYTES = 147456;

struct Params {
    const float* in[33];
    float* out;
    unsigned char* ws;
};
enum { I_X = 0, I_RELB, I_WIN, I_KVN, I_KVUP, I_BCONV, I_BALOG, I_BDTB, I_BONORM, I_CLRE, I_CLIM, I_CLOGDT, I_CBRE, I_CBIM, I_CCRE, I_CCIM, I_CD,
       I_GLUW, I_GLUB, I_WBRA, I_WBRB, I_WBRC, I_WO, I_LN1G, I_LN1B, I_RTW, I_RTB, I_EGU, I_EDN, I_SGU, I_SDN, I_LN2G, I_LN2B };

struct Ctx {
    LAS unsigned char* lds; int tid, lane, wave, wg, nwg;
};

template <class Map>
__device__ __forceinline__ void cvt_tile(const Ctx& c, const float* __restrict__ src, int ld, bf16_t* __restrict__ dst, int K, int n0, int k0, const Map& map) {
    LAS float* t = (LAS float*)c.lds;
    const int n = c.tid & 63, kq = c.tid >> 6;
    const int sc = map(n0 + n);
#pragma unroll
    for (int i = 0; i < 8; ++i) { const int k = i * 8 + kq; t[k * 65 + n] = sc >= 0 ? src[(size_t)(k0 + k) * ld + sc] : 0.f; }
    __syncthreads();
    { const int nn = c.tid >> 3, kc = (c.tid & 7) * 8; u32x4 w;
      w.x = cvt_pk_bf16(t[(kc + 0) * 65 + nn], t[(kc + 1) * 65 + nn]); w.y = cvt_pk_bf16(t[(kc + 2) * 65 + nn], t[(kc + 3) * 65 + nn]);
      w.z = cvt_pk_bf16(t[(kc + 4) * 65 + nn], t[(kc + 5) * 65 + nn]); w.w = cvt_pk_bf16(t[(kc + 6) * 65 + nn], t[(kc + 7) * 65 + nn]);
      *(u32x4*)(dst + (size_t)(n0 + nn) * K + k0 + kc) = w; }
    __syncthreads();
}
template <class Map>
__device__ __forceinline__ void cvt_tile4(const Ctx& c, const float* __restrict__ src, int ld, bf16_t* __restrict__ dst, int K, int n0, int k0, const Map& map) {
    LAS float* t = (LAS float*)c.lds;
    const int n = c.tid & 63, kq = c.tid >> 6;
    const int sc = map(n0 + n);
    float v[32];
#pragma unroll
    for (int i = 0; i < 32; ++i) { const int k = i * 8 + kq; v[i] = sc >= 0 ? src[(size_t)(k0 + k) * ld + sc] : 0.f; }
#pragma unroll
    for (int i = 0; i < 32; ++i) { const int k = i * 8 + kq; t[(k >> 6) * (64 * 65) + (k & 63) * 65 + n] = v[i]; }
    __syncthreads();
    { const int nn = c.tid >> 3, kc = (c.tid & 7) * 8;
#pragma unroll
      for (int sb = 0; sb < 4; ++sb) { const LAS float* tt = t + sb * (64 * 65); u32x4 w;
        w.x = cvt_pk_bf16(tt[(kc + 0) * 65 + nn], tt[(kc + 1) * 65 + nn]); w.y = cvt_pk_bf16(tt[(kc + 2) * 65 + nn], tt[(kc + 3) * 65 + nn]);
        w.z = cvt_pk_bf16(tt[(kc + 4) * 65 + nn], tt[(kc + 5) * 65 + nn]); w.w = cvt_pk_bf16(tt[(kc + 6) * 65 + nn], tt[(kc + 7) * 65 + nn]);
        *(u32x4*)(dst + (size_t)(n0 + nn) * K + k0 + sb * 64 + kc) = w; } }
    __syncthreads();
}
struct MapIdent { __device__ int operator()(int n) const { return n; } };
struct MapLimit { int lim; __device__ int operator()(int n) const { return n < lim ? n : -1; } };
struct MapWin {
    __device__ int operator()(int n) const {
        if (n < 512) return 640 + n;
        if (n < 2048) return 1224 + (n - 512);
        if (n < 2560) return 2760 + (n - 2048);
        if (n < 3072) return 3280 + (n - 2560);
        if (n < 6144) return 3792 + (n - 3072);
        if (n < 6272) return 512 + (n - 6144);
        if (n < 6336) return 1152 + (n - 6272);
        if (n < 6344) return 1216 + (n - 6336);
        if (n < 6348) return 3272 + (n - 6344);
        if (n < 6352) return 3276 + (n - 6348);
        return -1;
    }
};
struct MapGU { __device__ int operator()(int n) const { const int j = n >> 8, p = n & 255; return p < 128 ? 128 * j + p : 256 + 128 * j + (p - 128); } };

__device__ __forceinline__ void sincos_rev(float phi, float& s, float& c) {
    float r = phi * 0.15915494309189535f; r -= rintf(r);
    s = __builtin_amdgcn_sinf(r); c = __builtin_amdgcn_cosf(r);
}

template <class Map>
__device__ __forceinline__ void cvt_direct(const Ctx& c, const float* __restrict__ src, int ld, bf16_t* __restrict__ dst, int K, int n0, int k0, const Map& map) {
    const int kb = (c.tid >> 6) * 8, n4 = (c.tid & 63) * 4; const int sc = map(n0 + n4);
    f32x4 v[8];
#pragma unroll
    for (int i = 0; i < 8; ++i) v[i] = *(const f32x4*)(src + (size_t)(k0 + kb + i) * ld + sc);
#pragma unroll
    for (int q = 0; q < 4; ++q) { u32x4 w; w.x = cvt_pk_bf16(v[0][q], v[1][q]); w.y = cvt_pk_bf16(v[2][q], v[3][q]); w.z = cvt_pk_bf16(v[4][q], v[5][q]); w.w = cvt_pk_bf16(v[6][q], v[7][q]);
        *(u32x4*)(dst + (size_t)(n0 + n4 + q) * K + k0 + kb) = w; }
}
__device__ __forceinline__ void p0_small_tile(const Ctx& c, const Params& P, int l, int j) {
    unsigned char* ws = P.ws;
    constexpr int J0 = 400, J1 = J0 + 32, J2 = J1 + 32, J3 = J2 + 64, J4 = J3 + 16, J5 = J4 + 16;
    if (j < J0) {}
        else if (j < J1) { const int q = j - J0, nt = q >> 1, kt = q & 1;
            cvt_tile4(c, P.in[I_WBRB] + (size_t)l * 512 * 1024, 1024, (bf16_t*)(ws + WS_WBRB), 512, nt * 64, kt * 256, MapIdent()); }
        else if (j < J2) { const int q = j - J1, nt = q >> 1, kt = q & 1;
            cvt_tile4(c, P.in[I_WBRC] + (size_t)l * 512 * 1024, 1024, (bf16_t*)(ws + WS_WBRC), 512, nt * 64, kt * 256, MapIdent()); }
        else if (j < J3) { const int q = j - J2, nt = q >> 2, kt = q & 3;
            cvt_tile4(c, P.in[I_WO] + (size_t)l * 1024 * 1024, 1024, (bf16_t*)(ws + WS_WO), 1024, nt * 64, kt * 256, MapIdent()); }
        else if (j < J4) { const int q = j - J3, nt = q >> 1, kt = q & 1;
            cvt_tile4(c, P.in[I_GLUW] + (size_t)l * 512 * 512, 512, (bf16_t*)(ws + WS_WGLU), 512, nt * 64, kt * 256, MapIdent()); }
        else if (j < J5) { const int q = j - J4, nt = q >> 2, kt = q & 3; MapLimit m; m.lim = 64;
            cvt_tile4(c, P.in[I_RTW] + (size_t)l * 1024 * 64, 64, (bf16_t*)(ws + WS_WRT), 1024, nt * 64, kt * 256, m); }
}
__device__ __forceinline__ void p0_wbra_job(const Ctx& c, const Params& P, int l, int h, int blk) {
    unsigned char* ws = P.ws;
    LAS float* tA = (LAS float*)c.lds; LAS float* tB = tA + 64 * 65;
    const float* kvup = P.in[I_KVUP] + (size_t)l * 128 * 1024;
                const float* wbr = P.in[I_WBRA] + (size_t)l * 512 * 1024;
                for (int i = c.tid; i < 64 * 64; i += 512) { const int e = i >> 6, cc = i & 63; tA[cc * 65 + e] = wbr[(size_t)(h * 64 + e) * 1024 + blk * 64 + cc]; }
                for (int i = c.tid; i < 128 * 64; i += 512) { const int r = i >> 6, e = i & 63; tB[r * 65 + e] = kvup[(size_t)r * 1024 + 512 + h * 64 + e]; }
                __syncthreads();
#pragma unroll
                for (int it = 0; it < 2; ++it) { const int o = c.tid + it * 512, cc = o >> 4, r8 = (o & 15) * 8; float a[8];
#pragma unroll
                    for (int q = 0; q < 8; ++q) a[q] = 0.f;
                    for (int e = 0; e < 64; ++e) { const float b = tA[cc * 65 + e];
#pragma unroll
                        for (int q = 0; q < 8; ++q) a[q] += tB[(r8 + q) * 65 + e] * b; }
                    u32x4 w; w.x = cvt_pk_bf16(a[0], a[1]); w.y = cvt_pk_bf16(a[2], a[3]); w.z = cvt_pk_bf16(a[4], a[5]); w.w = cvt_pk_bf16(a[6], a[7]);
                    *(u32x4*)((bf16_t*)(ws + WS_WBRA) + (size_t)(blk * 64 + cc) * 1024 + h * 128 + r8) = w; }
                __syncthreads();
}
__device__ __forceinline__ void p0_wincomb_job(const Ctx& c, const Params& P, int l, int h, int blk) {
    unsigned char* ws = P.ws;
    LAS float* tA = (LAS float*)c.lds; LAS float* tB = tA + 64 * 65;
    const float* kvup = P.in[I_KVUP] + (size_t)l * 128 * 1024;
                const float* win = P.in[I_WIN] + (size_t)l * 1024 * D_IN;
                for (int i = c.tid; i < 64 * 64; i += 512) { const int dm = i >> 6, e = i & 63; tA[dm * 65 + e] = win[(size_t)(blk * 64 + dm) * D_IN + h * 64 + e]; }
                for (int i = c.tid; i < 128 * 64; i += 512) { const int r = i >> 6, e = i & 63; tB[r * 65 + e] = kvup[(size_t)r * 1024 + h * 64 + e]; }
                __syncthreads();
#pragma unroll
                for (int it = 0; it < 2; ++it) { const int o = c.tid + it * 512, r = o >> 3, d8 = (o & 7) * 8; float a[8];
#pragma unroll
                    for (int q = 0; q < 8; ++q) a[q] = 0.f;
                    for (int e = 0; e < 64; ++e) { const float b = tB[r * 65 + e];
#pragma unroll
                        for (int q = 0; q < 8; ++q) a[q] += tA[(d8 + q) * 65 + e] * b; }
                    u32x4 w; w.x = cvt_pk_bf16(a[0], a[1]); w.y = cvt_pk_bf16(a[2], a[3]); w.z = cvt_pk_bf16(a[4], a[5]); w.w = cvt_pk_bf16(a[6], a[7]);
                    *(u32x4*)((bf16_t*)(ws + WS_WIN) + (size_t)(h * 128 + r) * 1024 + blk * 64 + d8) = w; }
                __syncthreads();
}
constexpr int P0X_SMALL = 128 + 160;
constexpr int P0X_JOBS = P0X_SMALL + 2080 + 1040;
constexpr int P0X_WIN = 400 + 128;
__device__ __forceinline__ void phase_p0_experts(const Ctx& c, const Params& P, int l) {
    unsigned char* ws = P.ws; unsigned* ctr = (unsigned*)(ws + WS_CTL + 20480) + 64 * l;
    LAS int* slot = (LAS int*)(c.lds + 70000);
    for (;;) {
        if (c.tid == 0) slot[0] = (int)atomicAdd(ctr, 1u);
        __syncthreads();
        const int qw = __builtin_amdgcn_readfirstlane(slot[0]);
        const int nwin = l + 1 < DEPTH ? P0X_WIN : 0;
        if (qw >= P0X_JOBS + nwin) break;
        __syncthreads();
        if (qw < nwin) {
            if (qw < 400) cvt_tile4(c, P.in[I_WIN] + (size_t)(l + 1) * 1024 * D_IN, D_IN, (bf16_t*)(ws + WS_WIN) + (size_t)1024 * 1024, 1024, (qw >> 2) * 64, (qw & 3) * 256, MapWin());
            else p0_wincomb_job(c, P, l + 1, (qw - 400) >> 4, (qw - 400) & 15);
            continue;
        }
        const int qa = qw - nwin;
        const int q0 = qa - P0X_SMALL;
        if (qa < 128) p0_wbra_job(c, P, l, qa >> 4, qa & 15);
        else if (qa < P0X_SMALL) p0_small_tile(c, P, l, 400 + qa - 128);
        else if (q0 < 2080) { const int e = q0 >> 5, r = q0 & 31, nt = r >> 4, kt = r & 15;
            const float* src = e < 64 ? P.in[I_EGU] + ((size_t)l * 64 + e) * 1024 * 512 : P.in[I_SGU] + (size_t)l * 1024 * 512;
            cvt_direct(c, src, 512, (bf16_t*)(ws + WS_WGU) + (size_t)e * 512 * 1024, 1024, nt * 256, kt * 64, MapGU()); }
        else { const int q = q0 - 2080, e = q >> 4, nt = (q >> 2) & 3, kt = q & 3;
            const float* src = e < 64 ? P.in[I_EDN] + ((size_t)l * 64 + e) * 256 * 1024 : P.in[I_SDN] + (size_t)l * 256 * 1024;
            cvt_direct(c, src, 1024, (bf16_t*)(ws + WS_WDN) + (size_t)e * 1024 * 256, 256, nt * 256, kt * 64, MapIdent()); }
    }
    __syncthreads();
}
__device__ __forceinline__ void phase_p0(const Ctx& c, const Params& P, int l, bool win, int wg0) {
    unsigned char* ws = P.ws;
    constexpr int J0 = 400, J1 = J0 + 32, J2 = J1 + 32, J3 = J2 + 64, J4 = J3 + 16, J5 = J4 + 16;
    if (win) for (int j = c.wg; j < J0; j += c.nwg) {
        { const int nt = j >> 2, kt = j & 3;
            cvt_tile4(c, P.in[I_WIN] + (size_t)l * 1024 * D_IN, D_IN, (bf16_t*)(ws + WS_WIN) + (size_t)1024 * 1024, 1024, nt * 64, kt * 256, MapWin()); }
    }
    if (win) for (int j = c.wg; j < 128; j += c.nwg) p0_wincomb_job(c, P, l, j >> 4, j & 15);
    __syncthreads();
    for (int g = (c.wg - wg0) < 0 ? 32 : (c.wg - wg0); g < 32; g += c.nwg) {
        LAS float* AP = (LAS float*)c.lds;
        LAS float* BB = AP + 33 * 128;
        LAS float* CC = BB + 64 * 32;
        LAS float* KT = CC + 16 * 128;
        const float dt = __expf(P.in[I_CLOGDT][l * 32 + g]);
        if (c.tid < 64) { const int p = c.tid;
            const float lr = P.in[I_CLRE][(l * 32 + g) * 64 + p], li = P.in[I_CLIM][(l * 32 + g) * 64 + p];
            const float mag = __expf(lr * dt); float sn, cs; sincos_rev(li * dt, sn, cs);
            const float are = mag * cs, aim = mag * sn, den = lr * lr + li * li;
            const float fre = ((are - 1.0f) * lr + aim * li) / den, fim = (aim * lr - (are - 1.0f) * li) / den;
            float pr = 1.f, pi = 0.f;
            for (int k = 0; k <= 32; ++k) { AP[(k * 64 + p) * 2] = pr; AP[(k * 64 + p) * 2 + 1] = pi; const float nr = pr * are - pi * aim, ni = pr * aim + pi * are; pr = nr; pi = ni; }
            ((float*)(ws + WS_S5A32))[(g * 64 + p) * 2] = AP[(32 * 64 + p) * 2]; ((float*)(ws + WS_S5A32))[(g * 64 + p) * 2 + 1] = AP[(32 * 64 + p) * 2 + 1];
            for (int j = 0; j < 16; ++j) { const float br = P.in[I_CBRE][((size_t)(l * 32 + g) * 64 + p) * 16 + j], bi = P.in[I_CBIM][((size_t)(l * 32 + g) * 64 + p) * 16 + j];
                BB[(p * 16 + j) * 2] = fre * br - fim * bi; BB[(p * 16 + j) * 2 + 1] = fre * bi + fim * br; }
        }
        for (int i = c.tid; i < 16 * 64; i += 512) { const int ii = i >> 6, p = i & 63;
            CC[i * 2] = P.in[I_CCRE][((size_t)(l * 32 + g) * 16 + ii) * 64 + p]; CC[i * 2 + 1] = P.in[I_CCIM][((size_t)(l * 32 + g) * 16 + ii) * 64 + p]; }
        __syncthreads();
        for (int o = c.tid; o < 32 * 256; o += 512) { const int tau = o >> 8, i = (o >> 4) & 15, j = o & 15; float s = 0.f;
            for (int p = 0; p < 64; ++p) { const float cr = CC[(i * 64 + p) * 2], ci = CC[(i * 64 + p) * 2 + 1], ar = AP[(tau * 64 + p) * 2], ai = AP[(tau * 64 + p) * 2 + 1];
                const float xr = cr * ar - ci * ai, xi = cr * ai + ci * ar; s += xr * BB[(p * 16 + j) * 2] - xi * BB[(p * 16 + j) * 2 + 1]; }
            if (tau == 0 && i == j) s += P.in[I_CD][(l * 32 + g) * 16 + i];
            KT[o] = s; }
        __syncthreads();
        bf16_t* TF = (bf16_t*)(ws + WS_S5TF) + (size_t)g * 512 * 640;
        for (int o = c.tid; o < 512 * 80; o += 512) { const int n = o / 80, k8 = (o % 80) * 8, tp = n >> 4, i = n & 15; float v[8];
            if (k8 < 512) { const int sp = k8 >> 4, j0 = k8 & 15;
#pragma unroll
                for (int q = 0; q < 8; ++q) v[q] = tp >= sp ? KT[(tp - sp) * 256 + i * 16 + j0 + q] : 0.f; }
            else { const int p0 = (k8 - 512) >> 1;
#pragma unroll
                for (int q = 0; q < 4; ++q) { const int p = p0 + q; const float cr = CC[(i * 64 + p) * 2], ci = CC[(i * 64 + p) * 2 + 1], ar = AP[((tp + 1) * 64 + p) * 2], ai = AP[((tp + 1) * 64 + p) * 2 + 1];
                    v[2 * q] = cr * ar - ci * ai; v[2 * q + 1] = -(cr * ai + ci * ar); } }
            u32x4 w; w.x = cvt_pk_bf16(v[0], v[1]); w.y = cvt_pk_bf16(v[2], v[3]); w.z = cvt_pk_bf16(v[4], v[5]); w.w = cvt_pk_bf16(v[6], v[7]);
            *(u32x4*)(TF + (size_t)n * 640 + k8) = w; }
        bf16_t* EE = (bf16_t*)(ws + WS_S5E) + (size_t)g * 256 * 512;
        for (int o = c.tid; o < 256 * 64; o += 512) { const int n = o >> 6, k8 = (o & 63) * 8; float v[8];
            if (n < 128) { const int p = n >> 1, cpx = n & 1, sp = k8 >> 4, j0 = k8 & 15; const float ar = AP[((31 - sp) * 64 + p) * 2], ai = AP[((31 - sp) * 64 + p) * 2 + 1];
#pragma unroll
                for (int q = 0; q < 8; ++q) { const float br = BB[(p * 16 + j0 + q) * 2], bi = BB[(p * 16 + j0 + q) * 2 + 1]; v[q] = cpx ? (ar * bi + ai * br) : (ar * br - ai * bi); } }
            else {
#pragma unroll
                for (int q = 0; q < 8; ++q) v[q] = 0.f; }
            u32x4 w; w.x = cvt_pk_bf16(v[0], v[1]); w.y = cvt_pk_bf16(v[2], v[3]); w.z = cvt_pk_bf16(v[4], v[5]); w.w = cvt_pk_bf16(v[6], v[7]);
            *(u32x4*)(EE + (size_t)n * 512 + k8) = w; }
        __syncthreads();
    }
}

struct SchedPlain {
    int nM, nN, nwg, G, c, K; const char* Bt;
    __device__ __forceinline__ void init(int M, int N, int K_, const void* Bt_, int G_, int c_) { nM = M / 256; nN = N / 256; nwg = nM * nN; G = G_; c = c_; K = K_; Bt = (const char*)Bt_; }
    __device__ __forceinline__ bool next(int i, Unit& u) const {
        const long L = (long)i * G + c; if (L >= nwg) return false;
        int wgid = (int)L; { const int q = nwg / 8, r = nwg % 8, xcd = wgid % 8, off = wgid / 8; wgid = (xcd < r ? xcd * (q + 1) : r * (q + 1) + (xcd - r) * q) + off; }
        const int nig = 8 * nN, gid = wgid / nig, fm = gid * 8, gsz = (nM - fm) < 8 ? (nM - fm) : 8;
        u.pm = fm + ((wgid % nig) % gsz); u.pn = (wgid % nig) / gsz; return true;
    }
    static constexpr bool GATHER = false;
    __device__ __forceinline__ int a_ld() const { return K; }
    __device__ __forceinline__ size_t a_tile_off(const Unit& u) const { return (size_t)u.pm * 256 * K * 2; }
    __device__ __forceinline__ unsigned a_row_off(const Unit& u, int r) const { return 0u; }
    __device__ __forceinline__ const char* b_ptr(const Unit& u) const { return Bt + (size_t)u.pn * 256 * K * 2; }
};
struct SchedGrouped {
    int nMg, nNg, ngr, nwg, G, c, K, lda; const char* Bt;
    __device__ __forceinline__ void init(int ngr_, int Mg, int Ng, int K_, const void* Bt_, int G_, int c_) { ngr = ngr_; nMg = Mg / 256; nNg = Ng / 256; nwg = ngr * nMg * nNg; G = G_; c = c_; K = K_; lda = K_; Bt = (const char*)Bt_; }
    __device__ __forceinline__ bool next(int i, Unit& u) const {
        const int L = i * G + c; if (L >= nwg) return false;
        const int per = nMg * nNg, g = L / per, r = L % per;
        u.pm = g * nMg + r / nNg; u.pn = g * nNg + r % nNg; return true;
    }
    static constexpr bool GATHER = false;
    __device__ __forceinline__ int a_ld() const { return lda; }
    __device__ __forceinline__ size_t a_tile_off(const Unit& u) const { return (size_t)u.pm * 256 * lda * 2; }
    __device__ __forceinline__ unsigned a_row_off(const Unit& u, int r) const { return 0u; }
    __device__ __forceinline__ const char* b_ptr(const Unit& u) const { return Bt + (size_t)u.pn * 256 * K * 2; }
};
#define EPI_LOOP_BEGIN \
    _Pragma("unroll") for (int ai = 0; ai < 2; ++ai) _Pragma("unroll") for (int m = 0; m < 4; ++m) { const int r = ai * 128 + wr * 64 + m * 16 + fr; \
    _Pragma("unroll") for (int bj = 0; bj < 2; ++bj) { const int c8 = bj * 128 + wc * 32 + fq * 8; const f32x4 v0 = acc[ai][bj][m][0], v1 = acc[ai][bj][m][1];
#define EPI_LOOP_END } asm volatile("" ::: "memory"); }
__device__ __forceinline__ u32x4 pack8(const f32x4 a, const f32x4 b) { u32x4 w; w.x = cvt_pk_bf16(a[0], a[1]); w.y = cvt_pk_bf16(a[2], a[3]); w.z = cvt_pk_bf16(b[0], b[1]); w.w = cvt_pk_bf16(b[2], b[3]); return w; }
__device__ __forceinline__ void unpack8(const u32x4 w, f32x4& a, f32x4& b) { a = (f32x4){bflo(w.x), bfhi(w.x), bflo(w.y), bfhi(w.y)}; b = (f32x4){bflo(w.z), bfhi(w.z), bflo(w.w), bfhi(w.w)}; }

struct EpiWin {
    static constexpr bool PERM = true;
    unsigned char* ws;
    __device__ __forceinline__ void operator()(const f32x4 (&acc)[2][2][4][2], const Unit& u, int wr, int wc, int fr, int fq) const {
        asm volatile("" : "+v"(fr), "+v"(fq));
        const int pn = u.pn; const int row0 = u.pm * 256;
        if (pn == 28) {
            float* M = (float*)(ws + WS_MISC);
            EPI_LOOP_BEGIN
                float* p = M + (size_t)(row0 + r) * 256 + c8; *(f32x4*)p = v0; *(f32x4*)(p + 4) = v1;
            EPI_LOOP_END
        } else if (pn == 14 || pn == 15) {
            bf16_t* C = (bf16_t*)(ws + WS_CUP);
            EPI_LOOP_BEGIN
                const int t = row0 + r, b = t >> 13, s = t & 8191, n = s >> 5, sp = s & 31, cc = (pn - 14) * 256 + c8, g = cc >> 4, j0 = cc & 15;
                *(u32x4*)(C + ((size_t)(g * 1024 + b * 256 + n) * 640) + sp * 16 + j0) = pack8(v0, v1);
            EPI_LOOP_END
        } else {
            bf16_t* base; int ld, ct;
            if (pn < 4) { base = (bf16_t*)(ws + WS_QT); ld = 1024; ct = pn; }
            else if (pn < 6) { base = (bf16_t*)(ws + WS_IDXQ); ld = 512; ct = pn - 4; }
            else if (pn < 12) { base = (bf16_t*)(ws + WS_BQKV); ld = 1536; ct = pn - 6; }
            else if (pn < 14) { base = (bf16_t*)(ws + WS_BZ); ld = 512; ct = pn - 12; }
            else { base = (bf16_t*)(ws + WS_GATES); ld = 3072; ct = pn - 16; }
            EPI_LOOP_BEGIN
                __builtin_nontemporal_store(pack8(v0, v1), (u32x4*)(base + (size_t)(row0 + r) * ld + ct * 256 + c8));
            EPI_LOOP_END
        }
    }
};
struct EpiBf16 {
    static constexpr bool PERM = true;
    bf16_t* O; int ld;
    __device__ __forceinline__ void operator()(const f32x4 (&acc)[2][2][4][2], const Unit& u, int wr, int wc, int fr, int fq) const {
        asm volatile("" : "+v"(fr), "+v"(fq));
        EPI_LOOP_BEGIN
            *(u32x4*)(O + (size_t)(u.pm * 256 + r) * ld + u.pn * 256 + c8) = pack8(v0, v1);
        EPI_LOOP_END
    }
};
struct EpiF32 {
    static constexpr bool PERM = true;
    float* O; int ld;
    __device__ __forceinline__ void operator()(const f32x4 (&acc)[2][2][4][2], const Unit& u, int wr, int wc, int fr, int fq) const {
        asm volatile("" : "+v"(fr), "+v"(fq));
        EPI_LOOP_BEGIN
            float* p = O + (size_t)(u.pm * 256 + r) * ld + u.pn * 256 + c8; *(f32x4*)p = v0; *(f32x4*)(p + 4) = v1;
        EPI_LOOP_END
    }
};
template <int MODE> struct EpiMerge {
    static constexpr bool PERM = true;
    float* Mf; bf16_t* Mb; const bf16_t* gates; int gcol0;
    __device__ __forceinline__ void operator()(const f32x4 (&acc)[2][2][4][2], const Unit& u, int wr, int wc, int fr, int fq) const {
        asm volatile("" : "+v"(fr), "+v"(fq));
        EPI_LOOP_BEGIN
            const size_t row = (size_t)(u.pm * 256 + r); const int col = u.pn * 256 + c8;
            const u32x4 gw = *(const u32x4*)(gates + row * 3072 + gcol0 + col); f32x4 g0, g1; unpack8(gw, g0, g1);
#pragma unroll
            for (int q = 0; q < 4; ++q) { g0[q] = sigmoidf_(g0[q]); g1[q] = sigmoidf_(g1[q]); }
            f32x4 a = v0 * g0, b = v1 * g1; bf16_t* p = Mb + row * 1024 + col;
            if (MODE != 0) { f32x4 m0, m1; unpack8(*(const u32x4*)p, m0, m1); a += m0; b += m1; }
            *(u32x4*)p = pack8(a, b);
        EPI_LOOP_END
    }
};
struct SchedMergeBC : SchedPlain {
    size_t offB, offC; const char* BtB; const char* BtC;
    __device__ __forceinline__ bool next(int i, Unit& u) const {
        Unit t; if (!SchedPlain::next(i >> 1, t)) return false;
        u.pm = t.pm; u.pn = (i & 1) * 4 + t.pn; return true;
    }
    __device__ __forceinline__ size_t a_tile_off(const Unit& u) const { return ((u.pn >> 2) ? offC : offB) + (size_t)u.pm * 256 * 512 * 2; }
    __device__ __forceinline__ const char* b_ptr(const Unit& u) const { return ((u.pn >> 2) ? BtC : BtB) + (size_t)(u.pn & 3) * 256 * 512 * 2; }
};
struct EpiMergeBC {
    static constexpr bool PERM = true;
    bf16_t* Mb; const bf16_t* gates;
    __device__ __forceinline__ void operator()(const f32x4 (&acc)[2][2][4][2], const Unit& u, int wr, int wc, int fr, int fq) const {
        asm volatile("" : "+v"(fr), "+v"(fq));
        const int gcol0 = 1024 + 1024 * (u.pn >> 2), pn = u.pn & 3;
        EPI_LOOP_BEGIN
            const size_t row = (size_t)(u.pm * 256 + r); const int col = pn * 256 + c8;
            const u32x4 gw = *(const u32x4*)(gates + row * 3072 + gcol0 + col); f32x4 g0, g1; unpack8(gw, g0, g1);
#pragma unroll
            for (int q = 0; q < 4; ++q) { g0[q] = sigmoidf_(g0[q]); g1[q] = sigmoidf_(g1[q]); }
            f32x4 a = v0 * g0, b = v1 * g1; bf16_t* p = Mb + row * 1024 + col;
            { f32x4 m0, m1; unpack8(*(const u32x4*)p, m0, m1); a += m0; b += m1; }
            *(u32x4*)p = pack8(a, b);
        EPI_LOOP_END
    }
};
struct EpiResid {
    static constexpr bool PERM = true;
    const bf16_t* XB; float* O;
    __device__ __forceinline__ void operator()(const f32x4 (&acc)[2][2][4][2], const Unit& u, int wr, int wc, int fr, int fq) const {
        asm volatile("" : "+v"(fr), "+v"(fq));
        EPI_LOOP_BEGIN
            const size_t o = (size_t)(u.pm * 256 + r) * 1024 + u.pn * 256 + c8;
            f32x4 x0, x1; unpack8(*(const u32x4*)(XB + o), x0, x1);
            *(f32x4*)(O + o) = x0 * DN_ALPHA + v0; *(f32x4*)(O + o + 4) = x1 * DN_ALPHA + v1;
        EPI_LOOP_END
    }
};
struct EpiGlu {
    static constexpr bool PERM = true;
    const bf16_t* Y; const float* bias; bf16_t* O;
    __device__ __forceinline__ void operator()(const f32x4 (&acc)[2][2][4][2], const Unit& u, int wr, int wc, int fr, int fq) const {
        asm volatile("" : "+v"(fr), "+v"(fq));
        EPI_LOOP_BEGIN
            const size_t o = (size_t)(u.pm * 256 + r) * 512 + u.pn * 256 + c8; const int col = u.pn * 256 + c8;
            f32x4 y0, y1; unpack8(*(const u32x4*)(Y + o), y0, y1);
            const f32x4 b0 = *(const f32x4*)(bias + col), b1 = *(const f32x4*)(bias + col + 4); f32x4 a, b;
#pragma unroll
            for (int q = 0; q < 4; ++q) { a[q] = y0[q] * sigmoidf_(v0[q] + b0[q]); b[q] = y1[q] * sigmoidf_(v1[q] + b1[q]); }
            *(u32x4*)(O + o) = pack8(a, b);
        EPI_LOOP_END
    }
};
__device__ __forceinline__ float gelu_f(float v) {
    const float av = fabsf(v), t = __builtin_amdgcn_rcpf(av * 0.2316418882f + 1.0f);
    float q = t * 0.5307027145f + (-0.7265760135f); q = q * t + 0.7107068705f; q = q * t + (-0.142248368f); q = q * t + 0.127414796f; q = q * t;
    const float e = __builtin_amdgcn_exp2f((v * v) * (-0.72134752044f));
    const float mm = v * (q * e); return v < 0.f ? mm : v - mm;
}
struct EpiS5 {
    static constexpr bool PERM = true;
    bf16_t* O;
    __device__ __forceinline__ void operator()(const f32x4 (&acc)[2][2][4][2], const Unit& u, int wr, int wc, int fr, int fq) const {
        asm volatile("" : "+v"(fr), "+v"(fq));
        const int g = u.pm >> 2, rb = (u.pm & 3) * 256, cb = (u.pn & 1) * 256;
        EPI_LOOP_BEGIN
            const int rr = rb + r, b = rr >> 8, n = rr & 255, cc = cb + c8, tp = cc >> 4, i0 = cc & 15; f32x4 a, bb;
#pragma unroll
            for (int q = 0; q < 4; ++q) { a[q] = gelu_f(v0[q]); bb[q] = gelu_f(v1[q]); }
            *(u32x4*)(O + (size_t)(b * 8192 + n * 32 + tp) * 512 + g * 16 + i0) = pack8(a, bb);
        EPI_LOOP_END
    }
};
struct EpiXloc {
    static constexpr bool PERM = true;
    float* O;
    __device__ __forceinline__ void operator()(const f32x4 (&acc)[2][2][4][2], const Unit& u, int wr, int wc, int fr, int fq) const {
        asm volatile("" : "+v"(fr), "+v"(fq));
        EPI_LOOP_BEGIN
            float* p = O + (size_t)(u.pm * 256 + r) * 256 + c8; *(f32x4*)p = v0; *(f32x4*)(p + 4) = v1;
        EPI_LOOP_END
    }
};
struct EpiGU {
    static constexpr bool PERM = true;
    bf16_t* HS;
    __device__ __forceinline__ void operator()(const f32x4 (&acc)[2][2][4][2], const Unit& u, int wr, int wc, int fr, int fq) const {
        asm volatile("" : "+v"(fr), "+v"(fq));
#pragma unroll
        for (int ai = 0; ai < 2; ++ai)
#pragma unroll
            for (int m = 0; m < 4; ++m) { const int r = ai * 128 + wr * 64 + m * 16 + fr; const int c8 = wc * 32 + fq * 8; f32x4 a, b;
                const f32x4 g0 = acc[ai][0][m][0], g1 = acc[ai][0][m][1], u0 = acc[ai][1][m][0], u1 = acc[ai][1][m][1];
#pragma unroll
                for (int q = 0; q < 4; ++q) { a[q] = siluf_(g0[q]) * u0[q]; b[q] = siluf_(g1[q]) * u1[q]; }
                __builtin_nontemporal_store(pack8(a, b), (u32x4*)(HS + (size_t)(u.pm * 256 + r) * 256 + (u.pn & 1) * 128 + c8)); }
    }
};
struct EpiDown {
    static constexpr bool PERM = true;
    bf16_t* YS;
    __device__ __forceinline__ void operator()(const f32x4 (&acc)[2][2][4][2], const Unit& u, int wr, int wc, int fr, int fq) const {
        asm volatile("" : "+v"(fr), "+v"(fq));
        EPI_LOOP_BEGIN
            __builtin_nontemporal_store(pack8(v0, v1), (u32x4*)(YS + (size_t)(u.pm * 256 + r) * 1024 + (u.pn & 3) * 256 + c8));
        EPI_LOOP_END
    }
};
struct SchedGU {
    const int* texp; const int* srow; int ntiles, G, c; const char* Bt;
    __device__ __forceinline__ bool next(int i, Unit& u) const {
        const int L = i * G + c, pm = ((L >> 4) << 3) | (L & 7); if (pm >= 128 + ntiles) return false;
        const int e = pm < 128 ? 64 : __builtin_amdgcn_readfirstlane(texp[pm - 128]);
        u.pm = pm; u.pn = e * 2 + ((L >> 3) & 1); return true;
    }
    static constexpr bool GATHER = true;
    __device__ __forceinline__ int a_ld() const { return 1024; }
    __device__ __forceinline__ size_t a_tile_off(const Unit& u) const { return 0; }
    __device__ __forceinline__ unsigned a_row_off(const Unit& u, int r) const {
        const int tok = u.pm < 128 ? u.pm * 256 + r : srow[(u.pm - 128) * 256 + r];
        return (unsigned)tok * 2048u;
    }
    __device__ __forceinline__ const char* b_ptr(const Unit& u) const { return Bt + (size_t)u.pn * 256 * 1024 * 2; }
};
struct SchedDown {
    const int* texp; int ntiles, G, c; const char* Bt;
    __device__ __forceinline__ bool next(int i, Unit& u) const {
        const int L = i * G + c, pm = ((L >> 5) << 3) | (L & 7); if (pm >= 128 + ntiles) return false;
        const int e = pm < 128 ? 64 : __builtin_amdgcn_readfirstlane(texp[pm - 128]);
        u.pm = pm; u.pn = e * 4 + ((L >> 3) & 3); return true;
    }
    static constexpr bool GATHER = false;
    __device__ __forceinline__ int a_ld() const { return 256; }
    __device__ __forceinline__ size_t a_tile_off(const Unit& u) const { return (size_t)u.pm * 256 * 512; }
    __device__ __forceinline__ unsigned a_row_off(const Unit& u, int r) const { return 0u; }
    __device__ __forceinline__ const char* b_ptr(const Unit& u) const { return Bt + (size_t)u.pn * 256 * 256 * 2; }
};

__device__ __forceinline__ void phase_load_x(const Ctx& c, const Params& P) {
    const float* x = P.in[I_X]; float* X = (float*)(P.ws + WS_X); bf16_t* XB = (bf16_t*)(P.ws + WS_XB);
    const size_t n8 = (size_t)NTOK * 1024 / 8;
    for (size_t i = (size_t)c.wg * 512 + c.tid; i < n8; i += (size_t)c.nwg * 512) {
        const f32x4 a = *(const f32x4*)(x + i * 8), b = *(const f32x4*)(x + i * 8 + 4);
        *(u32x4*)(XB + i * 8) = pack8(a, b);
    }
}
__device__ __forceinline__ void phase_ln(const Ctx& c, const float* in, const float* g, const float* bta, float* outF, bf16_t* outB) {
    const int gw = c.wg * 8 + c.wave, nw = c.nwg * 8;
    f32x4 gg[4], bb[4];
#pragma unroll
    for (int q = 0; q < 4; ++q) { gg[q] = *(const f32x4*)(g + q * 256 + c.lane * 4); bb[q] = *(const f32x4*)(bta + q * 256 + c.lane * 4); }
    for (int row = gw; row < NTOK; row += nw) {
        const float* p = in + (size_t)row * 1024; f32x4 v[4]; float s = 0.f;
#pragma unroll
        for (int q = 0; q < 4; ++q) { v[q] = *(const f32x4*)(p + q * 256 + c.lane * 4); s += (v[q][0] + v[q][1]) + (v[q][2] + v[q][3]); }
        const float mu = wave_sum(s) * (1.0f / 1024.0f); float qq = 0.f;
#pragma unroll
        for (int q = 0; q < 4; ++q) { const f32x4 d = v[q] - mu; qq += (d[0] * d[0] + d[1] * d[1]) + (d[2] * d[2] + d[3] * d[3]); }
        const float rs = rsqrtf(wave_sum(qq) * (1.0f / 1024.0f) + LN_EPS);
#pragma unroll
        for (int q = 0; q < 4; ++q) { const f32x4 o = (v[q] - mu) * rs * gg[q] + bb[q];
            if (outF) *(f32x4*)(outF + (size_t)row * 1024 + q * 256 + c.lane * 4) = o;
            u32x2 w; w.x = cvt_pk_bf16(o[0], o[1]); w.y = cvt_pk_bf16(o[2], o[3]); *(u32x2*)(outB + (size_t)row * 1024 + q * 256 + c.lane * 4) = w; }
    }
}
__device__ __forceinline__ void phase_kvnorm(const Ctx& c, const Params& P, int l) {
    const float* M = (const float*)(P.ws + WS_MISC); bf16_t* CKV = (bf16_t*)(P.ws + WS_CKV); bf16_t* IK = (bf16_t*)(P.ws + WS_IDXK);
    const float* g = P.in[I_KVN] + l * 128; const float g0 = g[c.lane * 2], g1 = g[c.lane * 2 + 1];
    const int gw = c.wg * 8 + c.wave, nw = c.nwg * 8;
    for (int t = gw; t < NTOK; t += nw) {
        const f32x2 v = *(const f32x2*)(M + (size_t)t * 256 + c.lane * 2);
        const float ms = wave_sum(v[0] * v[0] + v[1] * v[1]) * (1.0f / 128.0f); const float rs = rsqrtf(ms + RMS_EPS);
        *(unsigned*)(CKV + (size_t)t * 128 + c.lane * 2) = cvt_pk_bf16(v[0] * rs * g0, v[1] * rs * g1);
        const float k = M[(size_t)t * 256 + 128 + c.lane]; IK[(size_t)t * 64 + c.lane] = f2bf(k);
    }
}
__device__ __forceinline__ void phase_s5_carry(const Ctx& c, const Params& P, int wg0, int nwgs) {
    if (c.wg < wg0 || c.wg >= wg0 + nwgs) return;
    LAS float* SE = (LAS float*)c.lds;
    const float* XL = (const float*)(P.ws + WS_XLOC); bf16_t* CUP = (bf16_t*)(P.ws + WS_CUP); const float* A32 = (const float*)(P.ws + WS_S5A32);
    for (int task = c.wg - wg0; task < 128; task += nwgs) {
        const int b = task >> 5, g = task & 31, p = c.tid & 63, seg = c.tid >> 6;
        const float ar = A32[(g * 64 + p) * 2], ai = A32[(g * 64 + p) * 2 + 1];
        const size_t rowb = (size_t)g * 1024 + b * 256 + seg * 32;
        float Lr[32], Li[32]; float sr = 0.f, si = 0.f;
#pragma unroll
        for (int i = 0; i < 32; ++i) { Lr[i] = sr; Li[i] = si; const f32x2 x = *(const f32x2*)(XL + (rowb + i) * 256 + p * 2);
            const float nr = ar * sr - ai * si + x[0], ni = ar * si + ai * sr + x[1]; sr = nr; si = ni; }
        SE[(seg * 64 + p) * 2] = sr; SE[(seg * 64 + p) * 2 + 1] = si;
        float br = ar, bi = ai;
#pragma unroll
        for (int q = 0; q < 5; ++q) { const float nr = br * br - bi * bi, ni = 2.f * br * bi; br = nr; bi = ni; }
        __syncthreads();
        float xr = 0.f, xi = 0.f;
        for (int s = 0; s < seg; ++s) { const float er = SE[(s * 64 + p) * 2], ei = SE[(s * 64 + p) * 2 + 1]; const float nr = br * xr - bi * xi + er, ni = br * xi + bi * xr + ei; xr = nr; xi = ni; }
        float pr = 1.f, pi = 0.f;
#pragma unroll
        for (int i = 0; i < 32; ++i) { const float vr = pr * xr - pi * xi + Lr[i], vi = pr * xi + pi * xr + Li[i];
            *(unsigned*)(CUP + (rowb + i) * 640 + 512 + p * 2) = cvt_pk_bf16(vr, vi);
            const float nr = pr * ar - pi * ai, ni = pr * ai + pi * ar; pr = nr; pi = ni; }
        __syncthreads();
    }
}

__device__ __forceinline__ bf16x8 ldfragL(const LAS bf16_t* base, int stride, int row, int k0) { return *(const LAS bf16x8*)(base + row * stride + k0); }
__device__ __forceinline__ bf16x8 ldfragG(const bf16_t* base, int stride, int row, int k0) { return *(const bf16x8*)(base + (size_t)row * stride + k0); }
__device__ __forceinline__ f32x4 mfma16(bf16x8 a, bf16x8 b, f32x4 c) { return __builtin_amdgcn_mfma_f32_16x16x32_bf16(a, b, c, 0, 0, 0); }

#ifndef DBG_TID
#define DBG_TID 0
#endif
constexpr int DN_QS = 136, DN_TS = 72, DN_MS = 68;
constexpr int DL_QN = 0;
constexpr int DL_KN = DL_QN + 64 * DN_QS * 2;
constexpr int DL_KTBG = DL_KN + 128 * DN_TS * 2;
constexpr int DL_KTDEC = DL_KTBG + 128 * DN_TS * 2;
constexpr int DL_VTB = DL_KTDEC + 128 * DN_TS * 2;
constexpr int DL_MF = DL_VTB + 128 * DN_TS * 2;
constexpr int DL_QK = DL_MF + 128 * DN_TS * 2;
constexpr int DL_TB = DL_QK + 64 * DN_TS * 2;
constexpr int DL_SC = DL_TB + 64 * DN_TS * 2;
constexpr int DL_END = DL_SC + 5 * 64 * 4;
static_assert(64 * DN_MS * 4 <= 128 * DN_TS * 2 && 64 * DN_QS * 2 <= 128 * DN_TS * 2 && DL_END <= LDS_BYTES, "deltanet LDS map");

__device__ __forceinline__ void phase_dn_prep(const Ctx& c, const Params& P, int l) {
    LAS bf16_t* QN = (LAS bf16_t*)(c.lds + DL_QN); LAS bf16_t* KN = (LAS bf16_t*)(c.lds + DL_KN); LAS bf16_t* WT = KN;
    LAS bf16_t* KTBG = (LAS bf16_t*)(c.lds + DL_KTBG); LAS bf16_t* KTDEC = (LAS bf16_t*)(c.lds + DL_KTDEC); LAS bf16_t* VTB = (LAS bf16_t*)(c.lds + DL_VTB);
    LAS float* MF = (LAS float*)(c.lds + DL_MF); LAS bf16_t* UT = (LAS bf16_t*)(c.lds + DL_MF);
    LAS bf16_t* QK = (LAS bf16_t*)(c.lds + DL_QK); LAS bf16_t* TB = (LAS bf16_t*)(c.lds + DL_TB);
    LAS float* GC = (LAS float*)(c.lds + DL_SC); LAS float* BETA = GC + 64; LAS float* EGC = GC + 128; LAS float* EDEC = GC + 192; LAS float* GLAST = GC + 256;
    const bf16_t* BQKV = (const bf16_t*)(P.ws + WS_BQKV); const float* MISC = (const float*)(P.ws + WS_MISC);
    const float* conv = P.in[I_BCONV] + (size_t)l * 4 * 1536;
    const int lane = c.lane, w = c.wave, fr = lane & 15, fq = lane >> 4;
    for (int unit = c.wg; unit < 2048; unit += c.nwg) {
        const int b = unit >> 9, h = (unit >> 7) & 3, n = unit & 127;
        const size_t tok0 = (size_t)b * 8192 + n * 64;
        if (w == 0) {
            const float a = MISC[(tok0 + lane) * 256 + 200 + h], bb = MISC[(tok0 + lane) * 256 + 204 + h];
            const float xx = a + P.in[I_BDTB][l * 4 + h];
            const float sp = fmaxf(xx, 0.f) + log1pf(__expf(-fabsf(xx)));
            const float g = -__expf(P.in[I_BALOG][l * 4 + h]) * sp;
            float cs = g;
#pragma unroll
            for (int o = 1; o < 64; o <<= 1) { const float t = shf(cs, lane - o); if (lane >= o) cs += t; }
            const float last = shf(cs, 63);
            GC[lane] = cs; BETA[lane] = sigmoidf_(bb); EGC[lane] = __expf(cs); EDEC[lane] = __expf(last - cs); if (lane == 0) GLAST[0] = __expf(last);
        }
        __syncthreads();
        {
            float cw[3][4][2], hx[3][3][2];
#pragma unroll
            for (int s = 0; s < 3; ++s) { const int col = s * 512 + h * 128 + 2 * lane;
#pragma unroll
                for (int j = 0; j < 4; ++j) { cw[s][j][0] = conv[j * 1536 + col]; cw[s][j][1] = conv[j * 1536 + col + 1]; }
#pragma unroll
                for (int d = 0; d < 3; ++d) { const int pos = n * 64 + 8 * w - 3 + d; unsigned v = 0u;
                    if (pos >= 0) v = *(const unsigned*)(BQKV + ((size_t)b * 8192 + pos) * 1536 + col);
                    hx[s][d][0] = bflo(v); hx[s][d][1] = bfhi(v); } }
#pragma unroll
            for (int i = 0; i < 8; ++i) { const int t = 8 * w + i; float y[3][2];
#pragma unroll
                for (int s = 0; s < 3; ++s) { const int col = s * 512 + h * 128 + 2 * lane; const unsigned v = *(const unsigned*)(BQKV + (tok0 + t) * 1536 + col); const float c0 = bflo(v), c1 = bfhi(v);
                    const float z0 = cw[s][0][0] * hx[s][0][0] + cw[s][1][0] * hx[s][1][0] + cw[s][2][0] * hx[s][2][0] + cw[s][3][0] * c0;
                    const float z1 = cw[s][0][1] * hx[s][0][1] + cw[s][1][1] * hx[s][1][1] + cw[s][2][1] * hx[s][2][1] + cw[s][3][1] * c1;
                    y[s][0] = siluf_(z0); y[s][1] = siluf_(z1);
                    hx[s][0][0] = hx[s][1][0]; hx[s][0][1] = hx[s][1][1]; hx[s][1][0] = hx[s][2][0]; hx[s][1][1] = hx[s][2][1]; hx[s][2][0] = c0; hx[s][2][1] = c1; }
                const float rq = rsqrtf(wave_sum(y[0][0] * y[0][0] + y[0][1] * y[0][1]) + RMS_EPS) * 0.08838834764831845f;
                const float rk = rsqrtf(wave_sum(y[1][0] * y[1][0] + y[1][1] * y[1][1]) + RMS_EPS);
                const float q0 = y[0][0] * rq, q1 = y[0][1] * rq, k0 = y[1][0] * rk, k1 = y[1][1] * rk;
                const float bt = BETA[t], eg = EGC[t], ed = EDEC[t];
                *(LAS unsigned*)(QN + t * DN_QS + 2 * lane) = cvt_pk_bf16(q0, q1);
                *(LAS unsigned*)(KN + t * DN_QS + 2 * lane) = cvt_pk_bf16(k0, k1);
                KTBG[(2 * lane) * DN_TS + t] = f2bf(k0 * bt * eg); KTBG[(2 * lane + 1) * DN_TS + t] = f2bf(k1 * bt * eg);
                KTDEC[(2 * lane) * DN_TS + t] = f2bf(k0 * ed); KTDEC[(2 * lane + 1) * DN_TS + t] = f2bf(k1 * ed);
                VTB[(2 * lane) * DN_TS + t] = f2bf(y[2][0] * bt); VTB[(2 * lane + 1) * DN_TS + t] = f2bf(y[2][1] * bt);
            }
        }
        __syncthreads();
        {
            const int rt = w & 3; const bool isqk = w >= 4; const LAS bf16_t* Asrc = isqk ? QN : KN;
            bf16x8 af[4];
#pragma unroll
            for (int ks = 0; ks < 4; ++ks) af[ks] = ldfragL(Asrc, DN_QS, rt * 16 + fr, ks * 32 + fq * 8);
            for (int ct = 0; ct < 4; ++ct) {
                f32x4 acc = (f32x4){0.f, 0.f, 0.f, 0.f};
                if (ct <= rt) {
#pragma unroll
                    for (int ks = 0; ks < 4; ++ks) acc = mfma16(af[ks], ldfragL(KN, DN_QS, ct * 16 + fr, ks * 32 + fq * 8), acc);
                }
                const int j = ct * 16 + fr; const float gj = GC[j];
#pragma unroll
                for (int r = 0; r < 4; ++r) { const int i = rt * 16 + 4 * fq + r; const float dec = __expf(fminf(GC[i] - gj, 0.f));
                    if (isqk) QK[i * DN_TS + j] = f2bf(i >= j ? acc[r] * dec : 0.f);
                    else MF[i * DN_MS + j] = (i > j) ? BETA[i] * acc[r] * dec : 0.f; }
            }
        }
        __syncthreads();
        {
            LAS float* TF = (LAS float*)KN;
            LAS float* SW = (LAS float*)(c.lds + DL_END + 64) + w * 272;
            if (w < 4) {
                const int I = w; float t[16];
#pragma unroll
                for (int i = 0; i < 16; ++i) { float sacc = (i == fr) ? 1.f : 0.f;
#pragma unroll
                    for (int j = 0; j < i; ++j) sacc -= MF[(16 * I + i) * DN_MS + 16 * I + j] * t[j];
                    t[i] = sacc; }
                if (fq == 0) {
#pragma unroll
                    for (int i = 0; i < 16; ++i) { TF[(16 * I + i) * DN_MS + 16 * I + fr] = t[i]; TB[(16 * I + i) * DN_TS + 16 * I + fr] = f2bf(t[i]); } }
            } else {
                for (int e = (w - 4) * 64 + lane; e < 4096; e += 256) { const int i = e >> 6, j = e & 63; if ((j >> 4) > (i >> 4)) TB[i * DN_TS + j] = 0; }
            }
            __syncthreads();
#pragma unroll
            for (int d = 1; d < 4; ++d) {
                if (w < 4 - d) {
                    const int J = w, I = w + d; f32x4 acc = (f32x4){0.f, 0.f, 0.f, 0.f};
                    for (int K = J; K < I; ++K)
#pragma unroll
                        for (int ks = 0; ks < 4; ++ks) acc = __builtin_amdgcn_mfma_f32_16x16x4f32(MF[(16 * I + fr) * DN_MS + 16 * K + 4 * ks + fq], TF[(16 * K + 4 * ks + fq) * DN_MS + 16 * J + fr], acc, 0, 0, 0);
#pragma unroll
                    for (int r = 0; r < 4; ++r) SW[(4 * fq + r) * 17 + fr] = acc[r];
                    asm volatile("s_waitcnt lgkmcnt(0)" ::: "memory");
                    f32x4 acc2 = (f32x4){0.f, 0.f, 0.f, 0.f};
#pragma unroll
                    for (int ks = 0; ks < 4; ++ks) acc2 = __builtin_amdgcn_mfma_f32_16x16x4f32(TF[(16 * I + fr) * DN_MS + 16 * I + 4 * ks + fq], SW[(4 * ks + fq) * 17 + fr], acc2, 0, 0, 0);
#pragma unroll
                    for (int r = 0; r < 4; ++r) { TF[(16 * I + 4 * fq + r) * DN_MS + 16 * J + fr] = -acc2[r]; TB[(16 * I + 4 * fq + r) * DN_TS + 16 * J + fr] = f2bf(-acc2[r]); }
                }
                __syncthreads();
            }
        }
#if DBG_TID
        {
            LAS int* FL = (LAS int*)(c.lds + DL_END);
            if (c.tid == 0) FL[0] = 0;
            __syncthreads();
            int f = 0;
            auto bad16 = [](bf16_t v) { return (v & 0x7f80) == 0x7f80; };
            auto bad32 = [](float v) { return (__float_as_uint(v) & 0x7f800000u) == 0x7f800000u; };
            for (int i = c.tid; i < 64; i += 512) { if (bad32(GC[i]) || bad32(EGC[i]) || bad32(EDEC[i]) || bad32(BETA[i])) f |= 1; }
            for (int i = c.tid; i < 64 * 128; i += 512) { const int r = i >> 7, cc = i & 127; if (bad16(QN[r * DN_QS + cc])) f |= 2; }
            for (int i = c.tid; i < 128 * 64; i += 512) { const int r = i >> 6, cc = i & 63; if (bad16(KTBG[r * DN_TS + cc])) f |= 4; if (bad16(KTDEC[r * DN_TS + cc])) f |= 8; if (bad16(VTB[r * DN_TS + cc])) f |= 16; }
            for (int i = c.tid; i < 64 * 64; i += 512) { const int r = i >> 6, cc = i & 63; if (bad32(MF[r * DN_MS + cc])) f |= 32; if (bad16(QK[r * DN_TS + cc])) f |= 64; if (bad16(TB[r * DN_TS + cc])) f |= 128; }
            if (f) __hip_atomic_fetch_or(&FL[0], f, __ATOMIC_RELAXED, __HIP_MEMORY_SCOPE_WORKGROUP);
            __syncthreads();
        }
#endif
        {
#pragma unroll
            for (int q = 0; q < 8; ++q) { const int tile = w * 8 + q, which = tile >> 5, it = (tile >> 3) & 3, dt = tile & 7;
                const LAS bf16_t* Bsrc = which ? VTB : KTBG; f32x4 acc = (f32x4){0.f, 0.f, 0.f, 0.f};
#pragma unroll
                for (int ks = 0; ks < 2; ++ks) acc = mfma16(ldfragL(TB, DN_TS, it * 16 + fr, ks * 32 + fq * 8), ldfragL(Bsrc, DN_TS, dt * 16 + fr, ks * 32 + fq * 8), acc);
                LAS bf16_t* dst = (which ? UT : WT) + (dt * 16 + fr) * DN_TS + it * 16 + 4 * fq;
                u32x2 pk; pk.x = cvt_pk_bf16(acc[0], acc[1]); pk.y = cvt_pk_bf16(acc[2], acc[3]); *(LAS u32x2*)dst = pk; }
        }
        __syncthreads();
        {
            bf16_t* DNA = (bf16_t*)(P.ws + WS_DNA) + (size_t)unit * 128 * 128; float* DNB = (float*)(P.ws + WS_DNB) + (size_t)unit * 128 * 128;
            bf16_t* DNQ = (bf16_t*)(P.ws + WS_DNQ) + (size_t)unit * 64 * 128; float* DNO = (float*)(P.ws + WS_DNO) + (size_t)unit * 64 * 128;
            const float glast = GLAST[0];
            for (int q = 0; q < 24; ++q) { const int tile = w * 24 + q; f32x4 acc = (f32x4){0.f, 0.f, 0.f, 0.f};
                if (tile < 64) {
                    const int mt = tile >> 3, nt = tile & 7;
#pragma unroll
                    for (int ks = 0; ks < 2; ++ks) acc = mfma16(ldfragL(WT, DN_TS, mt * 16 + fr, ks * 32 + fq * 8), ldfragL(KTDEC, DN_TS, nt * 16 + fr, ks * 32 + fq * 8), acc);
                    const int d1 = nt * 16 + fr, d2 = mt * 16 + 4 * fq; float v[4];
#pragma unroll
                    for (int r = 0; r < 4; ++r) v[r] = ((d1 == d2 + r) ? glast : 0.f) - acc[r];
#if DBG_TID
                    { const float fl = (float)((LAS int*)(c.lds + DL_END))[0]; v[0] = fl; v[1] = fl; v[2] = fl; v[3] = fl; }
#endif
                    u32x2 pk; pk.x = cvt_pk_bf16(v[0], v[1]); pk.y = cvt_pk_bf16(v[2], v[3]); *(u32x2*)(DNA + (size_t)d1 * 128 + d2) = pk;
                } else if (tile < 128) {
                    const int tt = tile - 64, mt = tt >> 3, nt = tt & 7;
#pragma unroll
                    for (int ks = 0; ks < 2; ++ks) acc = mfma16(ldfragL(KTDEC, DN_TS, mt * 16 + fr, ks * 32 + fq * 8), ldfragL(UT, DN_TS, nt * 16 + fr, ks * 32 + fq * 8), acc);
                    *(f32x4*)(DNB + (size_t)(tt * 64 + lane) * 4) = acc;
                } else if (tile < 160) {
                    const int tt = tile - 128, mt = tt >> 2, nt = tt & 3;
#pragma unroll
                    for (int ks = 0; ks < 2; ++ks) acc = mfma16(ldfragL(WT, DN_TS, mt * 16 + fr, ks * 32 + fq * 8), ldfragL(QK, DN_TS, nt * 16 + fr, ks * 32 + fq * 8), acc);
                    const int i = nt * 16 + fr, d = mt * 16 + 4 * fq; const float eg = EGC[i];
                    const u32x2 qw = *(const LAS u32x2*)(QN + i * DN_QS + d);
                    u32x2 pk; pk.x = cvt_pk_bf16(bflo(qw.x) * eg - acc[0], bfhi(qw.x) * eg - acc[1]); pk.y = cvt_pk_bf16(bflo(qw.y) * eg - acc[2], bfhi(qw.y) * eg - acc[3]);
                    *(u32x2*)(DNQ + (size_t)i * 128 + d) = pk;
                } else {
                    const int tt = tile - 160, mt = tt >> 2, nt = tt & 3;
#pragma unroll
                    for (int ks = 0; ks < 2; ++ks) acc = mfma16(ldfragL(UT, DN_TS, mt * 16 + fr, ks * 32 + fq * 8), ldfragL(QK, DN_TS, nt * 16 + fr, ks * 32 + fq * 8), acc);
                    *(f32x4*)(DNO + (size_t)(tt * 64 + lane) * 4) = acc;
                }
            }
        }
        __syncthreads();
    }
}

__device__ __forceinline__ void phase_dn_scan(const Ctx& c, const Params& P, int nwgs) {
    if (c.wg >= nwgs) return;
    LAS bf16_t* ST = (LAS bf16_t*)c.lds;
    const int lane = c.lane, w = c.wave, fr = lane & 15, fq = lane >> 4;
    for (int task = c.wg; task < 64; task += nwgs) {
        const int bh = task >> 2, sl = task & 3;
        for (int i = c.tid; i < 2 * 32 * DN_QS / 2; i += 512) ((LAS unsigned*)ST)[i] = 0u;
        __syncthreads();
        const bf16_t* DNA = (const bf16_t*)(P.ws + WS_DNA) + (size_t)bh * 128 * 128 * 128; const float* DNB = (const float*)(P.ws + WS_DNB) + (size_t)bh * 128 * 128 * 128;
        bf16_t* DNS = (bf16_t*)(P.ws + WS_DNS) + (size_t)bh * 128 * 128 * 128;
        { const int dvl = fr + 16 * (w & 1), d1 = 32 * (w >> 1) + fq * 8;
          *(u32x4*)(DNS + (size_t)(sl * 32 + dvl) * 128 + d1) = (u32x4){0u, 0u, 0u, 0u}; }
        constexpr int PF = 4;
        bf16x8 af[PF][4]; f32x4 bi[PF][2];
#pragma unroll
        for (int p = 0; p < PF; ++p) {
#pragma unroll
            for (int ks = 0; ks < 4; ++ks) af[p][ks] = ldfragG(DNA + (size_t)p * 128 * 128, 128, w * 16 + fr, ks * 32 + fq * 8);
#pragma unroll
            for (int nt = 0; nt < 2; ++nt) bi[p][nt] = *(const f32x4*)(DNB + (size_t)p * 128 * 128 + (size_t)((w * 8 + sl * 2 + nt) * 64 + lane) * 4);
        }
#pragma unroll
        for (int n = 0; n < 127; ++n) {
            const int p = n % PF;
            const LAS bf16_t* cur = ST + (n & 1) * 32 * DN_QS; LAS bf16_t* nxt = ST + ((n + 1) & 1) * 32 * DN_QS;
            f32x4 acc[2] = {bi[p][0], bi[p][1]};
            bf16x8 a2[4];
#pragma unroll
            for (int ks = 0; ks < 4; ++ks) a2[ks] = af[p][ks];
            if (n + PF < 127) {
                const bf16_t* An = DNA + (size_t)(n + PF) * 128 * 128; const float* Bn = DNB + (size_t)(n + PF) * 128 * 128;
#pragma unroll
                for (int ks = 0; ks < 4; ++ks) af[p][ks] = ldfragG(An, 128, w * 16 + fr, ks * 32 + fq * 8);
#pragma unroll
                for (int nt = 0; nt < 2; ++nt) bi[p][nt] = *(const f32x4*)(Bn + (size_t)((w * 8 + sl * 2 + nt) * 64 + lane) * 4);
            }
            __builtin_amdgcn_sched_barrier(0);
#pragma unroll
            for (int nt = 0; nt < 2; ++nt)
#pragma unroll
                for (int ks = 0; ks < 4; ++ks) acc[nt] = mfma16(a2[ks], ldfragL(cur, DN_QS, nt * 16 + fr, ks * 32 + fq * 8), acc[nt]);
            bf16_t* Sg = DNS + (size_t)(n + 1) * 128 * 128;
#pragma unroll
            for (int nt = 0; nt < 2; ++nt) { u32x2 pk; pk.x = cvt_pk_bf16(acc[nt][0], acc[nt][1]); pk.y = cvt_pk_bf16(acc[nt][2], acc[nt][3]);
                *(LAS u32x2*)(nxt + (nt * 16 + fr) * DN_QS + w * 16 + 4 * fq) = pk;
                *(u32x2*)(Sg + (size_t)(sl * 32 + nt * 16 + fr) * 128 + w * 16 + 4 * fq) = pk; }
            asm volatile("s_waitcnt lgkmcnt(0)" ::: "memory"); __builtin_amdgcn_s_barrier(); asm volatile("" ::: "memory");
        }
        __syncthreads();
    }
}

__device__ __forceinline__ void phase_dn_out(const Ctx& c, const Params& P, int l) {
    const int lane = c.lane, fr = lane & 15, fq = lane >> 4;
    const bf16_t* BZ = (const bf16_t*)(P.ws + WS_BZ); bf16_t* YB = (bf16_t*)(P.ws + WS_YB); const float* gn = P.in[I_BONORM] + l * 128;
    for (int task = c.wg * 8 + c.wave; task < 2048 * 4; task += c.nwg * 8) {
        const int unit = task >> 2, it = task & 3, b = unit >> 9, h = (unit >> 7) & 3, n = unit & 127;
        const bf16_t* S = (const bf16_t*)(P.ws + WS_DNS) + (size_t)unit * 128 * 128; const bf16_t* Q = (const bf16_t*)(P.ws + WS_DNQ) + (size_t)unit * 64 * 128;
        const float* O = (const float*)(P.ws + WS_DNO) + (size_t)unit * 64 * 128;
        bf16x8 bq[4];
#pragma unroll
        for (int ks = 0; ks < 4; ++ks) bq[ks] = ldfragG(Q, 128, it * 16 + fr, ks * 32 + fq * 8);
        f32x4 acc[8]; float ss = 0.f;
#pragma unroll
        for (int mt = 0; mt < 8; ++mt) { acc[mt] = *(const f32x4*)(O + (size_t)((mt * 4 + it) * 64 + lane) * 4);
#pragma unroll
            for (int ks = 0; ks < 4; ++ks) acc[mt] = mfma16(ldfragG(S, 128, mt * 16 + fr, ks * 32 + fq * 8), bq[ks], acc[mt]);
            ss += (acc[mt][0] * acc[mt][0] + acc[mt][1] * acc[mt][1]) + (acc[mt][2] * acc[mt][2] + acc[mt][3] * acc[mt][3]); }
        ss += shf(ss, lane ^ 16); ss += shf(ss, lane ^ 32);
        const float rs = rsqrtf(ss * (1.0f / 128.0f) + RMS_EPS);
        const size_t tok = (size_t)b * 8192 + n * 64 + it * 16 + fr;
#pragma unroll
        for (int mt = 0; mt < 8; ++mt) { const int dv = mt * 16 + 4 * fq; const u32x2 zw = *(const u32x2*)(BZ + tok * 512 + h * 128 + dv); const f32x4 g4 = *(const f32x4*)(gn + dv);
            u32x2 pk; pk.x = cvt_pk_bf16(acc[mt][0] * rs * g4[0] * siluf_(bflo(zw.x)), acc[mt][1] * rs * g4[1] * siluf_(bfhi(zw.x)));
            pk.y = cvt_pk_bf16(acc[mt][2] * rs * g4[2] * siluf_(bflo(zw.y)), acc[mt][3] * rs * g4[3] * siluf_(bfhi(zw.y)));
            *(u32x2*)(YB + tok * 512 + h * 128 + dv) = pk; }
    }
}

__device__ __forceinline__ f32x16 mfma32(bf16x8 a, bf16x8 b, f32x16 c) { return __builtin_amdgcn_mfma_f32_32x32x16_bf16(a, b, c, 0, 0, 0); }

constexpr int IX_KS = 72;
__device__ __forceinline__ void phase_idx_scores(const Ctx& c, const Params& P, int b, size_t sc_off = WS_SCORES) {
    LAS bf16_t* KL = (LAS bf16_t*)c.lds;
    const bf16_t* IQ = (const bf16_t*)(P.ws + WS_IDXQ) + (size_t)b * 8192 * 512; const bf16_t* IK = (const bf16_t*)(P.ws + WS_IDXK) + (size_t)b * 8192 * 64;
    const float* MISC = (const float*)(P.ws + WS_MISC) + (size_t)b * 8192 * 256; float* SC = (float*)(P.ws + sc_off);
    const int lane = c.lane, w = c.wave, l31 = lane & 31, lh = lane >> 5;
    constexpr int NBLK = 64 * 65 / 2;
    const int blk0 = (int)((long)c.wg * NBLK / c.nwg), blk1 = (int)((long)(c.wg + 1) * NBLK / c.nwg);
    int qt = 0; while ((qt + 1) * (qt + 2) / 2 <= blk0) ++qt;
    int kb = blk0 - qt * (qt + 1) / 2;
    for (int blk = blk0; blk < blk1; ++blk) {
        LAS bf16_t* kl = KL + (blk & 1) * 128 * IX_KS;
        { const int key = c.tid >> 2, pc = c.tid & 3; const bf16_t* src = IK + (size_t)(kb * 128 + key) * 64 + pc * 16;
          const u32x4 a = *(const u32x4*)src, bq = *(const u32x4*)(src + 8);
          *(LAS u32x4*)(kl + key * IX_KS + pc * 16) = a; *(LAS u32x4*)(kl + key * IX_KS + pc * 16 + 8) = bq; }
        __syncthreads();
        for (int hp = 0; hp < 2; ++hp) {
            const int qlo = qt * 128 + w * 16 + hp * 8;
            bf16x8 af[2][4]; float wq[2][2][8];
#pragma unroll
            for (int at = 0; at < 2; ++at) { const int qq = ((l31 >> 2) & 1) + 2 * (l31 >> 4), hd = (l31 & 3) + 4 * ((l31 >> 3) & 1);
#pragma unroll
                for (int ks = 0; ks < 4; ++ks) af[at][ks] = *(const bf16x8*)(IQ + (size_t)(qlo + 4 * at + qq) * 512 + hd * 64 + ks * 16 + lh * 8);
#pragma unroll
                for (int sub = 0; sub < 2; ++sub) { const float* wp = MISC + (size_t)(qlo + 4 * at + lh + 2 * sub) * 256 + 192; const f32x4 w0 = *(const f32x4*)wp, w1 = *(const f32x4*)(wp + 4);
                    wq[at][sub][0] = w0[0]; wq[at][sub][1] = w0[1]; wq[at][sub][2] = w0[2]; wq[at][sub][3] = w0[3]; wq[at][sub][4] = w1[0]; wq[at][sub][5] = w1[1]; wq[at][sub][6] = w1[2]; wq[at][sub][7] = w1[3]; } }
            for (int kt = 0; kt < 4; ++kt) {
                const int key0 = kb * 128 + kt * 32;
                if (key0 > qlo + 7) break;
                bf16x8 bf[4];
#pragma unroll
                for (int ks = 0; ks < 4; ++ks) bf[ks] = *(const LAS bf16x8*)(kl + (kt * 32 + l31) * IX_KS + ks * 16 + lh * 8);
#pragma unroll
                for (int at = 0; at < 2; ++at) {
                    f32x16 acc;
#pragma unroll
                    for (int q = 0; q < 16; ++q) acc[q] = 0.f;
#pragma unroll
                    for (int ks = 0; ks < 4; ++ks) acc = mfma32(af[at][ks], bf[ks], acc);
                    float s0 = 0.f, s1 = 0.f;
#pragma unroll
                    for (int hd = 0; hd < 8; ++hd) { s0 += wq[at][0][hd] * fmaxf(acc[hd], 0.f); s1 += wq[at][1][hd] * fmaxf(acc[8 + hd], 0.f); }
                    const int q0 = qlo + 4 * at + lh;
                    SC[(size_t)q0 * 8192 + key0 + l31] = s0; SC[(size_t)(q0 + 2) * 8192 + key0 + l31] = s1;
                }
            }
        }
        ++kb; if (kb > qt) { kb = 0; ++qt; }
    }
    __syncthreads();
}

__device__ __forceinline__ unsigned ord_key(float v) { const unsigned bits = __float_as_uint(v + 0.0f); return bits ^ ((bits >> 31) ? 0xFFFFFFFFu : 0x80000000u); }
__device__ __forceinline__ int mbcnt64(unsigned long long m) { return (int)__builtin_amdgcn_mbcnt_hi((unsigned)(m >> 32), __builtin_amdgcn_mbcnt_lo((unsigned)m, 0u)); }
constexpr int SEL_CAP = 1024;
__device__ __forceinline__ void phase_select(const Ctx& c, const Params& P, int b, size_t sc_off = WS_SCORES) {
    const float* SC = (const float*)(P.ws + sc_off); int* SEL = (int*)(P.ws + WS_SEL) + (size_t)b * 8192 * 256;
    const int lane = c.lane;
    LAS unsigned* CU = (LAS unsigned*)(c.lds + c.wave * (SEL_CAP * 8)); LAS int* CI = (LAS int*)(CU + SEL_CAP);
    for (int t = c.wg * 8 + c.wave; t < 8192; t += c.nwg * 8) {
        int* out = SEL + (size_t)t * 256;
        if (t < 256) { for (int i = lane; i < 256; i += 64) out[i] = i <= t ? i : 0; continue; }
        const float* row = SC + (size_t)t * 8192; const int n = t + 1, ngrp = (n + 63) >> 6;
        unsigned tau0 = 1u; int ks = 0, msamp = 0; unsigned su[8];
        if (n > SEL_CAP) {
            msamp = 512;
#pragma unroll
            for (int q = 0; q < 8; ++q) { const int sidx = (int)(((long)(lane + 64 * q) * n) >> 9); su[q] = ord_key(row[sidx]); }
            ks = (int)((448l * 512 + n - 1) / n); if (ks < 1) ks = 1;
        }
        int C = 0; bool ok = false;
        for (int attempt = 0; attempt < 5 && !ok; ++attempt) {
            if (n > SEL_CAP) {
                unsigned prefix = 0u;
                for (int bit = 31; bit >= 0; --bit) { const unsigned cand = prefix | (1u << bit); int cnt = 0;
#pragma unroll
                    for (int q = 0; q < 8; ++q) cnt += __popcll(__ballot(su[q] >= cand));
                    if (cnt >= ks) prefix = cand; }
                tau0 = prefix;
            }
            C = 0; bool over = false;
            const int nv4 = (n + 255) >> 8;
            for (int g0 = 0; g0 < nv4; g0 += 16) {
                f32x4 v4[16];
#pragma unroll
                for (int k = 0; k < 16; ++k) { v4[k] = (f32x4){0.f, 0.f, 0.f, 0.f}; if (g0 + k < nv4) v4[k] = *(const f32x4*)(row + (g0 + k) * 256 + lane * 4); }
#pragma unroll
                for (int k = 0; k < 16; ++k) {
                    if (g0 + k < nv4) {
                        const int idx0 = (g0 + k) * 256 + lane * 4; unsigned uq[4]; bool f[4]; int pre = 0, tot = 0;
#pragma unroll
                        for (int q = 0; q < 4; ++q) { uq[q] = (idx0 + q <= t) ? ord_key(v4[k][q]) : 0u; f[q] = uq[q] >= tau0; const unsigned long long m = __ballot(f[q]); pre += mbcnt64(m); tot += __popcll(m); }
                        int pos = C + pre;
#pragma unroll
                        for (int q = 0; q < 4; ++q) { if (f[q]) { if (pos < SEL_CAP) { CU[pos] = uq[q]; CI[pos] = idx0 + q; } ++pos; } }
                        C += tot;
                    }
                }
            }
            over = C > SEL_CAP;
            if (over) { ks = ks > 1 ? ks >> 1 : 1; if (n <= SEL_CAP) break; }
            else if (C < 256) { ks = ks * 2 + 8; if (ks > msamp) ks = msamp; if (n <= SEL_CAP) break; }
            else ok = true;
        }
        asm volatile("s_waitcnt lgkmcnt(0)" ::: "memory");
        if (ok) {
            unsigned cu[16];
#pragma unroll
            for (int q = 0; q < 16; ++q) { const int ci = lane + 64 * q; cu[q] = ci < C ? CU[ci] : 0u; }
            unsigned prefix = 0u;
            for (int bit = 31; bit >= 0; --bit) { const unsigned cand = prefix | (1u << bit); int cnt = 0;
#pragma unroll
                for (int q = 0; q < 16; ++q) cnt += __popcll(__ballot(cu[q] >= cand));
                if (cnt >= 256) prefix = cand;
                if (cnt == 256) break; }
            int cgt = 0;
#pragma unroll
            for (int q = 0; q < 16; ++q) cgt += __popcll(__ballot(cu[q] > prefix));
            const int need_eq = 256 - cgt; int obase = 0, eqseen = 0;
#pragma unroll
            for (int q = 0; q < 16; ++q) { const bool gt = cu[q] > prefix, eq = cu[q] == prefix; const unsigned long long meq = __ballot(eq);
                const bool take = gt || (eq && (eqseen + mbcnt64(meq)) < need_eq); const unsigned long long mt = __ballot(take);
                if (take) out[obase + mbcnt64(mt)] = CI[lane + 64 * q];
                obase += __popcll(mt); eqseen += __popcll(meq); }
        } else {
            unsigned prefix = 0u;
            for (int bit = 31; bit >= 0; --bit) { const unsigned cand = prefix | (1u << bit); int cnt = 0;
                for (int g = 0; g < ngrp; ++g) { const int idx = g * 64 + lane; const unsigned u = idx <= t ? ord_key(row[idx]) : 0u; cnt += __popcll(__ballot(u >= cand)); }
                if (cnt >= 256) prefix = cand;
                if (cnt == 256) break; }
            int cgt = 0;
            for (int g = 0; g < ngrp; ++g) { const int idx = g * 64 + lane; const unsigned u = idx <= t ? ord_key(row[idx]) : 0u; cgt += __popcll(__ballot(u > prefix)); }
            const int need_eq = 256 - cgt; int obase = 0, eqseen = 0;
            for (int g = 0; g < ngrp; ++g) { const int idx = g * 64 + lane; const unsigned u = idx <= t ? ord_key(row[idx]) : 0u;
                const bool gt = u > prefix, eq = u == prefix; const unsigned long long meq = __ballot(eq);
                const bool take = gt || (eq && (eqseen + mbcnt64(meq)) < need_eq); const unsigned long long mt = __ballot(take);
                if (take) out[obase + mbcnt64(mt)] = idx;
                obase += __popcll(mt); eqseen += __popcll(meq); }
        }
    }
    __syncthreads();
}

__device__ __forceinline__ unsigned off_b(unsigned row, unsigned ch) { return 256u * row + 16u * (ch ^ (((row & 3u) << 2) | ((row >> 2) & 3u))); }
__device__ __forceinline__ unsigned rho_of(unsigned kap) { return (kap & 32u) | (((kap >> 2) & 3u) << 3) | (((kap >> 4) & 1u) << 2) | (kap & 3u); }
__device__ __forceinline__ void tr_read4(unsigned a0, unsigned a1, unsigned a2, unsigned a3, bf16x8& x, bf16x8& y) {
    u32x2 r0, r1, r2, r3;
    asm volatile("ds_read_b64_tr_b16 %0, %4\n\tds_read_b64_tr_b16 %1, %5\n\tds_read_b64_tr_b16 %2, %6\n\tds_read_b64_tr_b16 %3, %7\n\ts_waitcnt lgkmcnt(0)"
                 : "=&v"(r0), "=&v"(r1), "=&v"(r2), "=&v"(r3) : "v"(a0), "v"(a1), "v"(a2), "v"(a3) : "memory");
    u32x4 xx; xx.x = r0.x; xx.y = r0.y; xx.z = r1.x; xx.w = r1.y; u32x4 yy; yy.x = r2.x; yy.y = r2.y; yy.z = r3.x; yy.w = r3.y;
    x = __builtin_bit_cast(bf16x8, xx); y = __builtin_bit_cast(bf16x8, yy);
}
constexpr int AT_TILE = 16384, AT_WAVE = AT_TILE + 256, AT_BIAS = 8 * AT_WAVE;
__device__ __forceinline__ void phase_attn(const Ctx& c, const Params& P) {
    const int lane = c.lane, w = c.wave, fr = lane & 15, fq = lane >> 4;
    LAS unsigned char* tile = c.lds + w * AT_WAVE; LAS int* kidx = (LAS int*)(tile + AT_TILE); LAS float* BT = (LAS float*)(c.lds + AT_BIAS);
    const unsigned tile_a = (unsigned)(size_t)tile;
    for (int i = c.tid; i < 129 * 8; i += 512) { const int d = i >> 3, h = i & 7; int bk;
        if (d < 16) bk = d; else { const int lg = 16 + (int)(logf((float)d / 16.0f) / 2.0794415416798357f * 16.0f); bk = lg < 31 ? lg : 31; }
        BT[i] = P.in[I_RELB][bk * 8 + h]; }
    __syncthreads();
    const bf16_t* QT = (const bf16_t*)(P.ws + WS_QT); const bf16_t* CKV = (const bf16_t*)(P.ws + WS_CKV); const int* SEL = (const int*)(P.ws + WS_SEL); bf16_t* CTX = (bf16_t*)(P.ws + WS_CTX);
    for (int t = c.wg * 8 + w; t < NTOK; t += c.nwg * 8) {
        const int b = t >> 13, s = t & 8191, nsel = s + 1 < 256 ? s + 1 : 256;
        bf16x8 qf[4];
#pragma unroll
        for (int ks = 0; ks < 4; ++ks) { u32x4 z = (u32x4){0u, 0u, 0u, 0u}; if (fr < 8) z = *(const u32x4*)(QT + (size_t)t * 1024 + fr * 128 + ks * 32 + fq * 8); qf[ks] = __builtin_bit_cast(bf16x8, z); }
        f32x4 ctx[8];
#pragma unroll
        for (int cc = 0; cc < 8; ++cc) ctx[cc] = (f32x4){0.f, 0.f, 0.f, 0.f};
        float mrun = -1e30f, lrun = 0.f;
        int nidx = lane < nsel ? SEL[(size_t)t * 256 + lane] : 0;
        u32x4 pre[8]; bool havepre = false;
        for (int ch = 0; ch * 64 < nsel; ++ch) {
            const bool more = (ch + 1) * 64 < nsel; int nnext = 0;
            if (more) { const int slot = (ch + 1) * 64 + lane; nnext = slot < nsel ? SEL[(size_t)t * 256 + slot] : 0; }
            kidx[lane] = nidx;
            asm volatile("s_waitcnt lgkmcnt(0)" ::: "memory");
#pragma unroll
            for (int it = 0; it < 16; ++it) { const int kap = it * 4 + fq; u32x4 v;
                if (it < 8 && havepre) v = pre[it & 7];
                else { const int ki = kidx[kap]; v = *(const u32x4*)(CKV + ((size_t)b * 8192 + ki) * 128 + fr * 8); }
                *(LAS u32x4*)(tile + off_b(rho_of(kap), fr)) = v; }
            asm volatile("s_waitcnt vmcnt(0) lgkmcnt(0)" ::: "memory");
            f32x4 sc[4];
#pragma unroll
            for (int rb = 0; rb < 4; ++rb) { sc[rb] = (f32x4){0.f, 0.f, 0.f, 0.f};
#pragma unroll
                for (int ks = 0; ks < 4; ++ks) { const bf16x8 a = *(const LAS bf16x8*)(tile + off_b(rho_of(16 * rb + fr), 4 * ks + fq)); sc[rb] = mfma16(a, qf[ks], sc[rb]); } }
            if (more) {
#pragma unroll
                for (int it = 0; it < 8; ++it) { const int ki = shi(nnext, it * 4 + fq); pre[it] = *(const u32x4*)(CKV + ((size_t)b * 8192 + ki) * 128 + fr * 8); } }
            havepre = more; nidx = nnext;
            float mx = -1e30f;
#pragma unroll
            for (int rb = 0; rb < 4; ++rb)
#pragma unroll
                for (int r = 0; r < 4; ++r) { const int kap = 16 * rb + 4 * fq + r; const int slot = ch * 64 + kap; int dist = s - kidx[kap]; dist = dist < 0 ? 0 : (dist > 128 ? 128 : dist);
                    float lg = sc[rb][r] * 0.125f + BT[dist * 8 + (fr & 7)]; lg = slot < nsel ? lg : -1e30f; sc[rb][r] = lg; mx = fmaxf(mx, lg); }
            mx = fmaxf(mx, shf(mx, lane ^ 16)); mx = fmaxf(mx, shf(mx, lane ^ 32));
            const float mnew = fmaxf(mrun, mx), alpha = __expf(mrun - mnew); mrun = mnew;
            float ps = 0.f; bf16x8 pf[2];
            { float pv[16];
#pragma unroll
              for (int rb = 0; rb < 4; ++rb)
#pragma unroll
                  for (int r = 0; r < 4; ++r) { const float p = sc[rb][r] > -1e29f ? __expf(sc[rb][r] - mnew) : 0.f; pv[rb * 4 + r] = p; ps += p; }
#pragma unroll
              for (int kk = 0; kk < 2; ++kk) { u32x4 pk; pk.x = cvt_pk_bf16(pv[kk * 8 + 0], pv[kk * 8 + 1]); pk.y = cvt_pk_bf16(pv[kk * 8 + 2], pv[kk * 8 + 3]); pk.z = cvt_pk_bf16(pv[kk * 8 + 4], pv[kk * 8 + 5]); pk.w = cvt_pk_bf16(pv[kk * 8 + 6], pv[kk * 8 + 7]);
                  pf[kk] = __builtin_bit_cast(bf16x8, pk); } }
            lrun = lrun * alpha + ps;
            float ar[4];
#pragma unroll
            for (int r = 0; r < 4; ++r) ar[r] = shf(alpha, (4 * fq + r) & 15);
#pragma unroll
            for (int cc = 0; cc < 8; ++cc) { ctx[cc][0] *= ar[0]; ctx[cc][1] *= ar[1]; ctx[cc][2] *= ar[2]; ctx[cc][3] *= ar[3]; }
#pragma unroll
            for (int kk = 0; kk < 2; ++kk)
#pragma unroll
                for (int c2 = 0; c2 < 4; ++c2) { bf16x8 b0, b1;
                    const unsigned q = fr >> 2, p = fr & 3;
                    const unsigned r0 = 32 * kk + 8 * fq + q, r1 = r0 + 4;
                    const unsigned a00 = tile_a + off_b(r0, 2 * (2 * c2) + (p >> 1)) + 8 * (p & 1), a01 = tile_a + off_b(r1, 2 * (2 * c2) + (p >> 1)) + 8 * (p & 1);
                    const unsigned a10 = tile_a + off_b(r0, 2 * (2 * c2 + 1) + (p >> 1)) + 8 * (p & 1), a11 = tile_a + off_b(r1, 2 * (2 * c2 + 1) + (p >> 1)) + 8 * (p & 1);
                    tr_read4(a00, a01, a10, a11, b0, b1);
                    ctx[2 * c2] = mfma16(pf[kk], b0, ctx[2 * c2]); ctx[2 * c2 + 1] = mfma16(pf[kk], b1, ctx[2 * c2 + 1]); }
        }
        lrun += shf(lrun, lane ^ 16); lrun += shf(lrun, lane ^ 32);
        const float linv = 1.0f / lrun; float li[4];
#pragma unroll
        for (int r = 0; r < 4; ++r) li[r] = shf(linv, (4 * fq + r) & 15);
        if (fq < 2) {
#pragma unroll
            for (int cc = 0; cc < 8; ++cc)
#pragma unroll
                for (int r = 0; r < 4; ++r) CTX[(size_t)t * 1024 + (4 * fq + r) * 128 + cc * 16 + fr] = f2bf(ctx[cc][r] * li[r]);
        }
    }
    __syncthreads();
}

__device__ __forceinline__ void phase_route(const Ctx& c, const Params& P, int l) {
    LAS int* LC = (LAS int*)c.lds;
    LAS int* LB = LC + 64;
    LAS int* LR = LC + 128;
    LAS int* LE = LC + 128 + 1024;
    const float* RL = (const float*)(P.ws + WS_RLOG); int* TOPI = (int*)(P.ws + WS_TOPI); float* TOPG = (float*)(P.ws + WS_TOPG); int* TOPR = (int*)(P.ws + WS_TOPR);
    unsigned* gcnt = (unsigned*)(P.ws + WS_CTL + CTL_MOECNT) + l * 64;
    const int lane = c.lane; const float rb = P.in[I_RTB][l * 64 + lane];
    for (int blk = c.wg; blk < NTOK / 128; blk += c.nwg) {
        if (c.tid < 64) LC[c.tid] = 0;
        __syncthreads();
        for (int i = 0; i < 16; ++i) { const int lt = c.wave * 16 + i, tok = blk * 128 + lt;
            const float sc = sigmoidf_(RL[(size_t)tok * 256 + lane]); float key = sc + rb; float mys = 0.f; int mye = 0; float ssum = 0.f;
#pragma unroll
            for (int j = 0; j < 8; ++j) { const float mx = wave_max(key); const unsigned long long m = __ballot(key == mx); const int src = m ? __ffsll((long long)m) - 1 : j;
                const float s = shf(sc, src); ssum += s; if (lane == j) { mys = s; mye = src; } if (lane == src) key = -1e30f; }
            if (lane < 8) { const int lr = __hip_atomic_fetch_add(&LC[mye], 1, __ATOMIC_RELAXED, __HIP_MEMORY_SCOPE_WORKGROUP); LR[lt * 8 + lane] = lr; LE[lt * 8 + lane] = mye;
                TOPI[(size_t)tok * 8 + lane] = mye; TOPG[(size_t)tok * 8 + lane] = mys / ssum * 2.5f; }
        }
        __syncthreads();
        if (c.tid < 64) LB[c.tid] = (int)atomicAdd(&gcnt[c.tid], (unsigned)LC[c.tid]);
        __syncthreads();
        for (int i = c.tid; i < 1024; i += 512) TOPR[(size_t)blk * 1024 + i] = LB[LE[i]] + LR[i];
        __syncthreads();
    }
}
__device__ __forceinline__ void phase_moe_book(const Ctx& c, const Params& P, int l) {
    LAS int* EB = (LAS int*)c.lds;
    const unsigned* gcnt = (const unsigned*)(P.ws + WS_CTL + CTL_MOECNT) + l * 64;
    int* SROW = (int*)(P.ws + WS_SROW); int* TEXP = (int*)(P.ws + WS_TEXP); int* EBASE = (int*)(P.ws + WS_EBASE);
    const int* TOPI = (const int*)(P.ws + WS_TOPI); const int* TOPR = (const int*)(P.ws + WS_TOPR);
    if (c.tid == 0) { int acc = 0; for (int e = 0; e < 64; ++e) { const int cnt = (int)__hip_atomic_load(&gcnt[e], __ATOMIC_RELAXED, __HIP_MEMORY_SCOPE_AGENT); EB[e] = acc; EB[64 + e] = cnt; acc += (cnt + 255) & ~255; } EB[128] = acc; }
    __syncthreads();
    if (c.wg == 0) { if (c.tid < 64) EBASE[c.tid] = EB[c.tid]; if (c.tid == 64) TEXP[MOE_TILES] = EB[128] >> 8; }
    for (int e = c.wg; e < 64; e += c.nwg) { const int base = EB[e], cnt = EB[64 + e], pad = (cnt + 255) & ~255;
        for (int i = cnt + c.tid; i < pad; i += 512) SROW[base + i] = 0;
        for (int i = c.tid; i < (pad >> 8); i += 512) TEXP[(base >> 8) + i] = e; }
    for (int i = c.wg * 512 + c.tid; i < NTOK * 8; i += c.nwg * 512) SROW[EB[TOPI[i]] + TOPR[i]] = i >> 3;
    __syncthreads();
}
__device__ __forceinline__ void phase_combine(const Ctx& c, const Params& P, int l, float* outF, bf16_t* outB) {
    const bf16_t* XMB = (const bf16_t*)(P.ws + WS_XMB); const bf16_t* YS = (const bf16_t*)(P.ws + WS_YS);
    const int* TOPI = (const int*)(P.ws + WS_TOPI); const int* TOPR = (const int*)(P.ws + WS_TOPR); const float* TOPG = (const float*)(P.ws + WS_TOPG); const int* EBASE = (const int*)(P.ws + WS_EBASE);
    const float* g = P.in[I_LN2G] + l * 1024; const float* bt = P.in[I_LN2B] + l * 1024; const int lane = c.lane;
    for (int tok = c.wg * 8 + c.wave; tok < NTOK; tok += c.nwg * 8) {
        f32x4 v[4];
#pragma unroll
        for (int q = 0; q < 4; ++q) { const u32x2 xw = *(const u32x2*)(XMB + (size_t)tok * 1024 + q * 256 + lane * 4); const f32x4 x = (f32x4){bflo(xw.x), bfhi(xw.x), bflo(xw.y), bfhi(xw.y)}; const u32x2 sh = *(const u32x2*)(YS + (size_t)tok * 1024 + q * 256 + lane * 4);
            v[q] = x * DN_ALPHA + (f32x4){bflo(sh.x), bfhi(sh.x), bflo(sh.y), bfhi(sh.y)}; }
        for (int k = 0; k < 8; ++k) { const int e = TOPI[(size_t)tok * 8 + k]; const size_t row = (size_t)NTOK + EBASE[e] + TOPR[(size_t)tok * 8 + k]; const float gt = TOPG[(size_t)tok * 8 + k];
#pragma unroll
            for (int q = 0; q < 4; ++q) { const u32x2 y = *(const u32x2*)(YS + row * 1024 + q * 256 + lane * 4); v[q] += (f32x4){bflo(y.x), bfhi(y.x), bflo(y.y), bfhi(y.y)} * gt; } }
        float s = 0.f;
#pragma unroll
        for (int q = 0; q < 4; ++q) s += (v[q][0] + v[q][1]) + (v[q][2] + v[q][3]);
        const float mu = wave_sum(s) * (1.0f / 1024.0f); float qq = 0.f;
#pragma unroll
        for (int q = 0; q < 4; ++q) { const f32x4 d = v[q] - mu; qq += (d[0] * d[0] + d[1] * d[1]) + (d[2] * d[2] + d[3] * d[3]); }
        const float rs = rsqrtf(wave_sum(qq) * (1.0f / 1024.0f) + LN_EPS);
#pragma unroll
        for (int q = 0; q < 4; ++q) { const f32x4 o = (v[q] - mu) * rs * *(const f32x4*)(g + q * 256 + lane * 4) + *(const f32x4*)(bt + q * 256 + lane * 4);
            if (outF) *(f32x4*)(outF + (size_t)tok * 1024 + q * 256 + lane * 4) = o;
            if (outB) { u32x2 wv; wv.x = cvt_pk_bf16(o[0], o[1]); wv.y = cvt_pk_bf16(o[2], o[3]); *(u32x2*)(outB + (size_t)tok * 1024 + q * 256 + lane * 4) = wv; } }
    }
}

constexpr int LDS_PARAM_OFF = LDS_BYTES - 1024;
__device__ __forceinline__ Params ld_params(LAS unsigned char* lds) {
    unsigned a_s = (unsigned)(size_t)lds + LDS_PARAM_OFF; asm volatile("" : "+s"(a_s) :: "memory");
    unsigned a_ = a_s; asm volatile("" : "+v"(a_));
    Params P; const LAS unsigned* src = (const LAS unsigned*)(size_t)a_;
#pragma unroll
    for (int i = 0; i < 33; ++i) { const unsigned lo = __builtin_amdgcn_readfirstlane(src[2 * i]), hi = __builtin_amdgcn_readfirstlane(src[2 * i + 1]); P.in[i] = (const float*)(const __attribute__((address_space(1))) float*)(((unsigned long long)hi << 32) | lo); }
    { const unsigned lo = __builtin_amdgcn_readfirstlane(src[66]), hi = __builtin_amdgcn_readfirstlane(src[67]); P.out = (float*)(__attribute__((address_space(1))) float*)(((unsigned long long)hi << 32) | lo); }
    { const unsigned lo = __builtin_amdgcn_readfirstlane(src[68]), hi = __builtin_amdgcn_readfirstlane(src[69]); P.ws = (unsigned char*)(__attribute__((address_space(1))) unsigned char*)(((unsigned long long)hi << 32) | lo); }
    return P;
}
__device__ __forceinline__ Ctx fresh_ctx(LAS unsigned char* lds, int wave) {
    Ctx c; int t = wave * 64 + (int)__builtin_amdgcn_mbcnt_hi(~0u, __builtin_amdgcn_mbcnt_lo(~0u, 0u)); asm volatile("" : "+v"(t)); c.tid = t; c.lane = t & 63; c.wave = __builtin_amdgcn_readfirstlane(t >> 6); c.wg = blockIdx.x; c.nwg = gridDim.x; c.lds = lds; return c;
}
#ifndef MK_DUMP_OFF
#define MK_DUMP_OFF WS_DNA
#define MK_DUMP_BF16 1
#define MK_DUMP_LD 1024
#endif
__device__ __forceinline__ void dbg_dump(const Ctx& c, const Params& P) {
    const size_t n = (size_t)NTOK * 1024;
    for (size_t i = (size_t)c.wg * 512 + c.tid; i < n; i += (size_t)c.nwg * 512)
    { const size_t row = i >> 10, col = i & 1023, j = row * MK_DUMP_LD + col;
        P.out[i] = col >= MK_DUMP_LD ? 0.f : (MK_DUMP_BF16 ? bf2f(((const bf16_t*)(P.ws + MK_DUMP_OFF))[j]) : ((const float*)(P.ws + MK_DUMP_OFF))[j]); }
}
#ifndef DUP_SEL
#define DUP_SEL 1
#define DUP_PREP 1
#define DUP_ATTN 1
#define DUP_P0 1
#define DUP_SCAN 1
#define DUP_SCORES 1
#endif
#ifndef MK_STOP_AFTER
#define MK_STOP_AFTER 100000
#endif
__global__ void __launch_bounds__(512, 2) hybrid_fwd(Params Pk) {
    extern __shared__ __attribute__((aligned(16))) unsigned char shm[];
    Ctx c0; c0.lds = (LAS unsigned char*)shm; c0.tid = threadIdx.x; c0.lane = c0.tid & 63; c0.wave = __builtin_amdgcn_readfirstlane(c0.tid >> 6); c0.wg = blockIdx.x; c0.nwg = gridDim.x;
#define CX (fresh_ctx(c0.lds, c0.wave))
    LAS unsigned* barw = (LAS unsigned*)(c0.lds + LDS_BYTES - 16);
    if (c0.tid == 0) { barw[0] = 0u; barw[1] = 0u; barw[2] = 0u; barw[3] = 0u; }
    if (c0.tid < 35) { LAS unsigned long long* d = (LAS unsigned long long*)(c0.lds + LDS_PARAM_OFF); d[c0.tid] = c0.tid < 33 ? (unsigned long long)Pk.in[c0.tid] : (c0.tid == 33 ? (unsigned long long)Pk.out : (unsigned long long)Pk.ws); }
    __syncthreads();
    XcdBarrier bar = xcd_barrier_post((unsigned*)(Pk.ws + WS_CTL + CTL_BAR), (volatile LAS unsigned*)barw, c0.tid);
#define PP (ld_params((CX).lds))
#define WSP (PP.ws)
#define GBAR() xcd_barrier_ni(bar.bar, bar.x, (unsigned)(size_t)bar.st, (CX).tid)
    phase_load_x(CX, PP);
    phase_p0(CX, PP, 0, true, 0);
    GBAR();
#define LAYER_BODY(l) {\
        { const Ctx cc = CX; SchedPlain S; S.init(NTOK, NIN, 1024, WSP + WS_WIN, cc.nwg, cc.wg); EpiWin E; E.ws = WSP; pg8::gemm_phase(cc.lds, cc.wave, (const char*)(WSP + WS_XB), 1024, S, E); } \
        GBAR(); if ((l) * 100 + 2 >= MK_STOP_AFTER) { dbg_dump(CX, PP); return; } \
        phase_kvnorm(CX, PP, l); \
        for (int d_ = 0; d_ < DUP_PREP; ++d_) phase_dn_prep(CX, PP, l); \
        { const Ctx cc = CX; SchedGrouped S; S.init(32, 1024, 256, 512, WSP + WS_S5E, cc.nwg, cc.wg); S.lda = 640; EpiXloc E; E.O = (float*)(WSP + WS_XLOC); pg8::gemm_phase(cc.lds, cc.wave, (const char*)(WSP + WS_CUP), 512, S, E); } \
        GBAR(); if ((l) * 100 + 3 >= MK_STOP_AFTER) { dbg_dump(CX, PP); return; } \
          \
        if (c0.nwg > 64) { \
            if (c0.wg < 64) phase_dn_scan(CX, PP, 64); \
            else { phase_s5_carry(CX, PP, 64, c0.nwg - 64); Ctx c2 = CX; c2.wg -= 64; c2.nwg -= 64; phase_idx_scores(c2, PP, 0); } \
        } else { phase_dn_scan(CX, PP, c0.nwg); phase_s5_carry(CX, PP, 0, c0.nwg); phase_idx_scores(CX, PP, 0); } \
        phase_p0_experts(CX, PP, l); \
        GBAR(); if ((l) * 100 + 4 >= MK_STOP_AFTER) { dbg_dump(CX, PP); return; } \
        phase_dn_out(CX, PP, l); \
        { const Ctx cc = CX; SchedGrouped S; S.init(32, 1024, 512, 640, WSP + WS_S5TF, cc.nwg, cc.wg); S.lda = 640; EpiS5 E; E.O = (bf16_t*)(WSP + WS_YCPRE); pg8::gemm_phase(cc.lds, cc.wave, (const char*)(WSP + WS_CUP), 640, S, E); } \
        phase_select(CX, PP, 0); \
        GBAR(); if ((l) * 100 + 5 >= MK_STOP_AFTER) { dbg_dump(CX, PP); return; } \
          \
        phase_idx_scores(CX, PP, 1, WS_SCORES2); \
        GBAR(); if ((l) * 100 + 6 >= MK_STOP_AFTER) { dbg_dump(CX, PP); return; } \
        phase_idx_scores(CX, PP, 2, WS_SCORES); phase_select(CX, PP, 1, WS_SCORES2); \
        GBAR(); if ((l) * 100 + 7 >= MK_STOP_AFTER) { dbg_dump(CX, PP); return; } \
        phase_idx_scores(CX, PP, 3, WS_SCORES2); phase_select(CX, PP, 2, WS_SCORES); \
        GBAR(); if ((l) * 100 + 7 >= MK_STOP_AFTER) { dbg_dump(CX, PP); return; } \
        phase_select(CX, PP, 3, WS_SCORES2); \
        GBAR(); if ((l) * 100 + 7 >= MK_STOP_AFTER) { dbg_dump(CX, PP); return; } \
        for (int d_ = 0; d_ < DUP_ATTN; ++d_) phase_attn(CX, PP); \
        { const Ctx cc = CX; SchedPlain S; S.init(NTOK, 512, 512, WSP + WS_WGLU, cc.nwg, cc.wg); EpiGlu E; E.Y = (const bf16_t*)(WSP + WS_YCPRE); E.bias = PP.in[I_GLUB] + l * 512; E.O = (bf16_t*)(WSP + WS_YC); \
          pg8::gemm_phase(cc.lds, cc.wave, (const char*)(WSP + WS_YCPRE), 512, S, E); } \
        GBAR(); if ((l) * 100 + 8 >= MK_STOP_AFTER) { dbg_dump(CX, PP); return; } \
        { const Ctx cc = CX; SchedPlain S; S.init(NTOK, 1024, 1024, WSP + WS_WBRA, cc.nwg, cc.wg); EpiMerge<0> E; E.Mf = (float*)(WSP + WS_MERGED); E.Mb = (bf16_t*)(WSP + WS_MERGEDB); E.gates = (const bf16_t*)(WSP + WS_GATES); E.gcol0 = 0; \
          pg8::gemm_phase(cc.lds, cc.wave, (const char*)(WSP + WS_CTX), 1024, S, E); } \
        { const Ctx cc = CX; SchedMergeBC S; S.init(NTOK, 1024, 512, WSP + WS_WBRB, cc.nwg, cc.wg); S.offB = WS_YB; S.offC = WS_YC; S.BtB = (const char*)(WSP + WS_WBRB); S.BtC = (const char*)(WSP + WS_WBRC); \
          EpiMergeBC E; E.Mb = (bf16_t*)(WSP + WS_MERGEDB); E.gates = (const bf16_t*)(WSP + WS_GATES); pg8::gemm_phase(cc.lds, cc.wave, (const char*)WSP, 512, S, E); } \
        GBAR(); if ((l) * 100 + 9 >= MK_STOP_AFTER) { dbg_dump(CX, PP); return; } \
        { const Ctx cc = CX; SchedPlain S; S.init(NTOK, 1024, 1024, WSP + WS_WO, cc.nwg, cc.wg); EpiResid E; E.XB = (const bf16_t*)(WSP + WS_XB); E.O = (float*)(WSP + WS_XM); pg8::gemm_phase(cc.lds, cc.wave, (const char*)(WSP + WS_MERGEDB), 1024, S, E); } \
        GBAR(); if ((l) * 100 + 10 >= MK_STOP_AFTER) { dbg_dump(CX, PP); return; } \
        phase_ln(CX, (const float*)(WSP + WS_XM), PP.in[I_LN1G] + l * 1024, PP.in[I_LN1B] + l * 1024, (float*)nullptr, (bf16_t*)(WSP + WS_XMB)); \
        GBAR(); if ((l) * 100 + 11 >= MK_STOP_AFTER) { dbg_dump(CX, PP); return; } \
        { const Ctx cc = CX; SchedPlain S; S.init(NTOK, 256, 1024, WSP + WS_WRT, cc.nwg, cc.wg); EpiF32 E; E.O = (float*)(WSP + WS_RLOG); E.ld = 256; pg8::gemm_phase(cc.lds, cc.wave, (const char*)(WSP + WS_XMB), 1024, S, E); } \
        if ((l) + 1 < DEPTH) phase_p0(CX, PP, (l) + 1, false, 128);        \
        GBAR(); if ((l) * 100 + 12 >= MK_STOP_AFTER) { dbg_dump(CX, PP); return; } \
        phase_route(CX, PP, l); \
        GBAR(); if ((l) * 100 + 13 >= MK_STOP_AFTER) { dbg_dump(CX, PP); return; } \
        phase_moe_book(CX, PP, l); \
        GBAR(); if ((l) * 100 + 14 >= MK_STOP_AFTER) { dbg_dump(CX, PP); return; } \
        { const Ctx cc = CX; SchedGU S; S.texp = (const int*)(WSP + WS_TEXP); S.srow = (const int*)(WSP + WS_SROW); S.ntiles = __builtin_amdgcn_readfirstlane(S.texp[MOE_TILES]); S.G = cc.nwg; S.c = cc.wg; S.Bt = (const char*)(WSP + WS_WGU); \
          EpiGU E; E.HS = (bf16_t*)(WSP + WS_HS); pg8::gemm_phase(cc.lds, cc.wave, (const char*)(WSP + WS_XMB), 1024, S, E); } \
        GBAR(); if ((l) * 100 + 15 >= MK_STOP_AFTER) { dbg_dump(CX, PP); return; } \
        { const Ctx cc = CX; SchedDown S; S.texp = (const int*)(WSP + WS_TEXP); S.ntiles = __builtin_amdgcn_readfirstlane(S.texp[MOE_TILES]); S.G = cc.nwg; S.c = cc.wg; S.Bt = (const char*)(WSP + WS_WDN); \
          EpiDown E; E.YS = (bf16_t*)(WSP + WS_YS); pg8::gemm_phase(cc.lds, cc.wave, (const char*)(WSP + WS_HS), 256, S, E); } \
        GBAR(); if ((l) * 100 + 16 >= MK_STOP_AFTER) { dbg_dump(CX, PP); return; } \
        if (l == DEPTH - 1) phase_combine(CX, PP, l, PP.out, (bf16_t*)nullptr); \
        else phase_combine(CX, PP, l, (float*)nullptr, (bf16_t*)(WSP + WS_XB)); \
        GBAR(); if ((l) * 100 + 17 >= MK_STOP_AFTER) { dbg_dump(CX, PP); return; } \
    }
    LAYER_BODY(0) LAYER_BODY(1) LAYER_BODY(2) LAYER_BODY(3)
#undef GBAR
#undef CX
#undef PP
#undef WSP
}

extern "C" void kernel_launch(void* const* d_in, const int* in_sizes, int n_in, void* d_out, int out_size, void* d_ws, size_t ws_size, hipStream_t stream) {
    static int grid = 0;
    if (grid == 0) {
        if (n_in != 33 || ws_size < WS_TOTAL) { fprintf(stderr, "kernel_launch: expected 33 inputs and >= %zu bytes of workspace; got %d inputs, %zu bytes\n", (size_t)WS_TOTAL, n_in, ws_size); grid = -1; return; }
        int dev = 0, cus = 0, per_cu = 0;
        if (hipGetDevice(&dev) != hipSuccess || hipDeviceGetAttribute(&cus, hipDeviceAttributeMultiprocessorCount, dev) != hipSuccess) { grid = -1; return; }
        if (hipFuncSetAttribute((const void*)hybrid_fwd, hipFuncAttributeMaxDynamicSharedMemorySize, LDS_BYTES) != hipSuccess) { fprintf(stderr, "kernel_launch: hipFuncSetAttribute failed\n"); grid = -1; return; }
        if (hipOccupancyMaxActiveBlocksPerMultiprocessor(&per_cu, (const void*)hybrid_fwd, 512, LDS_BYTES) != hipSuccess || per_cu < 1) { fprintf(stderr, "kernel_launch: occupancy query says %d\n", per_cu); per_cu = 1; }
        (void)hipGetLastError();
        grid = cus;
    }
    if (grid < 0) return;
    if (hipMemsetAsync((char*)d_ws + WS_CTL, 0, CTL_BYTES, stream) != hipSuccess) return;
    Params p{};
    for (int i = 0; i < 33; ++i) p.in[i] = (const float*)d_in[i];
    p.out = (float*)d_out; p.ws = (unsigned char*)d_ws;
    hipLaunchKernelGGL(hybrid_fwd, dim3(grid), dim3(512), LDS_BYTES, stream, p);
}
```
